# Optimizing an MI355X kernel written in HIP

```python
import jax, jax.numpy as jnp
from jax import lax
import numpy as np

D_MODEL = 1024
BATCH = 8
SEQ = 4096
DEPTH = 1

D_CONV = D_MODEL // 2
CONV_WIDTH = 31
GROUP_DIM = 64
N_HEADS = 8
N_KV_HEADS = 2
HEAD_DIM = 64
D_ATTN = N_HEADS * HEAD_DIM
D_KV = N_KV_HEADS * HEAD_DIM
WINDOW = 128
BLOCK = 128
D_IN = 2 * D_CONV + D_ATTN + 2 * D_KV

N_GROUPS = 4
EXPERTS_PER_GROUP = 8
N_EXPERTS = N_GROUPS * EXPERTS_PER_GROUP
TOP_K = 2
D_EXPERT = D_MODEL // 4

ALPHA = (2.0 * DEPTH) ** 0.25
BETA = (8.0 * DEPTH) ** -0.25
EPS = 1e-5
NEG_INF = -1e30

kernel_name = "hymba_conformer_swa_sink_hmoe_deepnorm_adaln"


def layer_norm(x, g, b):
    xf = x.astype(jnp.float32)
    mu = jnp.mean(xf, axis=-1, keepdims=True)
    var = jnp.mean(jnp.square(xf - mu), axis=-1, keepdims=True)
    y = (xf - mu) * lax.rsqrt(var + EPS)
    return (y * g.astype(jnp.float32) + b.astype(jnp.float32)).astype(x.dtype)


def group_rms_norm(y, g):
    shp = y.shape
    yf = y.astype(jnp.float32).reshape(shp[:-1] + (shp[-1] // GROUP_DIM, GROUP_DIM))
    yf = yf * lax.rsqrt(jnp.mean(jnp.square(yf), axis=-1, keepdims=True) + EPS)
    return (yf.reshape(shp) * g.astype(jnp.float32)).astype(y.dtype)


def conformer_conv(u_a, u_b, conv_w, conv_b, ln_g, ln_b):
    v = u_a * jax.nn.sigmoid(u_b)
    y = lax.conv_general_dilated(
        v, conv_w[:, None, :].astype(v.dtype), window_strides=(1,),
        padding=[(CONV_WIDTH - 1, 0)],
        dimension_numbers=("NWC", "WIO", "NWC"),
        feature_group_count=D_CONV) + conv_b
    y = layer_norm(y, ln_g, ln_b)
    return jax.nn.silu(y)


def sliding_window_sink_attention(q, k, v, sinks):
    B, S, H, Dh = q.shape
    KV = k.shape[2]
    G = H // KV
    NB = S // BLOCK
    qb = q.reshape(B, NB, BLOCK, KV, G, Dh)
    pad = jnp.zeros((B, BLOCK, KV, Dh), k.dtype)
    kp = jnp.concatenate([pad, k], axis=1).reshape(B, NB + 1, BLOCK, KV, Dh)
    vp = jnp.concatenate([pad, v], axis=1).reshape(B, NB + 1, BLOCK, KV, Dh)
    kb = jnp.concatenate([kp[:, :-1], kp[:, 1:]], axis=2)
    vb = jnp.concatenate([vp[:, :-1], vp[:, 1:]], axis=2)
    s = jnp.einsum("bnqkgd,bnskd->bnkgqs", qb, kb).astype(jnp.float32) * (Dh ** -0.5)
    qi = jnp.arange(BLOCK)[:, None]
    si = jnp.arange(2 * BLOCK)[None, :]
    diff = qi + BLOCK - si
    band = (diff >= 0) & (diff < WINDOW)
    key_pos = jnp.arange(NB)[:, None, None] * BLOCK - BLOCK + si[None]
    valid = band[None] & (key_pos >= 0)
    s = jnp.where(valid[None, :, None, None], s, NEG_INF)
    sink = jnp.broadcast_to(sinks.astype(jnp.float32).reshape(1, 1, KV, G, 1, 1),
                            s.shape[:-1] + (1,))
    p = jax.nn.softmax(jnp.concatenate([s, sink], axis=-1), axis=-1)[..., :-1]
    o = jnp.einsum("bnkgqs,bnskd->bnqkgd", p.astype(v.dtype), vb)
    return o.reshape(B, S, H * Dh)


def hierarchical_moe(h, w_rg, b_rg, w_re, b_re, w_gate, w_up, w_down):
    B, S, D = h.shape
    t = h.reshape(-1, D)
    T = t.shape[0]
    p_group = jax.nn.softmax((t @ w_rg + b_rg).astype(jnp.float32), axis=-1)
    p_top, g_idx = lax.top_k(p_group, 1)
    e_logits = (t @ w_re + b_re).astype(jnp.float32).reshape(T, N_GROUPS, EXPERTS_PER_GROUP)
    sel = jnp.take_along_axis(e_logits, g_idx[:, :, None], axis=1)[:, 0]
    p_exp = jax.nn.softmax(sel, axis=-1)
    w_top, e_idx = lax.top_k(p_exp, TOP_K)
    w_top = w_top / jnp.sum(w_top, axis=-1, keepdims=True) * p_top
    eid = g_idx * EXPERTS_PER_GROUP + e_idx
    gates = jnp.sum(jax.nn.one_hot(eid, N_EXPERTS, dtype=jnp.float32) * w_top[..., None],
                    axis=1).astype(t.dtype)
    y = jnp.zeros_like(t)
    for e in range(N_EXPERTS):
        a = jax.nn.silu(t @ w_gate[e]) * (t @ w_up[e])
        y = y + gates[:, e:e + 1] * (a @ w_down[e])
    return y.reshape(B, S, D)


def setup_inputs(seed: int = 0) -> dict:
    key = jax.random.key(seed)
    ks = jax.random.split(key, 32)
    L, D = DEPTH, D_MODEL
    nrm = lambda k, shp, s: jax.random.normal(k, shp, jnp.float32) * s
    col_scale = jnp.concatenate([
        jnp.full((2 * D_CONV,), BETA), jnp.ones((D_ATTN + D_KV,)), jnp.full((D_KV,), BETA)])
    return {
        "x": nrm(ks[0], (BATCH, SEQ, D), 1.0),
        "c": nrm(ks[1], (BATCH, D), 1.0),
        "w_ada": nrm(ks[2], (L, D, 6 * D), 0.5 * D ** -0.5),
        "b_ada": nrm(ks[3], (L, 6 * D), 0.02),
        "w_in": nrm(ks[4], (L, D, D_IN), D ** -0.5) * col_scale,
        "b_in": nrm(ks[5], (L, D_IN), 0.02),
        "conv_w": nrm(ks[6], (L, CONV_WIDTH, D_CONV), CONV_WIDTH ** -0.5),
        "conv_b": nrm(ks[7], (L, D_CONV), 0.02),
        "conv_ln_g": 1.0 + nrm(ks[8], (L, D_CONV), 0.02),
        "conv_ln_b": nrm(ks[9], (L, D_CONV), 0.02),
        "conv_out_g": 1.0 + nrm(ks[10], (L, D_CONV), 0.02),
        "sinks": nrm(ks[11], (L, N_HEADS), 0.5),
        "attn_out_g": 1.0 + nrm(ks[12], (L, D_ATTN), 0.02),
        "w_out": nrm(ks[13], (L, D_CONV + D_ATTN, D), (D_CONV + D_ATTN) ** -0.5 * BETA),
        "b_out": nrm(ks[14], (L, D), 0.02),
        "ln1_g": 1.0 + nrm(ks[15], (L, D), 0.02),
        "ln1_b": nrm(ks[16], (L, D), 0.02),
        "w_router_group": nrm(ks[17], (L, D, N_GROUPS), D ** -0.5),
        "b_router_group": nrm(ks[18], (L, N_GROUPS), 0.01),
        "w_router_expert": nrm(ks[19], (L, D, N_EXPERTS), D ** -0.5),
        "b_router_expert": nrm(ks[20], (L, N_EXPERTS), 0.01),
        "w_gate": nrm(ks[21], (L, N_EXPERTS, D, D_EXPERT), D ** -0.5 * BETA),
        "w_up": nrm(ks[22], (L, N_EXPERTS, D, D_EXPERT), D ** -0.5 * BETA),
        "w_down": nrm(ks[23], (L, N_EXPERTS, D_EXPERT, D), D_EXPERT ** -0.5 * BETA),
        "ln2_g": 1.0 + nrm(ks[24], (L, D), 0.02),
        "ln2_b": nrm(ks[25], (L, D), 0.02),
    }


def reference(x, c, w_ada, b_ada, w_in, b_in, conv_w, conv_b, conv_ln_g, conv_ln_b,
              conv_out_g, sinks, attn_out_g, w_out, b_out, ln1_g, ln1_b,
              w_router_group, b_router_group, w_router_expert, b_router_expert,
              w_gate, w_up, w_down, ln2_g, ln2_b):
    B, S, _ = x.shape
    c_act = jax.nn.silu(c)
    for l in range(DEPTH):
        mod = c_act @ w_ada[l] + b_ada[l]
        sh1, sc1, g1, sh2, sc2, g2 = [m[:, None, :] for m in jnp.split(mod, 6, axis=-1)]

        h = x * (1.0 + sc1) + sh1
        proj = h @ w_in[l] + b_in[l]
        u_a, u_b, q, k, v = jnp.split(
            proj, [D_CONV, 2 * D_CONV, 2 * D_CONV + D_ATTN, 2 * D_CONV + D_ATTN + D_KV], axis=-1)
        y_conv = conformer_conv(u_a, u_b, conv_w[l], conv_b[l], conv_ln_g[l], conv_ln_b[l])
        y_conv = group_rms_norm(y_conv, conv_out_g[l])
        y_attn = sliding_window_sink_attention(
            q.reshape(B, S, N_HEADS, HEAD_DIM), k.reshape(B, S, N_KV_HEADS, HEAD_DIM),
            v.reshape(B, S, N_KV_HEADS, HEAD_DIM), sinks[l])
        y_attn = group_rms_norm(y_attn, attn_out_g[l])
        mix = jnp.concatenate([y_conv, y_attn], axis=-1) @ w_out[l] + b_out[l]
        x = layer_norm(ALPHA * x + g1 * mix, ln1_g[l], ln1_b[l])

        h2 = x * (1.0 + sc2) + sh2
        ffn = hierarchical_moe(h2, w_router_group[l], b_router_group[l], w_router_expert[l],
                               b_router_expert[l], w_gate[l], w_up[l], w_down[l])
        x = layer_norm(ALPHA * x + g2 * ffn, ln2_g[l], ln2_b[l])
    return x
```

```cpp
#include <hip/hip_runtime.h>
#include <cstdio>
#include <cstdint>

#ifndef DUP_PHASE
#define DUP_PHASE -1
#endif
#ifndef DEV_STAGE
#define DEV_STAGE 8
#endif

#define LAS __attribute__((address_space(3)))
#define GAS __attribute__((address_space(1)))
typedef unsigned short bf16_t;
typedef short bf16x8 __attribute__((ext_vector_type(8)));
typedef float f32x4 __attribute__((ext_vector_type(4)));
typedef float f32x2 __attribute__((ext_vector_type(2)));
typedef unsigned u32x4 __attribute__((ext_vector_type(4)));
typedef unsigned u32x2 __attribute__((ext_vector_type(2)));
typedef GAS unsigned gu32;

constexpr int DM = 1024, NBATCH = 8, SEQ = 4096, T = NBATCH * SEQ;
constexpr int DCONV = 512, CW = 31, NH = 8, NKV = 2, HD = 64, DATTN = 512, DKV = 128, WIN = 128;
constexpr int DIN = 1792, NG = 4, EPG = 8, NE = 32, DE = 256;
constexpr float ALPHA = 1.189207115002721f, EPS = 1e-5f;
constexpr float LOG2E = 1.4426950408889634f;
constexpr float QSCALE = 0.125f * LOG2E;

constexpr size_t MiB = 1u << 20;
constexpr size_t WS_CTL = 0, CTL_ZERO_BYTES = 1 * MiB;
constexpr size_t WS_MOD = 1 * MiB;
constexpr size_t WS_BPERM = 1 * MiB + 256 * 1024;
constexpr size_t WS_WR = 1 * MiB + 512 * 1024;
constexpr size_t WS_WI = 2 * MiB;
constexpr size_t WS_WO = 6 * MiB;
constexpr size_t WS_WGU = 8 * MiB;
constexpr size_t WS_WD = 40 * MiB;
constexpr size_t WS_H = 56 * MiB;
constexpr size_t WS_VG = 120 * MiB;
constexpr size_t WS_Q = 152 * MiB;
constexpr size_t WS_KV = 184 * MiB;
constexpr size_t WS_H2 = 200 * MiB;
constexpr size_t WS_ACT = 264 * MiB;
constexpr size_t WS_LIST = 300 * MiB;
constexpr size_t WS_TOK = 304 * MiB;
constexpr size_t WS_STATS = 305 * MiB;
constexpr size_t WS_YS = 56 * MiB;
constexpr size_t WS_DEV1 = 320 * MiB;
constexpr int CW_BAR = 4096;
constexpr int CW_ECNT = 16384;

constexpr int RING_OFF = 0, RING_BYTES = 139264;
constexpr int LDSCTL_OFF = RING_BYTES, MISC_OFF = LDSCTL_OFF + 320;
constexpr int LDS_BYTES = 147456;
constexpr int NWAVES = 8;

#define RLX_AGENT __ATOMIC_RELAXED, __HIP_MEMORY_SCOPE_AGENT
#define LDS_WAIT() asm volatile("s_waitcnt lgkmcnt(0)" ::: "memory")
#define VM_WAIT() asm volatile("s_waitcnt vmcnt(0)" ::: "memory")

__device__ __forceinline__ unsigned f2bf(float f) { unsigned u = __builtin_bit_cast(unsigned, f); return (u + 0x7fffu + ((u >> 16) & 1u)) >> 16; }
__device__ __forceinline__ unsigned pk2(float lo, float hi) { return f2bf(lo) | (f2bf(hi) << 16); }
__device__ __forceinline__ float bf2f(unsigned short b) { return __builtin_bit_cast(float, (unsigned)b << 16); }
__device__ __forceinline__ unsigned cvt_pk_bf16(float lo, float hi) { unsigned r; asm volatile("v_cvt_pk_bf16_f32 %0, %1, %2" : "=v"(r) : "v"(lo), "v"(hi)); return r; }
__device__ __forceinline__ float fast_sigmoid(float v) { return __builtin_amdgcn_rcpf(1.f + __builtin_amdgcn_exp2f(-v * LOG2E)); }
__device__ __forceinline__ float fast_silu(float v) { return v * fast_sigmoid(v); }

#define XB_TMO      128
#define XB_XCNT(j)  (256  + 64 * (j))
#define XB_XSUB(j)  (1280 + 64 * (j))
#define XB_XGEN(j)  (2304 + 64 * (j))
#define XB_TOP      3328
#define XB_TOPGEN   3392
#define XCD_BAR_WORDS 3456
#define XB_SPIN_CAP (1u << 18)
__device__ __forceinline__ unsigned xb_ld(unsigned* p)              { return __hip_atomic_load(p, __ATOMIC_RELAXED, __HIP_MEMORY_SCOPE_AGENT); }
__device__ __forceinline__ unsigned xb_add(unsigned* p, unsigned v) { return __hip_atomic_fetch_add(p, v, __ATOMIC_RELAXED, __HIP_MEMORY_SCOPE_AGENT); }
__device__ __forceinline__ unsigned xb_xcc_id() { return (unsigned)__builtin_amdgcn_s_getreg((3 << 11) | 20) & 0xFu; }
#define XB_SPIN(cond, bar) do { unsigned _sp = 0; while (cond) { __builtin_amdgcn_s_sleep(1); \
    if ((++_sp & 255u) == 0u) { if (xb_ld(&(bar)[XB_TMO])) break; if (_sp > XB_SPIN_CAP) { atomicAdd(&(bar)[XB_TMO], 1u); break; } } } } while (0)
struct XcdBarrier { unsigned* bar; unsigned x; volatile LAS unsigned* st; };
__device__ __forceinline__ XcdBarrier xcd_barrier_post(unsigned* bar, volatile LAS unsigned* st) {
    XcdBarrier b; b.bar = bar; b.x = xb_xcc_id(); b.st = st;
    if (threadIdx.x == 0) (void)xb_add(&bar[XB_XCNT(b.x)], 1u);
    return b;
}
__device__ __forceinline__ void xcd_barrier_complete(unsigned* bar, unsigned x, unsigned& nloc, unsigned& nx) {
    const unsigned G = gridDim.x * gridDim.y * gridDim.z;
    unsigned sum, cnt, mine, sp = 0u;
    for (;;) {
        sum = 0u; cnt = 0u; mine = 0u;
#pragma unroll
        for (unsigned j = 0; j < 16; ++j) { const unsigned c = xb_ld(&bar[XB_XCNT(j)]); sum += c; cnt += (c > 0u) ? 1u : 0u; mine = (j == x) ? c : mine; }
        if (sum == G) break;
        __builtin_amdgcn_s_sleep(1);
        if ((++sp & 255u) == 0u) { if (xb_ld(&bar[XB_TMO])) break; if (sp > XB_SPIN_CAP) { atomicAdd(&bar[XB_TMO], 1u); break; } }
    }
    nloc = mine > 0u ? mine : 1u; nx = cnt > 0u ? cnt : 1u;
}
__device__ __forceinline__ void xcd_barrier(const XcdBarrier& b) {
    asm volatile("s_waitcnt vmcnt(0)" ::: "memory");
    __syncthreads();
    if (threadIdx.x == 0) {
        unsigned* bar = b.bar;
        __builtin_amdgcn_s_waitcnt(0);
        unsigned nloc = b.st[0], nx = b.st[1];
        if (nloc == 0u) { xcd_barrier_complete(bar, b.x, nloc, nx); b.st[0] = nloc; b.st[1] = nx; }
        const unsigned old = xb_add(&bar[XB_XSUB(b.x)], 1u);
        const unsigned gen = old / nloc;
        if (old + 1u == (gen + 1u) * nloc) {
            __builtin_amdgcn_fence(__ATOMIC_RELEASE, "agent");
            asm volatile("s_waitcnt vmcnt(0)" ::: "memory");
            const unsigned og = xb_add(&bar[XB_TOP], 1u);
            const unsigned tg = og / nx;
            if (og + 1u == (tg + 1u) * nx) xb_add(&bar[XB_TOPGEN], 1u);
            else XB_SPIN(xb_ld(&bar[XB_TOPGEN]) == tg, bar);
            __builtin_amdgcn_fence(__ATOMIC_ACQUIRE, "agent");
            xb_add(&bar[XB_XGEN(b.x)], 1u);
            asm volatile("s_waitcnt vmcnt(0)" ::: "memory");
        } else {
            XB_SPIN(xb_ld(&bar[XB_XGEN(b.x)]) == gen, bar);
            __builtin_amdgcn_fence(__ATOMIC_ACQUIRE, "agent");
            asm volatile("s_waitcnt vmcnt(0)" ::: "memory");
        }
    }
    __syncthreads();
}

namespace pg8 {
constexpr int BM = 256, BK = 64, HALF = 128, HTB = HALF * BK * 2, STAGE_BYTES = 8 * HTB, NXCD = 8, WGM = 8;
__host__ __device__ __forceinline__ int lds_byte(int r, int c) { const int st = (r >> 4) * 2 + (c >> 5), rr = r & 15, cc = c & 31, ob = rr * 64 + cc * 2; return st * 1024 + (ob ^ (((ob >> 9) & 1) << 5)); }
__host__ __device__ __forceinline__ void stage_rc(int b, int& R, int& C) { const int st = b / 1024, sb = b % 1024, swz = sb ^ (((sb >> 9) & 1) << 5); R = (st >> 1) * 16 + swz / 64; C = (st & 1) * 32 + (swz % 64) / 2; }
__host__ __device__ __forceinline__ int perm32(int rho) { const int n = rho >> 4, i = rho & 15; return 8 * (i >> 2) + 4 * n + (i & 3); }

struct Unit { int pm, pn, e; };
__device__ __forceinline__ bool static_next(int i, int G, int c, int nM, int nN, int& pm, int& pn) {
    const int nwg = nM * nN; const long L = (long)i * G + c; if (L >= nwg) return false;
    int wgid = (int)L; { const int q = nwg / NXCD, r = nwg % NXCD, xcd = wgid % NXCD, off = wgid / NXCD; wgid = (xcd < r ? xcd * (q + 1) : r * (q + 1) + (xcd - r) * q) + off; }
    const int nig = WGM * nN, gid = wgid / nig, fm = gid * WGM, gsz = (nM - fm) < WGM ? (nM - fm) : WGM;
    pm = fm + ((wgid % nig) % gsz); pn = (wgid % nig) / gsz; return true;
}

template <class P>
__device__ __forceinline__ void gemm_phase(LAS unsigned char* lds, const P& S) {
    const int tid = threadIdx.x, wid = __builtin_amdgcn_readfirstlane(tid >> 6), lane = tid & 63, wr = wid >> 2, wc = wid & 3, fr = lane & 15, fq = lane >> 4;
    const int K = S.K, nt = K / BK;
    int sR[2], sC[2]; unsigned voffB[2];
#pragma unroll
    for (int i = 0; i < 2; ++i) { int R, C; stage_rc(tid * 16 + i * 8192, R, C); sR[i] = R; sC[i] = C; const int Rb = P::PERM ? ((R & ~31) + perm32(R & 31)) : R; voffB[i] = (unsigned)(Rb * K + C) * 2u; }
    const size_t kstep = (size_t)(BK * 2);
    const size_t hstepB = (size_t)HALF * K * 2;
    const unsigned ldsw = (unsigned)wid * 1024u;
    const int aoff = lds_byte(wr * 64 + fr, fq * 8), boff = lds_byte(wc * 32 + fr, fq * 8);
#define PG8_SA(b, h) (((b) * 2 + (h)) * HTB)
#define PG8_SB(b, h) ((4 + (b) * 2 + (h)) * HTB)
#define PG8_STAGE(bufoff, gbase, voff) do { _Pragma("unroll") for (int _i = 0; _i < 2; ++_i) \
        __builtin_amdgcn_global_load_lds((const unsigned*)((const char*)(gbase) + (voff)[_i]), (LAS unsigned*)(lds + (bufoff) + ldsw + _i * 8192), 16, 0, 0); } while (0)
#define PG8_LDA(dst, b, h) do { _Pragma("unroll") for (int m = 0; m < 4; ++m) _Pragma("unroll") for (int k = 0; k < 2; ++k) dst[m][k] = *(const LAS bf16x8*)(lds + PG8_SA(b, h) + aoff + m * 2048 + k * 1024); } while (0)
#define PG8_LDB(dst, b, h) do { _Pragma("unroll") for (int n = 0; n < 2; ++n) _Pragma("unroll") for (int k = 0; k < 2; ++k) dst[n][k] = *(const LAS bf16x8*)(lds + PG8_SB(b, h) + boff + n * 2048 + k * 1024); } while (0)
#define PG8_MMA(ai, bj, At, Bt) do { __builtin_amdgcn_s_setprio(1); _Pragma("unroll") for (int m = 0; m < 4; ++m) _Pragma("unroll") for (int n = 0; n < 2; ++n) _Pragma("unroll") for (int k = 0; k < 2; ++k) \
        acc[ai][bj][m][n] = __builtin_amdgcn_mfma_f32_16x16x32_bf16(Bt[n][k], At[m][k], acc[ai][bj][m][n], 0, 0, 0); __builtin_amdgcn_s_setprio(0); } while (0)
#define PG8_WAIT_V(n) asm volatile("s_waitcnt vmcnt(" #n ")" ::: "memory")
#define PG8_WAIT_L(n) asm volatile("s_waitcnt lgkmcnt(" #n ")" ::: "memory")
#define PG8_BAR __builtin_amdgcn_s_barrier()
#define PG8_SCHED __builtin_amdgcn_sched_barrier(0)
    Unit cur, nxt; int ui = 0;
    if (!S.next(0, cur)) return;
    f32x4 acc[2][2][4][2];
#pragma unroll
    for (int a = 0; a < 2; ++a)
#pragma unroll
        for (int b = 0; b < 2; ++b)
#pragma unroll
            for (int m = 0; m < 4; ++m)
#pragma unroll
                for (int n = 0; n < 2; ++n) acc[a][b][m][n] = (f32x4){0.f, 0.f, 0.f, 0.f};
    bf16x8 At[4][2], B0[2][2], B1[2][2];
    unsigned vAc[2][2], vAn[2][2];
    S.a_voff(cur, sR, sC, vAc);
    const char* cA = S.a_base(cur); const char* cB = S.b_base(cur);
    PG8_STAGE(PG8_SB(0, 0), cB, voffB); PG8_STAGE(PG8_SB(0, 1), cB + hstepB, voffB); PG8_STAGE(PG8_SA(0, 0), cA, vAc[0]); PG8_STAGE(PG8_SA(0, 1), cA, vAc[1]);
    if (wr == 1) PG8_BAR;
    PG8_WAIT_V(2); PG8_BAR;
    PG8_STAGE(PG8_SB(1, 0), cB + kstep, voffB); PG8_STAGE(PG8_SA(1, 0), cA + kstep, vAc[0]); PG8_STAGE(PG8_SB(1, 1), cB + hstepB + kstep, voffB);
    PG8_WAIT_V(6); PG8_BAR;
    for (;;) {
        const bool has_next = S.next(ui + 1, nxt);
        const char* nA = has_next ? S.a_base(nxt) : cA; const char* nB = has_next ? S.b_base(nxt) : cB;
        if (has_next) S.a_voff(nxt, sR, sC, vAn); else { vAn[0][0] = vAc[0][0]; vAn[0][1] = vAc[0][1]; vAn[1][0] = vAc[1][0]; vAn[1][1] = vAc[1][1]; }
        for (int t = 0; t < nt; t += 2) {
            const bool last = (t == nt - 2);
            const char* a1 = cA + (size_t)(t + 1) * kstep;
            const char* a2 = last ? nA : cA + (size_t)(t + 2) * kstep; const char* b2 = last ? nB : cB + (size_t)(t + 2) * kstep;
            const char* a3 = a2 + kstep; const char* b3 = b2 + kstep;
            unsigned v2[2][2];
            v2[0][0] = last ? vAn[0][0] : vAc[0][0]; v2[0][1] = last ? vAn[0][1] : vAc[0][1]; v2[1][0] = last ? vAn[1][0] : vAc[1][0]; v2[1][1] = last ? vAn[1][1] : vAc[1][1];
            PG8_LDB(B0, 0, 0); PG8_LDB(B1, 0, 1); PG8_SCHED; PG8_LDA(At, 0, 0); PG8_STAGE(PG8_SA(1, 1), a1, vAc[1]);
            PG8_WAIT_V(8); PG8_WAIT_L(0); PG8_BAR; PG8_MMA(0, 0, At, B0); PG8_MMA(0, 1, At, B1); PG8_BAR; PG8_SCHED;
            PG8_LDA(At, 0, 1); PG8_STAGE(PG8_SB(0, 0), b2, voffB); PG8_STAGE(PG8_SB(0, 1), b2 + hstepB, voffB); PG8_STAGE(PG8_SA(0, 0), a2, v2[0]);
            PG8_WAIT_V(8); PG8_WAIT_L(0); PG8_BAR; PG8_MMA(1, 0, At, B0); PG8_MMA(1, 1, At, B1); PG8_BAR; PG8_SCHED;
            PG8_LDB(B0, 1, 0); PG8_LDB(B1, 1, 1); PG8_SCHED; PG8_LDA(At, 1, 0); PG8_STAGE(PG8_SA(0, 1), a2, v2[1]);
            PG8_WAIT_V(8); PG8_WAIT_L(0); PG8_BAR; PG8_MMA(0, 0, At, B0); PG8_MMA(0, 1, At, B1); PG8_BAR; PG8_SCHED;
            PG8_LDA(At, 1, 1); PG8_STAGE(PG8_SB(1, 0), b3, voffB); PG8_STAGE(PG8_SB(1, 1), b3 + hstepB, voffB); PG8_STAGE(PG8_SA(1, 0), a3, v2[0]);
            PG8_WAIT_V(8); PG8_WAIT_L(0); PG8_BAR; PG8_MMA(1, 0, At, B0); PG8_MMA(1, 1, At, B1); PG8_BAR; PG8_SCHED;
        }
        if (wr == 0) PG8_BAR;
        S.epi(acc, cur, wr, wc, fr, fq);
        if (!has_next) break;
#pragma unroll
        for (int a = 0; a < 2; ++a)
#pragma unroll
            for (int b = 0; b < 2; ++b)
#pragma unroll
                for (int m = 0; m < 4; ++m)
#pragma unroll
                    for (int n = 0; n < 2; ++n) acc[a][b][m][n] = (f32x4){0.f, 0.f, 0.f, 0.f};
        cur = nxt; cA = nA; cB = nB; ++ui;
        vAc[0][0] = vAn[0][0]; vAc[0][1] = vAn[0][1]; vAc[1][0] = vAn[1][0]; vAc[1][1] = vAn[1][1];
        if (wr == 1) PG8_BAR;
    }
    PG8_WAIT_V(0);
    PG8_BAR;
#undef PG8_SA
#undef PG8_SB
#undef PG8_STAGE
#undef PG8_LDA
#undef PG8_LDB
#undef PG8_MMA
#undef PG8_WAIT_V
#undef PG8_WAIT_L
#undef PG8_BAR
#undef PG8_SCHED
}
}

struct Frame {
    LAS unsigned char* lds;
    volatile LAS unsigned* MISC;
    gu32* ctl;
    int tid, lane, wave, vcu, G;
    const float* in[26]; float* out; unsigned char* ws;
};
struct Args { const float* in[26]; float* out; unsigned char* ws; int ph_lo, ph_hi; };

__device__ __forceinline__ float wave_sum(float v) {
#pragma unroll
    for (int o = 1; o < 64; o <<= 1) v += __shfl_xor(v, o);
    return v;
}

__device__ __forceinline__ void p0_transpose_item(const float* W, int Ksrc, int N, bf16_t* WT, int dst_row0, LAS float* scr, int k0, int n0, int lane) {
#pragma unroll 8
    for (int i = 0; i < 32; ++i) { const int kk = 2 * i + (lane >> 5); scr[kk * 33 + (lane & 31)] = W[(size_t)(k0 + kk) * N + n0 + (lane & 31)]; }
    LDS_WAIT(); asm volatile("" ::: "memory");
    const int c = lane & 7;
#pragma unroll
    for (int j = 0; j < 4; ++j) { const int n = (lane >> 3) + 8 * j; const LAS float* s = scr + (8 * c) * 33 + n;
        u32x4 o; o.x = pk2(s[0 * 33], s[1 * 33]); o.y = pk2(s[2 * 33], s[3 * 33]); o.z = pk2(s[4 * 33], s[5 * 33]); o.w = pk2(s[6 * 33], s[7 * 33]);
        *(GAS u32x4*)(WT + (size_t)(dst_row0 + n) * Ksrc + k0 + 8 * c) = o; }
    LDS_WAIT(); asm volatile("" ::: "memory");
}
__host__ __device__ __forceinline__ int map_in(int n) { return n < 512 ? 256 * (n >> 7) + (n & 127) : (n < 1024 ? 256 * ((n - 512) >> 7) + 128 + ((n - 512) & 127) : n); }

__device__ __forceinline__ void p0_prologue(Frame& F) {
    const float* c = F.in[1]; const float* w_ada = F.in[2]; const float* b_ada = F.in[3];
    {
        LAS float* cact = (LAS float*)(F.lds + RING_OFF);
        LAS float* red = (LAS float*)(F.lds + RING_OFF + 32768);
        for (int i = F.tid; i < NBATCH * DM; i += 512) { const float v = c[i]; cact[i] = v / (1.f + __expf(-v)); }
        __syncthreads();
        float* mod = (float*)(F.ws + WS_MOD);
        for (int cg = blockIdx.x; cg < 256; cg += F.G) {
            const int j0 = cg * 24, ks = F.tid >> 5, jj = F.tid & 31;
            float a[8] = {0.f, 0.f, 0.f, 0.f, 0.f, 0.f, 0.f, 0.f};
            if (jj < 24) {
                for (int k = ks * 64; k < ks * 64 + 64; ++k) { const float w = w_ada[(size_t)k * 6 * DM + j0 + jj];
#pragma unroll
                    for (int b = 0; b < 8; ++b) a[b] += cact[b * DM + k] * w; }
            }
#pragma unroll
            for (int b = 0; b < 8; ++b) red[(ks * 8 + b) * 32 + jj] = a[b];
            __syncthreads();
            if (F.tid < 8 * 24) { const int b = F.tid / 24, j = F.tid % 24; float s = 0.f;
                for (int q = 0; q < 16; ++q) s += red[(q * 8 + b) * 32 + j];
                mod[b * 6 * DM + j0 + j] = s + b_ada[j0 + j]; }
            __syncthreads();
        }
    }
    {
        const int gt = blockIdx.x * 512 + F.tid, NT = F.G * 512;
        float* bperm = (float*)(F.ws + WS_BPERM); const float* b_in = F.in[5];
        for (int n = gt; n < DIN; n += NT) bperm[map_in(n)] = b_in[n];
        bf16_t* wr_hi = (bf16_t*)(F.ws + WS_WR); bf16_t* wr_lo = wr_hi + 48 * DM;
        const float* wrg = F.in[17]; const float* wre = F.in[19];
        for (int i = gt; i < 48 * DM; i += NT) { const int j = i / DM, k = i % DM; float v = 0.f;
            if (j < 4) v = wrg[k * NG + j]; else if (j < 36) v = wre[k * NE + (j - 4)];
            const unsigned h = f2bf(v); const float r = v - bf2f((unsigned short)h); wr_hi[i] = (bf16_t)h; wr_lo[i] = (bf16_t)f2bf(r); }
    }
    {
        LAS float* scr = (LAS float*)(F.lds + RING_OFF + F.wave * 16384);
        const int gw = F.vcu * NWAVES + F.wave, NGW = F.G * NWAVES;
        constexpr int I_IN = 16 * 56, I_OUT = 16 * 32, I_G = 16 * 8, I_D = 4 * 32, I_E = 2 * I_G + I_D;
        constexpr int NITEMS = I_IN + I_OUT + NE * I_E;
        bf16_t* WI = (bf16_t*)(F.ws + WS_WI); bf16_t* WO = (bf16_t*)(F.ws + WS_WO); bf16_t* WGU = (bf16_t*)(F.ws + WS_WGU); bf16_t* WD = (bf16_t*)(F.ws + WS_WD);
        for (int it = gw; it < NITEMS; it += NGW) {
            int r = it;
            if (r < I_IN) { const int kb = r / 56, nb = r % 56; p0_transpose_item(F.in[4], DM, DIN, WI, map_in(32 * nb), scr, 64 * kb, 32 * nb, F.lane); continue; } r -= I_IN;
            if (r < I_OUT) { const int kb = r / 32, nb = r % 32; p0_transpose_item(F.in[13], DM, DM, WO, 32 * nb, scr, 64 * kb, 32 * nb, F.lane); continue; } r -= I_OUT;
            const int e = r / I_E; r -= e * I_E;
            if (r < I_G) { const int kb = r / 8, nb = r % 8, n0 = 32 * nb; p0_transpose_item(F.in[21] + (size_t)e * DM * DE, DM, DE, WGU + (size_t)e * 512 * DM, 256 * (n0 >> 7) + (n0 & 127), scr, 64 * kb, n0, F.lane); continue; } r -= I_G;
            if (r < I_G) { const int kb = r / 8, nb = r % 8, n0 = 32 * nb; p0_transpose_item(F.in[22] + (size_t)e * DM * DE, DM, DE, WGU + (size_t)e * 512 * DM, 256 * (n0 >> 7) + 128 + (n0 & 127), scr, 64 * kb, n0, F.lane); continue; } r -= I_G;
            { const int kb = r / 32, nb = r % 32; p0_transpose_item(F.in[23] + (size_t)e * DE * DM, DE, DM, WD + (size_t)e * DM * DE, 32 * nb, scr, 64 * kb, 32 * nb, F.lane); }
        }
    }
}

__device__ __forceinline__ void p1_modulate(Frame& F) {
    const float* x = F.in[0]; const float* mod = (const float*)(F.ws + WS_MOD); bf16_t* H = (bf16_t*)(F.ws + WS_H);
    const int cv = F.tid & 127, rsub = F.tid >> 7, col = cv * 8;
    for (int r0 = blockIdx.x * 16; r0 < T; r0 += F.G * 16) {
        const int b = r0 / SEQ; const float* mb = mod + b * 6 * DM;
        const f32x4 s0 = *(const f32x4*)(mb + DM + col) + 1.f, s1 = *(const f32x4*)(mb + DM + col + 4) + 1.f, h0 = *(const f32x4*)(mb + col), h1 = *(const f32x4*)(mb + col + 4);
        f32x4 xa[4], xb[4];
#pragma unroll
        for (int i = 0; i < 4; ++i) { const size_t e0 = (size_t)(r0 + rsub + 4 * i) * DM + col; xa[i] = *(const f32x4*)(x + e0); xb[i] = *(const f32x4*)(x + e0 + 4); }
#pragma unroll
        for (int i = 0; i < 4; ++i) { const size_t e0 = (size_t)(r0 + rsub + 4 * i) * DM + col; const f32x4 y0 = xa[i] * s0 + h0, y1 = xb[i] * s1 + h1;
            u32x4 o; o.x = pk2(y0[0], y0[1]); o.y = pk2(y0[2], y0[3]); o.z = pk2(y1[0], y1[1]); o.w = pk2(y1[2], y1[3]);
            *(u32x4*)(H + e0) = o; }
    }
}

struct InProj {
    static constexpr bool PERM = true;
    int K, G, c; const bf16_t* A; const bf16_t* Bt; const float* bias; bf16_t* VG; bf16_t* Q; bf16_t* KV;
    __device__ __forceinline__ bool next(int i, pg8::Unit& u) const { u.e = 0; return pg8::static_next(i, G, c, T / 256, DIN / 256, u.pm, u.pn); }
    __device__ __forceinline__ const char* a_base(const pg8::Unit& u) const { return (const char*)A + (size_t)u.pm * 256 * K * 2; }
    __device__ __forceinline__ const char* b_base(const pg8::Unit& u) const { return (const char*)Bt + (size_t)u.pn * 256 * K * 2; }
    __device__ __forceinline__ void a_voff(const pg8::Unit&, const int (&R)[2], const int (&C)[2], unsigned (&v)[2][2]) const {
#pragma unroll
        for (int i = 0; i < 2; ++i) { v[0][i] = (unsigned)(R[i] * K + C[i]) * 2u; v[1][i] = v[0][i] + (unsigned)(128 * K * 2); } }
    __device__ __forceinline__ void epi(const f32x4 (&acc)[2][2][4][2], const pg8::Unit& u, int wr, int wc, int fr, int fq) const {
        const int row0 = u.pm * 256 + wr * 64 + fr; const int bcol0 = u.pn * 256 + wc * 32 + 8 * fq;
        f32x4 bv[2][2];
#pragma unroll
        for (int bj = 0; bj < 2; ++bj)
#pragma unroll
            for (int n = 0; n < 2; ++n) bv[bj][n] = *(const f32x4*)(bias + bcol0 + bj * 128 + 4 * n);
        if (u.pn < 4) {
            bf16_t* base = VG + u.pn * 128 + wc * 32 + 8 * fq;
#pragma unroll
            for (int ai = 0; ai < 2; ++ai)
#pragma unroll
                for (int m = 0; m < 4; ++m) { bf16_t* rowp = base + (size_t)(row0 + ai * 128 + m * 16) * DCONV;
                    f32x4 a0 = acc[ai][0][m][0] + bv[0][0], a1 = acc[ai][0][m][1] + bv[0][1], g0 = acc[ai][1][m][0] + bv[1][0], g1 = acc[ai][1][m][1] + bv[1][1];
#pragma unroll
                    for (int j = 0; j < 4; ++j) { a0[j] *= fast_sigmoid(g0[j]); a1[j] *= fast_sigmoid(g1[j]); }
                    u32x4 w; w.x = cvt_pk_bf16(a0[0], a0[1]); w.y = cvt_pk_bf16(a0[2], a0[3]); w.z = cvt_pk_bf16(a1[0], a1[1]); w.w = cvt_pk_bf16(a1[2], a1[3]);
                    *(u32x4*)rowp = w; }
        } else {
            const bool isq = u.pn < 6; const float sc = isq ? QSCALE : 1.f; const int ldc = isq ? DATTN : 2 * DKV;
            bf16_t* base = (isq ? Q + (u.pn - 4) * 256 : KV) + wc * 32 + 8 * fq;
#pragma unroll
            for (int ai = 0; ai < 2; ++ai)
#pragma unroll
                for (int m = 0; m < 4; ++m) { bf16_t* rowp = base + (size_t)(row0 + ai * 128 + m * 16) * ldc;
#pragma unroll
                    for (int bj = 0; bj < 2; ++bj) { const f32x4 v0 = (acc[ai][bj][m][0] + bv[bj][0]) * sc, v1 = (acc[ai][bj][m][1] + bv[bj][1]) * sc;
                        u32x4 w; w.x = cvt_pk_bf16(v0[0], v0[1]); w.y = cvt_pk_bf16(v0[2], v0[3]); w.z = cvt_pk_bf16(v1[0], v1[1]); w.w = cvt_pk_bf16(v1[2], v1[3]);
                        *(u32x4*)(rowp + bj * 128) = w; } }
        }
    }
};


template <int R> __device__ __forceinline__ void conv_rows(float (&acc)[32], const float (&w)[31], const float (&vin)[62]) {
    if constexpr (R < 62) {
#pragma unroll
        for (int j = 0; j < 31; ++j) { const int o = R - j; if (o >= 0 && o < 32) acc[o] += w[j] * vin[R]; }
        conv_rows<R + 1>(acc, w, vin);
    }
}
__device__ __forceinline__ void conv_unit(Frame& F, int t0) {
    const bf16_t* VG = (const bf16_t*)(F.ws + WS_VG);
    const float* conv_w = F.in[6]; const float* conv_b = F.in[7]; const float* lng = F.in[8]; const float* lnb = F.in[9]; const float* outg = F.in[10];
    bf16_t* Y = (bf16_t*)(F.ws + WS_H);
    LAS float* tile = (LAS float*)(F.lds + RING_OFF);
    const int c = F.tid; const int s0 = t0 % SEQ; const int tb = t0 - s0;
    float w[31];
#pragma unroll
    for (int j = 0; j < 31; ++j) w[j] = conv_w[j * DCONV + c];
    float acc[32]; { const float cb = conv_b[c];
#pragma unroll
        for (int o = 0; o < 32; ++o) acc[o] = cb; }
    float vin[62];
#pragma unroll
    for (int r = 0; r < 62; ++r) { const int ss = s0 - 30 + r; const int tr = tb + (ss < 0 ? 0 : ss); const float v = bf2f(VG[(size_t)tr * DCONV + c]); vin[r] = ss < 0 ? 0.f : v; }
    conv_rows<0>(acc, w, vin);
#pragma unroll
    for (int o = 0; o < 32; ++o) tile[o * 516 + c] = acc[o];
    __syncthreads();
    {
        const int c8 = F.lane * 8;
        const f32x4 g0 = *(const f32x4*)(lng + c8), g1 = *(const f32x4*)(lng + c8 + 4), b0 = *(const f32x4*)(lnb + c8), b1 = *(const f32x4*)(lnb + c8 + 4), og0 = *(const f32x4*)(outg + c8), og1 = *(const f32x4*)(outg + c8 + 4);
#pragma unroll
        for (int i = 0; i < 4; ++i) { const int o = F.wave * 4 + i;
            f32x4 v0 = *(const LAS f32x4*)(tile + o * 516 + c8), v1 = *(const LAS f32x4*)(tile + o * 516 + c8 + 4);
            const float mean = wave_sum((v0[0] + v0[1]) + (v0[2] + v0[3]) + (v1[0] + v1[1]) + (v1[2] + v1[3])) * (1.f / DCONV);
            v0 = v0 - mean; v1 = v1 - mean;
            const float var = wave_sum((v0[0] * v0[0] + v0[1] * v0[1]) + (v0[2] * v0[2] + v0[3] * v0[3]) + (v1[0] * v1[0] + v1[1] * v1[1]) + (v1[2] * v1[2] + v1[3] * v1[3])) * (1.f / DCONV);
            const float rstd = rsqrtf(var + EPS);
            v0 = v0 * rstd * g0 + b0; v1 = v1 * rstd * g1 + b1;
            float q = 0.f;
#pragma unroll
            for (int j = 0; j < 4; ++j) { v0[j] = fast_silu(v0[j]); v1[j] = fast_silu(v1[j]); q += v0[j] * v0[j] + v1[j] * v1[j]; }
            q += __shfl_xor(q, 1); q += __shfl_xor(q, 2); q += __shfl_xor(q, 4);
            const float r2 = rsqrtf(q * (1.f / 64.f) + EPS);
            v0 = v0 * r2 * og0; v1 = v1 * r2 * og1;
            u32x4 ow; ow.x = pk2(v0[0], v0[1]); ow.y = pk2(v0[2], v0[3]); ow.z = pk2(v1[0], v1[1]); ow.w = pk2(v1[2], v1[3]);
            *(u32x4*)(Y + (size_t)(t0 + o) * DM + c8) = ow; }
    }
    __syncthreads();
}

namespace att {
constexpr int KCH = 4112;
constexpr int L_K = 0, L_V = 8 * KCH, L_O = L_V + 32768, OST = 8704, L_WS = L_O + 8 * OST, L_END = L_WS + 8 * 128;
static_assert(L_END <= RING_BYTES, "attention LDS");
typedef short s16x4 __attribute__((ext_vector_type(4)));
typedef float f32x16 __attribute__((ext_vector_type(16)));
typedef short v4i16_t __attribute__((ext_vector_type(4)));
__device__ __forceinline__ int crow(int r, int hi) { return (r & 3) + 8 * (r >> 2) + 4 * hi; }
__device__ __forceinline__ s16x4 vtr(const LAS unsigned char* p) { return __builtin_bit_cast(s16x4, __builtin_amdgcn_ds_read_tr16_b64_v4i16((LAS v4i16_t*)p)); }

__device__ __forceinline__ void attn_unit(Frame& F, int b, int kvh, int blk) {
    const bf16_t* Q = (const bf16_t*)(F.ws + WS_Q); const bf16_t* KV = (const bf16_t*)(F.ws + WS_KV); bf16_t* Y = (bf16_t*)(F.ws + WS_H);
    const float* sinks = F.in[11]; const float* outg = F.in[12];
    LAS unsigned char* lds = F.lds + RING_OFF;
    const int lane = F.lane, r32 = lane & 31, hi = lane >> 5, wave = F.wave;
    const int t0 = b * SEQ + blk * 128;
    bf16x8 qrr[2][4];
#pragma unroll
    for (int wi = 0; wi < 2; ++wi) { const int wu = wave + 8 * wi, hq = wu >> 2, sub = wu & 3;
        const bf16_t* qrow = Q + (size_t)(t0 + 32 * sub + r32) * DATTN + (kvh * 4 + hq) * 64 + hi * 8;
#pragma unroll
        for (int s = 0; s < 4; ++s) qrr[wi][s] = *(const bf16x8*)(qrow + 16 * s); }
    {
        u32x4 kq[4], vq[4];
#pragma unroll
        for (int i = 0; i < 4; ++i) { const int p = F.tid + 512 * i, key = p >> 3, ch = p & 7; const bool valid = (blk > 0) || key >= 128;
            const int tk = valid ? t0 - 128 + key : t0;
            const bf16_t* gk = KV + (size_t)tk * 256 + kvh * 64 + ch * 8;
            kq[i] = *(const u32x4*)gk; vq[i] = *(const u32x4*)(gk + 128);
            if (!valid) { kq[i] = (u32x4){0u, 0u, 0u, 0u}; vq[i] = kq[i]; } }
#pragma unroll
        for (int i = 0; i < 4; ++i) { const int p = F.tid + 512 * i, key = p >> 3, ch = p & 7;
            *(LAS u32x4*)(lds + L_K + ch * KCH + key * 16) = kq[i];
            *(LAS u32x4*)(lds + L_V + (key >> 6) * 8192 + ((ch >> 2) * 4 + ((key & 63) >> 4)) * 1024 + (key & 15) * 64 + (ch & 3) * 16) = vq[i]; }
    }
    __syncthreads();
    const int vlane = (4 * hi + ((lane & 15) >> 2)) * 64 + ((lane >> 4) & 1) * 32 + (lane & 3) * 8;
#pragma unroll
    for (int wi = 0; wi < 2; ++wi) {
        const int wu = wave + 8 * wi, hq = wu >> 2, sub = wu & 3, i0 = 32 * sub, h = kvh * 4 + hq;
        bf16x8 qr[4];
#pragma unroll
        for (int s = 0; s < 4; ++s) qr[s] = qrr[wi][s];
        f32x16 st[5];
#pragma unroll
        for (int t = 0; t < 5; ++t) {
#pragma unroll
            for (int r = 0; r < 16; ++r) st[t][r] = 0.f;
#pragma unroll
            for (int s = 0; s < 4; ++s) { const bf16x8 kf = *(const LAS bf16x8*)(lds + L_K + (2 * s + hi) * KCH + (i0 + 32 * t + r32) * 16);
                st[t] = __builtin_amdgcn_mfma_f32_32x32x16_bf16(kf, qr[s], st[t], 0, 0, 0); } }
        const float sinkl = sinks[h] * LOG2E;
        float m = sinkl;
#pragma unroll
        for (int t = 0; t < 5; ++t)
#pragma unroll
            for (int r = 0; r < 16; ++r) { const int cj = crow(r, hi); bool ok = true;
                if (t == 0) ok = cj >= r32 + 1; if (t == 4) ok = cj <= r32;
                if (blk == 0) ok = ok && (i0 + 32 * t + cj >= 128);
                const float v = ok ? st[t][r] : -1e30f; st[t][r] = v; m = fmaxf(m, v); }
        m = fmaxf(m, __shfl_xor(m, 32));
        float l = 0.f;
#pragma unroll
        for (int t = 0; t < 5; ++t)
#pragma unroll
            for (int r = 0; r < 16; ++r) { const float pv = __builtin_amdgcn_exp2f(st[t][r] - m); st[t][r] = pv; l += pv; }
        l += __shfl_xor(l, 32); l += __builtin_amdgcn_exp2f(sinkl - m);
        f32x16 o[2];
#pragma unroll
        for (int r = 0; r < 16; ++r) { o[0][r] = 0.f; o[1][r] = 0.f; }
#pragma unroll
        for (int t = 0; t < 5; ++t)
#pragma unroll
            for (int s2 = 0; s2 < 2; ++s2) {
                u32x4 pw; pw.x = cvt_pk_bf16(st[t][8 * s2 + 0], st[t][8 * s2 + 1]); pw.y = cvt_pk_bf16(st[t][8 * s2 + 2], st[t][8 * s2 + 3]); pw.z = cvt_pk_bf16(st[t][8 * s2 + 4], st[t][8 * s2 + 5]); pw.w = cvt_pk_bf16(st[t][8 * s2 + 6], st[t][8 * s2 + 7]);
                const bf16x8 pa = __builtin_bit_cast(bf16x8, pw);
                const int kk0 = i0 + 32 * t + 16 * s2, g = kk0 >> 6, pc = (kk0 & 63) >> 4;
#pragma unroll
                for (int d0 = 0; d0 < 2; ++d0) { const LAS unsigned char* vb = lds + L_V + g * 8192 + (d0 * 4 + pc) * 1024 + vlane;
                    const s16x4 lo = vtr(vb), hh = vtr(vb + 512);
                    const bf16x8 vf = (bf16x8){lo[0], lo[1], lo[2], lo[3], hh[0], hh[1], hh[2], hh[3]};
                    o[d0] = __builtin_amdgcn_mfma_f32_32x32x16_bf16(pa, vf, o[d0], 0, 0, 0); } }
        LAS float* wsf = (LAS float*)(lds + L_WS + wave * 128);
        LAS float* ost = (LAS float*)(lds + L_O + wave * OST);
        if (hi == 0) wsf[r32] = l;
#pragma unroll
        for (int r = 0; r < 16; ++r) { const int q = crow(r, hi); ost[q * 68 + r32] = o[0][r]; ost[q * 68 + 32 + r32] = o[1][r]; }
        LDS_WAIT(); asm volatile("" ::: "memory");
        { const int q = lane >> 1, half = lane & 1; const float rl = 1.f / wsf[q];
          f32x4 v[8]; float ss = 0.f;
#pragma unroll
          for (int j = 0; j < 8; ++j) { v[j] = *(const LAS f32x4*)(ost + q * 68 + half * 32 + 4 * j) * rl; ss += (v[j][0] * v[j][0] + v[j][1] * v[j][1]) + (v[j][2] * v[j][2] + v[j][3] * v[j][3]); }
          ss += __shfl_xor(ss, 1);
          const float rr = rsqrtf(ss * (1.f / 64.f) + EPS);
          const float* gp = outg + h * 64 + half * 32; bf16_t* yp = Y + (size_t)(t0 + i0 + q) * DM + DCONV + h * 64 + half * 32;
#pragma unroll
          for (int j = 0; j < 4; ++j) { const f32x4 a = v[2 * j] * rr * *(const f32x4*)(gp + 8 * j), c2 = v[2 * j + 1] * rr * *(const f32x4*)(gp + 8 * j + 4);
              u32x4 ow; ow.x = pk2(a[0], a[1]); ow.y = pk2(a[2], a[3]); ow.z = pk2(c2[0], c2[1]); ow.w = pk2(c2[2], c2[3]);
              *(u32x4*)(yp + 8 * j) = ow; } }
        LDS_WAIT(); asm volatile("" ::: "memory");
    }
    __syncthreads();
}
}

__device__ __forceinline__ void p3_attn_only(Frame& F) {
    for (int u = blockIdx.x; u < NBATCH * NKV * (SEQ / 128); u += F.G) { const int blk = u & 31, kvh = (u >> 5) & 1, b = u >> 6; att::attn_unit(F, b, kvh, blk); }
}
__device__ __forceinline__ void p3_conv_only(Frame& F) {
    for (int u = blockIdx.x; u < T / 32; u += F.G) conv_unit(F, 32 * u);
}
__device__ __forceinline__ void p3_mixers(Frame& F) {
#ifndef SKIP_ATTN
    for (int u = blockIdx.x; u < NBATCH * NKV * (SEQ / 128); u += F.G) { const int blk = u & 31, kvh = (u >> 5) & 1, b = u >> 6; att::attn_unit(F, b, kvh, blk); }
#endif
#ifndef SKIP_CONV
    for (int u = blockIdx.x; u < T / 32; u += F.G) conv_unit(F, 32 * u);
#endif
}

struct OutProj {
    static constexpr bool PERM = false;
    int K, G, c; const bf16_t* A; const bf16_t* Bt; const float* x; const float* mod; const float* bo; float* Z; f32x2* stats;
    __device__ __forceinline__ bool next(int i, pg8::Unit& u) const { u.e = 0; return pg8::static_next(i, G, c, T / 256, DM / 256, u.pm, u.pn); }
    __device__ __forceinline__ const char* a_base(const pg8::Unit& u) const { return (const char*)A + (size_t)u.pm * 256 * K * 2; }
    __device__ __forceinline__ const char* b_base(const pg8::Unit& u) const { return (const char*)Bt + (size_t)u.pn * 256 * K * 2; }
    __device__ __forceinline__ void a_voff(const pg8::Unit&, const int (&R)[2], const int (&C)[2], unsigned (&v)[2][2]) const {
#pragma unroll
        for (int i = 0; i < 2; ++i) { v[0][i] = (unsigned)(R[i] * K + C[i]) * 2u; v[1][i] = v[0][i] + (unsigned)(128 * K * 2); } }
    __device__ __forceinline__ void epi(const f32x4 (&acc)[2][2][4][2], const pg8::Unit& u, int wr, int wc, int fr, int fq) const {
        const int b = (u.pm * 256) / SEQ; const float* g1 = mod + b * 6 * DM + 2 * DM;
        const int col0 = u.pn * 256 + wc * 32 + 4 * fq;
        f32x4 gv[2][2], bv[2][2];
#pragma unroll
        for (int bj = 0; bj < 2; ++bj)
#pragma unroll
            for (int n = 0; n < 2; ++n) { gv[bj][n] = *(const f32x4*)(g1 + col0 + bj * 128 + n * 16); bv[bj][n] = *(const f32x4*)(bo + col0 + bj * 128 + n * 16); }
        f32x4 xc[2][2], xn[2][2];
        { const size_t off = (size_t)(u.pm * 256 + wr * 64 + fr) * DM + col0;
#pragma unroll
          for (int bj = 0; bj < 2; ++bj)
#pragma unroll
              for (int n = 0; n < 2; ++n) xc[bj][n] = *(const f32x4*)(x + off + bj * 128 + n * 16); }
#pragma unroll
        for (int gi = 0; gi < 8; ++gi) { const int ai = gi >> 2, m = gi & 3;
            const int row = u.pm * 256 + ai * 128 + wr * 64 + m * 16 + fr; const size_t off = (size_t)row * DM + col0; float s = 0.f, q = 0.f;
            if (gi < 7) { const int ai2 = (gi + 1) >> 2, m2 = (gi + 1) & 3; const size_t off2 = (size_t)(u.pm * 256 + ai2 * 128 + wr * 64 + m2 * 16 + fr) * DM + col0;
#pragma unroll
                for (int bj = 0; bj < 2; ++bj)
#pragma unroll
                    for (int n = 0; n < 2; ++n) xn[bj][n] = *(const f32x4*)(x + off2 + bj * 128 + n * 16); }
#pragma unroll
            for (int bj = 0; bj < 2; ++bj)
#pragma unroll
                for (int n = 0; n < 2; ++n) { const f32x4 z = xc[bj][n] * ALPHA + gv[bj][n] * (acc[ai][bj][m][n] + bv[bj][n]);
                    *(f32x4*)(Z + off + bj * 128 + n * 16) = z; s += (z[0] + z[1]) + (z[2] + z[3]); q += (z[0] * z[0] + z[1] * z[1]) + (z[2] * z[2] + z[3] * z[3]); }
            s += __shfl_xor(s, 16); s += __shfl_xor(s, 32); q += __shfl_xor(q, 16); q += __shfl_xor(q, 32);
            if (fq == 0) stats[(size_t)row * 16 + u.pn * 4 + wc] = (f32x2){s, q};
#pragma unroll
            for (int bj = 0; bj < 2; ++bj)
#pragma unroll
                for (int n = 0; n < 2; ++n) xc[bj][n] = xn[bj][n];
            asm volatile("" ::: "memory"); }
    }
};

constexpr int TAB_OFF = LDSCTL_OFF + 1024;
__device__ __forceinline__ void build_route_table(Frame& F) {
    volatile LAS int* tab = (volatile LAS int*)(F.lds + TAB_OFF);
    if (F.tid == 0) { int tp = 0;
        for (int e = 0; e < NE; ++e) { const int cn = (int)__hip_atomic_load(F.ctl + CW_ECNT + 64 * e, RLX_AGENT); tab[e] = cn; tab[32 + e] = tp; tp += (cn + 255) >> 8; }
        tab[64] = tp; }
    __syncthreads();
}

__device__ __forceinline__ void p5_rows(Frame& F) {
    float* X = F.out; const f32x2* stats = (const f32x2*)(F.ws + WS_STATS); bf16_t* H2 = (bf16_t*)(F.ws + WS_H2);
    const float* ln_g = F.in[15]; const float* ln_b = F.in[16]; const float* mod = (const float*)(F.ws + WS_MOD);
    const bf16_t* wr_hi = (const bf16_t*)(F.ws + WS_WR); const bf16_t* wr_lo = wr_hi + 48 * DM;
    const float* brg = F.in[18]; const float* bre = F.in[20];
    int* list = (int*)(F.ws + WS_LIST); unsigned* tokrec = (unsigned*)(F.ws + WS_TOK);
    LAS float* lg = (LAS float*)(F.lds + RING_OFF + F.wave * 3072);
    volatile LAS int* lcnt = (volatile LAS int*)(F.lds + RING_OFF + 24576);
    const int lane = F.lane, i16 = lane & 15, kq = lane >> 4;
    for (int tile = blockIdx.x; tile < T / 128; tile += F.G) {
        if (F.tid < 64) lcnt[F.tid] = 0;
        __syncthreads();
        const int row = tile * 128 + F.wave * 16 + i16; const int b = (tile * 128) / SEQ;
        const float* sc2 = mod + b * 6 * DM + 4 * DM; const float* sh2 = mod + b * 6 * DM + 3 * DM;
        float mean, rstd;
        { const f32x4 p0 = *(const f32x4*)(stats + (size_t)row * 16 + 4 * kq), p1 = *(const f32x4*)(stats + (size_t)row * 16 + 4 * kq + 2);
          float sm = (p0[0] + p0[2]) + (p1[0] + p1[2]), sq = (p0[1] + p0[3]) + (p1[1] + p1[3]);
          sm += __shfl_xor(sm, 16); sm += __shfl_xor(sm, 32); sq += __shfl_xor(sq, 16); sq += __shfl_xor(sq, 32);
          mean = sm * (1.f / DM); rstd = rsqrtf(sq * (1.f / DM) - mean * mean + EPS); }
        f32x4 acc[3];
#pragma unroll
        for (int ct = 0; ct < 3; ++ct) acc[ct] = (f32x4){0.f, 0.f, 0.f, 0.f};
        float* xr = X + (size_t)row * DM + 8 * kq; bf16_t* hr = H2 + (size_t)row * DM + 8 * kq;
#pragma unroll 2
        for (int kc = 0; kc < DM; kc += 32) {
            const int k0 = kc + 8 * kq;
            f32x4 z0 = *(const f32x4*)(xr + kc), z1 = *(const f32x4*)(xr + kc + 4);
            const f32x4 g0 = *(const f32x4*)(ln_g + k0), g1 = *(const f32x4*)(ln_g + k0 + 4), b0 = *(const f32x4*)(ln_b + k0), b1 = *(const f32x4*)(ln_b + k0 + 4);
            const f32x4 s0 = *(const f32x4*)(sc2 + k0), s1 = *(const f32x4*)(sc2 + k0 + 4), h0 = *(const f32x4*)(sh2 + k0), h1 = *(const f32x4*)(sh2 + k0 + 4);
            z0 = (z0 - mean) * rstd * g0 + b0; z1 = (z1 - mean) * rstd * g1 + b1;
            *(f32x4*)(xr + kc) = z0; *(f32x4*)(xr + kc + 4) = z1;
            const f32x4 t0 = z0 * (s0 + 1.f) + h0, t1 = z1 * (s1 + 1.f) + h1;
            u32x4 hw; hw.x = pk2(t0[0], t0[1]); hw.y = pk2(t0[2], t0[3]); hw.z = pk2(t1[0], t1[1]); hw.w = pk2(t1[2], t1[3]);
            *(u32x4*)(hr + kc) = hw;
            u32x4 lw;
            lw.x = pk2(t0[0] - __builtin_bit_cast(float, hw.x << 16), t0[1] - __builtin_bit_cast(float, hw.x & 0xffff0000u));
            lw.y = pk2(t0[2] - __builtin_bit_cast(float, hw.y << 16), t0[3] - __builtin_bit_cast(float, hw.y & 0xffff0000u));
            lw.z = pk2(t1[0] - __builtin_bit_cast(float, hw.z << 16), t1[1] - __builtin_bit_cast(float, hw.z & 0xffff0000u));
            lw.w = pk2(t1[2] - __builtin_bit_cast(float, hw.w << 16), t1[3] - __builtin_bit_cast(float, hw.w & 0xffff0000u));
            const bf16x8 ah = __builtin_bit_cast(bf16x8, hw), al = __builtin_bit_cast(bf16x8, lw);
#pragma unroll
            for (int ct = 0; ct < 3; ++ct) { const size_t wo = (size_t)(16 * ct + i16) * DM + k0;
                const bf16x8 bh = *(const bf16x8*)(wr_hi + wo), bl = *(const bf16x8*)(wr_lo + wo);
                acc[ct] = __builtin_amdgcn_mfma_f32_16x16x32_bf16(ah, bh, acc[ct], 0, 0, 0);
                acc[ct] = __builtin_amdgcn_mfma_f32_16x16x32_bf16(ah, bl, acc[ct], 0, 0, 0);
                acc[ct] = __builtin_amdgcn_mfma_f32_16x16x32_bf16(al, bh, acc[ct], 0, 0, 0); }
        }
#pragma unroll
        for (int ct = 0; ct < 3; ++ct)
#pragma unroll
            for (int r = 0; r < 4; ++r) lg[(4 * kq + r) * 48 + 16 * ct + i16] = acc[ct][r];
        LDS_WAIT(); asm volatile("" ::: "memory");
        int e1 = 0, e2 = 0, rk1 = 0, rk2 = 0; float w1 = 0.f, w2 = 0.f;
        if (lane < 16) {
            const LAS float* L = lg + lane * 48;
            float gl[4];
#pragma unroll
            for (int j = 0; j < 4; ++j) gl[j] = L[j] + brg[j];
            int gi = 0; float gm = gl[0];
#pragma unroll
            for (int j = 1; j < 4; ++j) if (gl[j] > gm) { gm = gl[j]; gi = j; }
            float gs = 0.f;
#pragma unroll
            for (int j = 0; j < 4; ++j) gs += __expf(gl[j] - gm);
            const float ptop = 1.f / gs;
            float el[8];
#pragma unroll
            for (int j = 0; j < 8; ++j) el[j] = L[4 + gi * 8 + j] + bre[gi * 8 + j];
            int i1 = 0; float m1 = el[0];
#pragma unroll
            for (int j = 1; j < 8; ++j) if (el[j] > m1) { m1 = el[j]; i1 = j; }
            int i2 = -1; float m2 = -3e38f;
#pragma unroll
            for (int j = 0; j < 8; ++j) if (j != i1 && el[j] > m2) { m2 = el[j]; i2 = j; }
            const float pb = __expf(m2 - m1), inv = ptop / (1.f + pb);
            e1 = gi * 8 + i1; e2 = gi * 8 + i2; w1 = inv; w2 = pb * inv;
            rk1 = __hip_atomic_fetch_add((LAS int*)lcnt + e1, 1, __ATOMIC_RELAXED, __HIP_MEMORY_SCOPE_WORKGROUP);
            rk2 = __hip_atomic_fetch_add((LAS int*)lcnt + e2, 1, __ATOMIC_RELAXED, __HIP_MEMORY_SCOPE_WORKGROUP);
        }
        __syncthreads();
        if (F.tid < 32) { const int n = lcnt[F.tid]; int base = 0; if (n > 0) base = (int)__hip_atomic_fetch_add(F.ctl + CW_ECNT + 64 * F.tid, (unsigned)n, RLX_AGENT); lcnt[32 + F.tid] = base; }
        __syncthreads();
        if (lane < 16) { const int tok = tile * 128 + F.wave * 16 + lane; const int s1 = lcnt[32 + e1] + rk1, s2 = lcnt[32 + e2] + rk2;
            list[(size_t)e1 * T + s1] = tok; list[(size_t)e2 * T + s2] = tok;
            u32x4 r0; r0.x = (unsigned)e1; r0.y = (unsigned)s1; r0.z = (unsigned)e2; r0.w = (unsigned)s2;
            u32x4 r1; r1.x = __builtin_bit_cast(unsigned, w1); r1.y = __builtin_bit_cast(unsigned, w2); r1.z = 0u; r1.w = 0u;
            *(u32x4*)(tokrec + (size_t)tok * 8) = r0; *(u32x4*)(tokrec + (size_t)tok * 8 + 4) = r1; }
        __syncthreads();
    }
}

__device__ __forceinline__ bool moe_next(const volatile LAS int* tab, int i, int G, int c, int NT, pg8::Unit& u) {
    const int nwg = tab[64] * NT; const long L = (long)i * G + c; if (L >= nwg) return false;
    int wgid = (int)L; { const int q = nwg / 8, r = nwg % 8, xcd = wgid % 8, off = wgid / 8; wgid = (xcd < r ? xcd * (q + 1) : r * (q + 1) + (xcd - r) * q) + off; }
    const int mtg = wgid / NT; int e = 0;
    for (int k = 1; k < NE; ++k) e += (tab[32 + k] <= mtg) ? 1 : 0;
    u.e = __builtin_amdgcn_readfirstlane(e); u.pm = __builtin_amdgcn_readfirstlane(mtg - tab[32 + e]); u.pn = __builtin_amdgcn_readfirstlane(wgid % NT); return true;
}
struct MoeUp {
    static constexpr bool PERM = true;
    int K, G, c; const volatile LAS int* tab; const bf16_t* H2; const bf16_t* WGU; const int* list; bf16_t* ACT;
    __device__ __forceinline__ bool next(int i, pg8::Unit& u) const { return moe_next(tab, i, G, c, 2, u); }
    __device__ __forceinline__ const char* a_base(const pg8::Unit&) const { return (const char*)H2; }
    __device__ __forceinline__ const char* b_base(const pg8::Unit& u) const { return (const char*)WGU + ((size_t)u.e * 512 + u.pn * 256) * K * 2; }
    __device__ __forceinline__ void a_voff(const pg8::Unit& u, const int (&R)[2], const int (&C)[2], unsigned (&v)[2][2]) const {
        const int cn = tab[u.e]; const int* lp = list + (size_t)u.e * T;
#pragma unroll
        for (int h = 0; h < 2; ++h)
#pragma unroll
            for (int i = 0; i < 2; ++i) { const int idx = u.pm * 256 + h * 128 + R[i]; const int tok = lp[idx < cn ? idx : 0]; v[h][i] = (unsigned)(tok * K + C[i]) * 2u; } }
    __device__ __forceinline__ void epi(const f32x4 (&acc)[2][2][4][2], const pg8::Unit& u, int wr, int wc, int fr, int fq) const {
        const int row0 = tab[32 + u.e] * 256 + u.pm * 256 + wr * 64 + fr;
        bf16_t* base = ACT + u.pn * 128 + wc * 32 + 8 * fq;
#pragma unroll
        for (int ai = 0; ai < 2; ++ai)
#pragma unroll
            for (int m = 0; m < 4; ++m) { bf16_t* rowp = base + (size_t)(row0 + ai * 128 + m * 16) * DE;
                f32x4 g0 = acc[ai][0][m][0], g1 = acc[ai][0][m][1]; const f32x4 u0 = acc[ai][1][m][0], u1 = acc[ai][1][m][1];
#pragma unroll
                for (int j = 0; j < 4; ++j) { g0[j] = fast_silu(g0[j]) * u0[j]; g1[j] = fast_silu(g1[j]) * u1[j]; }
                u32x4 w; w.x = cvt_pk_bf16(g0[0], g0[1]); w.y = cvt_pk_bf16(g0[2], g0[3]); w.z = cvt_pk_bf16(g1[0], g1[1]); w.w = cvt_pk_bf16(g1[2], g1[3]);
                *(u32x4*)rowp = w; }
    }
};
struct MoeDown {
    static constexpr bool PERM = true;
    int K, G, c; const volatile LAS int* tab; const bf16_t* ACT; const bf16_t* WD; bf16_t* YS;
    __device__ __forceinline__ bool next(int i, pg8::Unit& u) const { return moe_next(tab, i, G, c, 4, u); }
    __device__ __forceinline__ const char* a_base(const pg8::Unit& u) const { return (const char*)ACT + ((size_t)tab[32 + u.e] * 256 + u.pm * 256) * K * 2; }
    __device__ __forceinline__ const char* b_base(const pg8::Unit& u) const { return (const char*)WD + ((size_t)u.e * DM + u.pn * 256) * K * 2; }
    __device__ __forceinline__ void a_voff(const pg8::Unit&, const int (&R)[2], const int (&C)[2], unsigned (&v)[2][2]) const {
#pragma unroll
        for (int i = 0; i < 2; ++i) { v[0][i] = (unsigned)(R[i] * K + C[i]) * 2u; v[1][i] = v[0][i] + (unsigned)(128 * K * 2); } }
    __device__ __forceinline__ void epi(const f32x4 (&acc)[2][2][4][2], const pg8::Unit& u, int wr, int wc, int fr, int fq) const {
        const int row0 = tab[32 + u.e] * 256 + u.pm * 256 + wr * 64 + fr;
        bf16_t* base = YS + u.pn * 256 + wc * 32 + 8 * fq;
#pragma unroll
        for (int ai = 0; ai < 2; ++ai)
#pragma unroll
            for (int m = 0; m < 4; ++m) { bf16_t* rowp = base + (size_t)(row0 + ai * 128 + m * 16) * DM;
#pragma unroll
                for (int bj = 0; bj < 2; ++bj) { const f32x4 v0 = acc[ai][bj][m][0], v1 = acc[ai][bj][m][1];
                    u32x4 w; w.x = cvt_pk_bf16(v0[0], v0[1]); w.y = cvt_pk_bf16(v0[2], v0[3]); w.z = cvt_pk_bf16(v1[0], v1[1]); w.w = cvt_pk_bf16(v1[2], v1[3]);
                    *(u32x4*)(rowp + bj * 128) = w; } }
    }
};

__device__ __forceinline__ void p8_final(Frame& F) {
    float* X = F.out; const bf16_t* YS = (const bf16_t*)(F.ws + WS_YS); const unsigned* tokrec = (const unsigned*)(F.ws + WS_TOK);
    const float* mod = (const float*)(F.ws + WS_MOD); const float* lg = F.in[24]; const float* lb = F.in[25];
    volatile LAS int* tab = (volatile LAS int*)(F.lds + TAB_OFF);
    const int lane = F.lane; const int gw = blockIdx.x * NWAVES + F.wave, NGW = F.G * NWAVES;
    for (int t = gw; t < T; t += NGW) {
        const int b = t / SEQ; const float* g2 = mod + b * 6 * DM + 5 * DM;
        const u32x4 r0 = *(const u32x4*)(tokrec + (size_t)t * 8); const u32x2 r1 = *(const u32x2*)(tokrec + (size_t)t * 8 + 4);
        const int e1 = __builtin_amdgcn_readfirstlane((int)r0.x), s1 = __builtin_amdgcn_readfirstlane((int)r0.y), e2 = __builtin_amdgcn_readfirstlane((int)r0.z), s2 = __builtin_amdgcn_readfirstlane((int)r0.w);
        const float w1 = __builtin_bit_cast(float, __builtin_amdgcn_readfirstlane(r1.x)), w2 = __builtin_bit_cast(float, __builtin_amdgcn_readfirstlane(r1.y));
        const size_t ra = (size_t)(tab[32 + e1] * 256 + s1), rb = (size_t)(tab[32 + e2] * 256 + s2);
        f32x4 z[4]; float sm = 0.f;
#pragma unroll
        for (int j = 0; j < 4; ++j) { const int col = 4 * lane + 256 * j;
            const f32x4 xv = *(const f32x4*)(X + (size_t)t * DM + col); const f32x4 gv = *(const f32x4*)(g2 + col);
            const u32x2 ya = *(const u32x2*)(YS + ra * DM + col), yb = *(const u32x2*)(YS + rb * DM + col);
            f32x4 f;
            f[0] = w1 * __builtin_bit_cast(float, ya.x << 16) + w2 * __builtin_bit_cast(float, yb.x << 16);
            f[1] = w1 * __builtin_bit_cast(float, ya.x & 0xffff0000u) + w2 * __builtin_bit_cast(float, yb.x & 0xffff0000u);
            f[2] = w1 * __builtin_bit_cast(float, ya.y << 16) + w2 * __builtin_bit_cast(float, yb.y << 16);
            f[3] = w1 * __builtin_bit_cast(float, ya.y & 0xffff0000u) + w2 * __builtin_bit_cast(float, yb.y & 0xffff0000u);
            z[j] = xv * ALPHA + gv * f; sm += (z[j][0] + z[j][1]) + (z[j][2] + z[j][3]); }
        const float mean = wave_sum(sm) * (1.f / DM); float sq = 0.f;
#pragma unroll
        for (int j = 0; j < 4; ++j) { z[j] = z[j] - mean; sq += (z[j][0] * z[j][0] + z[j][1] * z[j][1]) + (z[j][2] * z[j][2] + z[j][3] * z[j][3]); }
        const float rstd = rsqrtf(wave_sum(sq) * (1.f / DM) + EPS);
#pragma unroll
        for (int j = 0; j < 4; ++j) { const int col = 4 * lane + 256 * j; *(f32x4*)(X + (size_t)t * DM + col) = z[j] * rstd * *(const f32x4*)(lg + col) + *(const f32x4*)(lb + col); }
    }
}

__global__ void __launch_bounds__(NWAVES * 64, 2) mega_fwd(Args args) {
    extern __shared__ __attribute__((aligned(16))) unsigned char lds[];
    Frame F;
    F.lds = (LAS unsigned char*)lds;
    F.MISC = (volatile LAS unsigned*)(F.lds + MISC_OFF);
    F.tid = threadIdx.x; F.lane = F.tid & 63; F.wave = __builtin_amdgcn_readfirstlane(F.tid >> 6);
    F.G = gridDim.x; { const int bx = blockIdx.x; F.vcu = (F.G % 8 == 0) ? (bx % 8) * (F.G / 8) + bx / 8 : bx; }
    F.ws = args.ws; F.out = args.out; F.ctl = (gu32*)(args.ws + WS_CTL);
#pragma unroll
    for (int i = 0; i < 26; ++i) F.in[i] = args.in[i];
    for (int u = F.tid; u < (LDS_BYTES - LDSCTL_OFF) / 4; u += NWAVES * 64) ((LAS unsigned*)(F.lds + LDSCTL_OFF))[u] = 0u;
    __syncthreads();
    XcdBarrier bar = xcd_barrier_post((unsigned*)(F.ctl + CW_BAR), F.MISC + 8);
    const int lo = args.ph_lo, hi = args.ph_hi;
#define IN(k) (lo <= (k) && (k) < hi)
#define BOTH(k) (IN(k) && IN((k) + 1))
    if (IN(0)) { p0_prologue(F); if (DUP_PHASE == 0) { xcd_barrier(bar); p0_prologue(F); } if (BOTH(0)) xcd_barrier(bar); }
    if (IN(1)) { p1_modulate(F); if (DUP_PHASE == 1) { xcd_barrier(bar); p1_modulate(F); } if (BOTH(1)) xcd_barrier(bar); }
    if (IN(2)) {
        InProj S; S.K = DM; S.G = F.G; S.c = (int)blockIdx.x; S.A = (const bf16_t*)(F.ws + WS_H); S.Bt = (const bf16_t*)(F.ws + WS_WI); S.bias = (const float*)(F.ws + WS_BPERM);
        S.VG = (bf16_t*)(F.ws + WS_VG); S.Q = (bf16_t*)(F.ws + WS_Q); S.KV = (bf16_t*)(F.ws + WS_KV);
        pg8::gemm_phase<InProj>(F.lds + RING_OFF, S);
        if (DUP_PHASE == 2) { xcd_barrier(bar); pg8::gemm_phase<InProj>(F.lds + RING_OFF, S); }
        if (BOTH(2)) xcd_barrier(bar);
    }
    if (IN(3)) { p3_mixers(F); if (DUP_PHASE == 3) { xcd_barrier(bar); p3_mixers(F); } if (DUP_PHASE == 30) { xcd_barrier(bar); p3_attn_only(F); } if (DUP_PHASE == 31) { xcd_barrier(bar); p3_conv_only(F); } if (BOTH(3)) xcd_barrier(bar); }
    if (IN(4)) {
        OutProj S; S.K = DM; S.G = F.G; S.c = (int)blockIdx.x; S.A = (const bf16_t*)(F.ws + WS_H); S.Bt = (const bf16_t*)(F.ws + WS_WO); S.x = F.in[0]; S.mod = (const float*)(F.ws + WS_MOD); S.bo = F.in[14];
        S.Z = F.out; S.stats = (f32x2*)(F.ws + WS_STATS);
        pg8::gemm_phase<OutProj>(F.lds + RING_OFF, S);
        if (DUP_PHASE == 4) { xcd_barrier(bar); pg8::gemm_phase<OutProj>(F.lds + RING_OFF, S); }
        if (BOTH(4)) xcd_barrier(bar);
    }
    if (IN(5)) { p5_rows(F); if (BOTH(5)) xcd_barrier(bar); }
    if (IN(6) || IN(7) || IN(8)) build_route_table(F);
    if (IN(6)) {
        MoeUp S; S.K = DM; S.G = F.G; S.c = (int)blockIdx.x; S.tab = (const volatile LAS int*)(F.lds + TAB_OFF); S.H2 = (const bf16_t*)(F.ws + WS_H2); S.WGU = (const bf16_t*)(F.ws + WS_WGU);
        S.list = (const int*)(F.ws + WS_LIST); S.ACT = (bf16_t*)(F.ws + WS_ACT);
        pg8::gemm_phase<MoeUp>(F.lds + RING_OFF, S);
        if (DUP_PHASE == 6) { xcd_barrier(bar); pg8::gemm_phase<MoeUp>(F.lds + RING_OFF, S); }
        if (BOTH(6)) xcd_barrier(bar);
    }
    if (IN(7)) {
        MoeDown S; S.K = DE; S.G = F.G; S.c = (int)blockIdx.x; S.tab = (const volatile LAS int*)(F.lds + TAB_OFF); S.ACT = (const bf16_t*)(F.ws + WS_ACT); S.WD = (const bf16_t*)(F.ws + WS_WD); S.YS = (bf16_t*)(F.ws + WS_YS);
        pg8::gemm_phase<MoeDown>(F.lds + RING_OFF, S);
        if (DUP_PHASE == 7) { xcd_barrier(bar); pg8::gemm_phase<MoeDown>(F.lds + RING_OFF, S); }
        if (BOTH(7)) xcd_barrier(bar);
    }
    if (IN(8)) { p8_final(F); }
#undef IN
#undef BOTH
}

namespace nv {
__device__ __forceinline__ float sigmoidf_(float v) { return 1.f / (1.f + __expf(-v)); }
__device__ __forceinline__ float siluf_(float v) { return v / (1.f + __expf(-v)); }
__global__ void __launch_bounds__(256) k_gemm(const float* A, const float* B, const float* bias, float* C, int M, int N, int K) {
    __shared__ float As[16][65]; __shared__ float Bs[16][64];
    int tx = threadIdx.x % 16, ty = threadIdx.x / 16; int m0 = blockIdx.y * 64, n0 = blockIdx.x * 64;
    float acc[4][4] = {};
    for (int k0 = 0; k0 < K; k0 += 16) {
        for (int i = threadIdx.x; i < 64 * 16; i += 256) { int r = i / 16, kk = i % 16; As[kk][r] = A[(size_t)(m0 + r) * K + k0 + kk]; }
        for (int i = threadIdx.x; i < 16 * 64; i += 256) { int kk = i / 64, cc = i % 64; Bs[kk][cc] = B[(size_t)(k0 + kk) * N + n0 + cc]; }
        __syncthreads();
#pragma unroll
        for (int kk = 0; kk < 16; ++kk) { float a[4], b[4];
#pragma unroll
            for (int i = 0; i < 4; ++i) { a[i] = As[kk][ty * 4 + i]; b[i] = Bs[kk][tx * 4 + i]; }
#pragma unroll
            for (int i = 0; i < 4; ++i)
#pragma unroll
                for (int j = 0; j < 4; ++j) acc[i][j] += a[i] * b[j]; }
        __syncthreads();
    }
    for (int i = 0; i < 4; ++i) for (int j = 0; j < 4; ++j) { int r = m0 + ty * 4 + i, cc = n0 + tx * 4 + j; C[(size_t)r * N + cc] = acc[i][j] + (bias ? bias[cc] : 0.f); }
}
__device__ __forceinline__ float block_sum512(float v, float* red) {
    for (int o = 32; o > 0; o >>= 1) v += __shfl_xor(v, o);
    __syncthreads();
    if ((threadIdx.x & 63) == 0) red[threadIdx.x >> 6] = v;
    __syncthreads();
    float s = 0.f; for (int i = 0; i < 8; ++i) s += red[i];
    return s;
}
__global__ void __launch_bounds__(512) k_conv2(const bf16_t* VG, const float* conv_w, const float* conv_b, const float* lng, const float* lnb, const float* outg, float* ycat) {
    __shared__ float red[8];
    int t = blockIdx.x, c = threadIdx.x; int s = t % SEQ;
    float acc = 0.f;
    for (int j = 0; j < CW; ++j) { int ss = s - (CW - 1) + j; if (ss < 0) continue; acc += conv_w[j * DCONV + c] * bf2f(VG[(size_t)(t - (CW - 1) + j) * DCONV + c]); }
    acc += conv_b[c];
    float mean = block_sum512(acc, red) * (1.f / DCONV); float d = acc - mean;
    float var = block_sum512(d * d, red) * (1.f / DCONV);
    float y = d * rsqrtf(var + EPS) * lng[c] + lnb[c];
    y = siluf_(y);
    float q = y * y; for (int o = 32; o > 0; o >>= 1) q += __shfl_xor(q, o);
    y = y * rsqrtf(q * (1.f / 64.f) + EPS) * outg[c];
    ycat[(size_t)t * DM + c] = y;
}
__global__ void __launch_bounds__(512) k_attn2(const bf16_t* Q, const bf16_t* KV, const float* sinks, const float* outg, float* ycat) {
    __shared__ float ps[8][128];
    int t = blockIdx.x, h = threadIdx.x >> 6, lane = threadIdx.x & 63; int s = t % SEQ; int kvh = h / 4;
    const bf16_t* q = Q + (size_t)t * DATTN + h * HD;
    float sc[2];
    for (int i = 0; i < 2; ++i) { int d = lane + 64 * i; int ss = s - d; float v = -1e30f;
        if (ss >= 0) { const bf16_t* k = KV + (size_t)(t - d) * 256 + kvh * HD; float a = 0.f; for (int e = 0; e < HD; ++e) a += bf2f(q[e]) * bf2f(k[e]); v = a; }
        sc[i] = v; }
    float sk = sinks[h] * LOG2E; float m = fmaxf(fmaxf(sc[0], sc[1]), sk);
    for (int o = 32; o > 0; o >>= 1) m = fmaxf(m, __shfl_xor(m, o));
    float p0 = (sc[0] > -1e29f) ? exp2f(sc[0] - m) : 0.f, p1 = (sc[1] > -1e29f) ? exp2f(sc[1] - m) : 0.f;
    float l = p0 + p1; for (int o = 32; o > 0; o >>= 1) l += __shfl_xor(l, o);
    l += exp2f(sk - m);
    ps[h][lane] = p0 / l; ps[h][lane + 64] = p1 / l;
    __syncthreads();
    float o = 0.f; int nd = (s + 1 < WIN) ? s + 1 : WIN;
    for (int d = 0; d < nd; ++d) o += ps[h][d] * bf2f(KV[(size_t)(t - d) * 256 + DKV + kvh * HD + lane]);
    float qq = o * o; for (int oo = 32; oo > 0; oo >>= 1) qq += __shfl_xor(qq, oo);
    ycat[(size_t)t * DM + DCONV + h * HD + lane] = o * rsqrtf(qq * (1.f / 64.f) + EPS) * outg[h * HD + lane];
}
__device__ __forceinline__ float block_sum256(float v, float* red) {
    for (int o = 32; o > 0; o >>= 1) v += __shfl_xor(v, o);
    __syncthreads();
    if ((threadIdx.x & 63) == 0) red[threadIdx.x >> 6] = v;
    __syncthreads();
    return red[0] + red[1] + red[2] + red[3];
}
__global__ void __launch_bounds__(256) k_ln1(const float* x, const float* mix, const float* mod, const float* g, const float* bta, float* x1) {
    __shared__ float red[4];
    int t = blockIdx.x, b = t / SEQ; float z[4]; float s = 0.f;
    for (int i = 0; i < 4; ++i) { int c = threadIdx.x + 256 * i; z[i] = ALPHA * x[(size_t)t * DM + c] + mod[b * 6 * DM + 2 * DM + c] * mix[(size_t)t * DM + c]; s += z[i]; }
    float mean = block_sum256(s, red) * (1.f / DM); float q = 0.f;
    for (int i = 0; i < 4; ++i) { z[i] -= mean; q += z[i] * z[i]; }
    float rstd = rsqrtf(block_sum256(q, red) * (1.f / DM) + EPS);
    for (int i = 0; i < 4; ++i) { int c = threadIdx.x + 256 * i; x1[(size_t)t * DM + c] = z[i] * rstd * g[c] + bta[c]; }
}
__global__ void __launch_bounds__(256) k_ln1s(float* io, const f32x2* stats, const float* g, const float* bta) {
    int t = blockIdx.x; float s = 0.f, q = 0.f;
    for (int i = 0; i < 16; ++i) { f32x2 p = stats[(size_t)t * 16 + i]; s += p.x; q += p.y; }
    float mean = s * (1.f / DM); float var = q * (1.f / DM) - mean * mean; float rstd = rsqrtf(var + EPS);
    for (int i = 0; i < 4; ++i) { int c = threadIdx.x + 256 * i; io[(size_t)t * DM + c] = (io[(size_t)t * DM + c] - mean) * rstd * g[c] + bta[c]; }
}
__global__ void k_bf2f(const bf16_t* in, float* out, size_t n) { size_t i = (size_t)blockIdx.x * blockDim.x + threadIdx.x; if (i < n) out[i] = bf2f(in[i]); }
__global__ void __launch_bounds__(256) k_moe(float* io, const float* mod, const float* wrg, const float* brg, const float* wre, const float* bre,
                                            const float* wg, const float* wu, const float* wd, const float* g2ln, const float* b2ln) {
    __shared__ float h2[DM]; __shared__ float part[4][64]; __shared__ float logit[64]; __shared__ float act[DE]; __shared__ int se[2]; __shared__ float sw[2]; __shared__ float red[4];
    int t = blockIdx.x, b = t / SEQ, tid = threadIdx.x;
    float x1v[4];
    for (int i = 0; i < 4; ++i) { int c = tid + 256 * i; x1v[i] = io[(size_t)t * DM + c]; h2[c] = x1v[i] * (1.f + mod[b * 6 * DM + 4 * DM + c]) + mod[b * 6 * DM + 3 * DM + c]; }
    __syncthreads();
    { int j = tid & 63, kp = tid >> 6; float a = 0.f;
      if (j < 36) { for (int k = kp * 256; k < kp * 256 + 256; ++k) a += h2[k] * (j < 4 ? wrg[k * NG + j] : wre[k * NE + (j - 4)]); }
      part[kp][j] = a; }
    __syncthreads();
    if (tid < 36) logit[tid] = part[0][tid] + part[1][tid] + part[2][tid] + part[3][tid] + (tid < 4 ? brg[tid] : bre[tid - 4]);
    __syncthreads();
    if (tid == 0) {
        float m = logit[0]; int gi = 0; for (int i = 1; i < 4; ++i) if (logit[i] > m) { m = logit[i]; gi = i; }
        float ssum = 0.f; for (int i = 0; i < 4; ++i) ssum += __expf(logit[i] - m); float ptop = 1.f / ssum;
        const float* el = logit + 4 + gi * 8; float em = el[0]; int i1 = 0; for (int i = 1; i < 8; ++i) if (el[i] > em) { em = el[i]; i1 = i; }
        float e2m = -3e38f; int i2 = -1; for (int i = 0; i < 8; ++i) if (i != i1 && el[i] > e2m) { e2m = el[i]; i2 = i; }
        float pa = 1.f, pb = __expf(e2m - em); float inv = ptop / (pa + pb);
        se[0] = gi * 8 + i1; se[1] = gi * 8 + i2; sw[0] = pa * inv; sw[1] = pb * inv;
    }
    __syncthreads();
    float y[4] = {0.f, 0.f, 0.f, 0.f};
    for (int s = 0; s < 2; ++s) {
        int e = se[s]; float w = sw[s];
        const float* G = wg + (size_t)e * DM * DE; const float* U = wu + (size_t)e * DM * DE; const float* Dn = wd + (size_t)e * DE * DM;
        float ga = 0.f, ua = 0.f;
        for (int k = 0; k < DM; ++k) { float hv = h2[k]; ga += hv * G[(size_t)k * DE + tid]; ua += hv * U[(size_t)k * DE + tid]; }
        __syncthreads();
        act[tid] = siluf_(ga) * ua;
        __syncthreads();
        for (int j = 0; j < DE; ++j) { float av = act[j] * w; for (int i = 0; i < 4; ++i) y[i] += av * Dn[(size_t)j * DM + tid + 256 * i]; }
    }
    float z[4]; float sm = 0.f;
    for (int i = 0; i < 4; ++i) { int c = tid + 256 * i; z[i] = ALPHA * x1v[i] + mod[b * 6 * DM + 5 * DM + c] * y[i]; sm += z[i]; }
    float mean = block_sum256(sm, red) * (1.f / DM); float q = 0.f;
    for (int i = 0; i < 4; ++i) { z[i] -= mean; q += z[i] * z[i]; }
    float rstd = rsqrtf(block_sum256(q, red) * (1.f / DM) + EPS);
    for (int i = 0; i < 4; ++i) { int c = tid + 256 * i; io[(size_t)t * DM + c] = z[i] * rstd * g2ln[c] + b2ln[c]; }
}
}

extern "C" void kernel_launch(void* const* d_in, const int* in_sizes, int n_in, void* d_out, int out_size, void* d_ws, size_t ws_size, hipStream_t stream) {
    static int grid = 0;
    if (grid == 0) {
        int dev = 0, cus = 0;
        if (hipGetDevice(&dev) != hipSuccess || hipDeviceGetAttribute(&cus, hipDeviceAttributeMultiprocessorCount, dev) != hipSuccess) { fprintf(stderr, "kernel_launch: device query failed\n"); grid = -1; return; }
        if (hipFuncSetAttribute((const void*)mega_fwd, hipFuncAttributeMaxDynamicSharedMemorySize, LDS_BYTES) != hipSuccess) { fprintf(stderr, "kernel_launch: hipFuncSetAttribute failed\n"); grid = -1; return; }
        int per_cu = 0;
        if (hipOccupancyMaxActiveBlocksPerMultiprocessor(&per_cu, (const void*)mega_fwd, NWAVES * 64, LDS_BYTES) != hipSuccess || per_cu < 1) fprintf(stderr, "kernel_launch: occupancy query reports %d\n", per_cu);
        (void)hipGetLastError();
        grid = cus;
    }
    if (grid < 0) return;
    (void)hipMemsetAsync((char*)d_ws + WS_CTL, 0, CTL_ZERO_BYTES, stream);
    Args a{};
    for (int i = 0; i < 26; ++i) a.in[i] = (const float*)d_in[i];
    a.out = (float*)d_out; a.ws = (unsigned char*)d_ws; a.ph_lo = 0; a.ph_hi = DEV_STAGE + 1;
    hipLaunchKernelGGL(mega_fwd, dim3(grid), dim3(NWAVES * 64), LDS_BYTES, stream, a);
    {
        using namespace nv;
        char* ws = (char*)d_ws; float* out = (float*)d_out;
        const float* x = (const float*)d_in[0];
        const float* mod = (const float*)(ws + WS_MOD);
        float* ycat = (float*)(ws + WS_DEV1);
        float* mix = (float*)(ws + 56 * MiB);
#if DEV_STAGE == 3
        k_bf2f<<<(unsigned)((size_t)T * DM / 256), 256, 0, stream>>>((const bf16_t*)(ws + WS_H), ycat, (size_t)T * DM);
        mix = (float*)(ws + 120 * MiB);
        k_gemm<<<dim3(DM / 64, T / 64), 256, 0, stream>>>(ycat, (const float*)d_in[13], (const float*)d_in[14], mix, T, DM, DM);
        k_ln1<<<T, 256, 0, stream>>>(x, mix, mod, (const float*)d_in[15], (const float*)d_in[16], out);
        k_moe<<<T, 256, 0, stream>>>(out, mod, (const float*)d_in[17], (const float*)d_in[18], (const float*)d_in[19], (const float*)d_in[20], (const float*)d_in[21], (const float*)d_in[22], (const float*)d_in[23], (const float*)d_in[24], (const float*)d_in[25]);
#endif
#if DEV_STAGE == 4
        k_ln1s<<<T, 256, 0, stream>>>(out, (const f32x2*)(ws + WS_STATS), (const float*)d_in[15], (const float*)d_in[16]);
        k_moe<<<T, 256, 0, stream>>>(out, mod, (const float*)d_in[17], (const float*)d_in[18], (const float*)d_in[19], (const float*)d_in[20], (const float*)d_in[21], (const float*)d_in[22], (const float*)d_in[23], (const float*)d_in[24], (const float*)d_in[25]);
#endif
#if DEV_STAGE == 2
        k_conv2<<<T, 512, 0, stream>>>((const bf16_t*)(ws + WS_VG), (const float*)d_in[6], (const float*)d_in[7], (const float*)d_in[8], (const float*)d_in[9], (const float*)d_in[10], ycat);
        k_attn2<<<T, 512, 0, stream>>>((const bf16_t*)(ws + WS_Q), (const bf16_t*)(ws + WS_KV), (const float*)d_in[11], (const float*)d_in[12], ycat);
        k_gemm<<<dim3(DM / 64, T / 64), 256, 0, stream>>>(ycat, (const float*)d_in[13], (const float*)d_in[14], mix, T, DM, DM);
        k_ln1<<<T, 256, 0, stream>>>(x, mix, mod, (const float*)d_in[15], (const float*)d_in[16], out);
        k_moe<<<T, 256, 0, stream>>>(out, mod, (const float*)d_in[17], (const float*)d_in[18], (const float*)d_in[19], (const float*)d_in[20], (const float*)d_in[21], (const float*)d_in[22], (const float*)d_in[23], (const float*)d_in[24], (const float*)d_in[25]);
#endif
    }
}
```

```cpp
#include <hip/hip_runtime.h>
#include <cstdio>
#include <cstdint>

#ifndef DUP_PHASE
#define DUP_PHASE -1
#endif
#ifndef DEV_STAGE
#define DEV_STAGE 8
#endif

#define LAS __attribute__((address_space(3)))
#define GAS __attribute__((address_space(1)))
typedef unsigned short bf16_t;
typedef short bf16x8 __attribute__((ext_vector_type(8)));
typedef float f32x4 __attribute__((ext_vector_type(4)));
typedef float f32x2 __attribute__((ext_vector_type(2)));
typedef unsigned u32x4 __attribute__((ext_vector_type(4)));
typedef unsigned u32x2 __attribute__((ext_vector_type(2)));
typedef GAS unsigned gu32;

constexpr int DM = 1024, NBATCH = 8, SEQ = 4096, T = NBATCH * SEQ;
constexpr int DCONV = 512, CW = 31, NH = 8, NKV = 2, HD = 64, DATTN = 512, DKV = 128, WIN = 128;
constexpr int DIN = 1792, NG = 4, EPG = 8, NE = 32, DE = 256;
constexpr float ALPHA = 1.189207115002721f, EPS = 1e-5f;
constexpr float LOG2E = 1.4426950408889634f;
constexpr float QSCALE = 0.125f * LOG2E;

constexpr size_t MiB = 1u << 20;
constexpr size_t WS_CTL = 0, CTL_ZERO_BYTES = 1 * MiB;
constexpr size_t WS_MOD = 1 * MiB;
constexpr size_t WS_BPERM = 1 * MiB + 256 * 1024;
constexpr size_t WS_WR = 1 * MiB + 512 * 1024;
constexpr size_t WS_WI = 2 * MiB;
constexpr size_t WS_WO = 6 * MiB;
constexpr size_t WS_WGU = 8 * MiB;
constexpr size_t WS_WD = 40 * MiB;
constexpr size_t WS_H = 56 * MiB;
constexpr size_t WS_VG = 120 * MiB;
constexpr size_t WS_Q = 152 * MiB;
constexpr size_t WS_KV = 184 * MiB;
constexpr size_t WS_H2 = 200 * MiB;
constexpr size_t WS_ACT = 264 * MiB;
constexpr size_t WS_LIST = 300 * MiB;
constexpr size_t WS_TOK = 304 * MiB;
constexpr size_t WS_MIX = 120 * MiB;
constexpr size_t WS_YS = 56 * MiB;
constexpr size_t WS_DEV1 = 320 * MiB;
constexpr int CW_BAR = 4096;
constexpr int CW_ECNT = 16384;

constexpr int RING_OFF = 0, RING_BYTES = 139264;
constexpr int LDSCTL_OFF = RING_BYTES, MISC_OFF = LDSCTL_OFF + 320;
constexpr int LDS_BYTES = 147456;
constexpr int NWAVES = 8;

#define RLX_AGENT __ATOMIC_RELAXED, __HIP_MEMORY_SCOPE_AGENT
#define LDS_WAIT() asm volatile("s_waitcnt lgkmcnt(0)" ::: "memory")
#define VM_WAIT() asm volatile("s_waitcnt vmcnt(0)" ::: "memory")

__device__ __forceinline__ unsigned f2bf(float f) { unsigned u = __builtin_bit_cast(unsigned, f); return (u + 0x7fffu + ((u >> 16) & 1u)) >> 16; }
__device__ __forceinline__ unsigned pk2(float lo, float hi) { return f2bf(lo) | (f2bf(hi) << 16); }
__device__ __forceinline__ float bf2f(unsigned short b) { return __builtin_bit_cast(float, (unsigned)b << 16); }
__device__ __forceinline__ unsigned cvt_pk_bf16(float lo, float hi) { unsigned r; asm volatile("v_cvt_pk_bf16_f32 %0, %1, %2" : "=v"(r) : "v"(lo), "v"(hi)); return r; }
__device__ __forceinline__ float fast_sigmoid(float v) { return __builtin_amdgcn_rcpf(1.f + __builtin_amdgcn_exp2f(-v * LOG2E)); }
__device__ __forceinline__ float fast_silu(float v) { return v * fast_sigmoid(v); }

#define XB_TMO      128
#define XB_XCNT(j)  (256  + 64 * (j))
#define XB_XSUB(j)  (1280 + 64 * (j))
#define XB_XGEN(j)  (2304 + 64 * (j))
#define XB_TOP      3328
#define XB_TOPGEN   3392
#define XCD_BAR_WORDS 3456
#define XB_SPIN_CAP (1u << 18)
__device__ __forceinline__ unsigned xb_ld(unsigned* p)              { return __hip_atomic_load(p, __ATOMIC_RELAXED, __HIP_MEMORY_SCOPE_AGENT); }
__device__ __forceinline__ unsigned xb_add(unsigned* p, unsigned v) { return __hip_atomic_fetch_add(p, v, __ATOMIC_RELAXED, __HIP_MEMORY_SCOPE_AGENT); }
__device__ __forceinline__ unsigned xb_xcc_id() { return (unsigned)__builtin_amdgcn_s_getreg((3 << 11) | 20) & 0xFu; }
#define XB_SPIN(cond, bar) do { unsigned _sp = 0; while (cond) { __builtin_amdgcn_s_sleep(1); \
    if ((++_sp & 255u) == 0u) { if (xb_ld(&(bar)[XB_TMO])) break; if (_sp > XB_SPIN_CAP) { atomicAdd(&(bar)[XB_TMO], 1u); break; } } } } while (0)
struct XcdBarrier { unsigned* bar; unsigned x; volatile LAS unsigned* st; };
__device__ __forceinline__ XcdBarrier xcd_barrier_post(unsigned* bar, volatile LAS unsigned* st) {
    XcdBarrier b; b.bar = bar; b.x = xb_xcc_id(); b.st = st;
    if (threadIdx.x == 0) (void)xb_add(&bar[XB_XCNT(b.x)], 1u);
    return b;
}
__device__ __forceinline__ void xcd_barrier_complete(unsigned* bar, unsigned x, unsigned& nloc, unsigned& nx) {
    const unsigned G = gridDim.x * gridDim.y * gridDim.z;
    unsigned sum, cnt, mine, sp = 0u;
    for (;;) {
        sum = 0u; cnt = 0u; mine = 0u;
#pragma unroll
        for (unsigned j = 0; j < 16; ++j) { const unsigned c = xb_ld(&bar[XB_XCNT(j)]); sum += c; cnt += (c > 0u) ? 1u : 0u; mine = (j == x) ? c : mine; }
        if (sum == G) break;
        __builtin_amdgcn_s_sleep(1);
        if ((++sp & 255u) == 0u) { if (xb_ld(&bar[XB_TMO])) break; if (sp > XB_SPIN_CAP) { atomicAdd(&bar[XB_TMO], 1u); break; } }
    }
    nloc = mine > 0u ? mine : 1u; nx = cnt > 0u ? cnt : 1u;
}
__device__ __forceinline__ void xcd_barrier(const XcdBarrier& b) {
    asm volatile("s_waitcnt vmcnt(0)" ::: "memory");
    __syncthreads();
    if (threadIdx.x == 0) {
        unsigned* bar = b.bar;
        __builtin_amdgcn_s_waitcnt(0);
        unsigned nloc = b.st[0], nx = b.st[1];
        if (nloc == 0u) { xcd_barrier_complete(bar, b.x, nloc, nx); b.st[0] = nloc; b.st[1] = nx; }
        const unsigned old = xb_add(&bar[XB_XSUB(b.x)], 1u);
        const unsigned gen = old / nloc;
        if (old + 1u == (gen + 1u) * nloc) {
            __builtin_amdgcn_fence(__ATOMIC_RELEASE, "agent");
            asm volatile("s_waitcnt vmcnt(0)" ::: "memory");
            const unsigned og = xb_add(&bar[XB_TOP], 1u);
            const unsigned tg = og / nx;
            if (og + 1u == (tg + 1u) * nx) xb_add(&bar[XB_TOPGEN], 1u);
            else XB_SPIN(xb_ld(&bar[XB_TOPGEN]) == tg, bar);
            __builtin_amdgcn_fence(__ATOMIC_ACQUIRE, "agent");
            xb_add(&bar[XB_XGEN(b.x)], 1u);
            asm volatile("s_waitcnt vmcnt(0)" ::: "memory");
        } else {
            XB_SPIN(xb_ld(&bar[XB_XGEN(b.x)]) == gen, bar);
            __builtin_amdgcn_fence(__ATOMIC_ACQUIRE, "agent");
            asm volatile("s_waitcnt vmcnt(0)" ::: "memory");
        }
    }
    __syncthreads();
}

namespace pg8 {
constexpr int BM = 256, BK = 64, HALF = 128, HTB = HALF * BK * 2, STAGE_BYTES = 8 * HTB, NXCD = 8, WGM = 8;
__host__ __device__ __forceinline__ int lds_byte(int r, int c) { const int st = (r >> 4) * 2 + (c >> 5), rr = r & 15, cc = c & 31, ob = rr * 64 + cc * 2; return st * 1024 + (ob ^ (((ob >> 9) & 1) << 5)); }
__host__ __device__ __forceinline__ void stage_rc(int b, int& R, int& C) { const int st = b / 1024, sb = b % 1024, swz = sb ^ (((sb >> 9) & 1) << 5); R = (st >> 1) * 16 + swz / 64; C = (st & 1) * 32 + (swz % 64) / 2; }
__host__ __device__ __forceinline__ int perm32(int rho) { const int n = rho >> 4, i = rho & 15; return 8 * (i >> 2) + 4 * n + (i & 3); }

struct Unit { int pm, pn, e; };
__device__ __forceinline__ bool static_next(int i, int G, int c, int nM, int nN, int& pm, int& pn) {
    const int nwg = nM * nN; const long L = (long)i * G + c; if (L >= nwg) return false;
    int wgid = (int)L; { const int q = nwg / NXCD, r = nwg % NXCD, xcd = wgid % NXCD, off = wgid / NXCD; wgid = (xcd < r ? xcd * (q + 1) : r * (q + 1) + (xcd - r) * q) + off; }
    const int nig = WGM * nN, gid = wgid / nig, fm = gid * WGM, gsz = (nM - fm) < WGM ? (nM - fm) : WGM;
    pm = fm + ((wgid % nig) % gsz); pn = (wgid % nig) / gsz; return true;
}

template <class P>
__device__ __forceinline__ void gemm_phase(LAS unsigned char* lds, const P& S) {
    const int tid = threadIdx.x, wid = __builtin_amdgcn_readfirstlane(tid >> 6), lane = tid & 63, wr = wid >> 2, wc = wid & 3, fr = lane & 15, fq = lane >> 4;
    const int K = S.K, nt = K / BK;
    int sR[2], sC[2]; unsigned voffB[2];
#pragma unroll
    for (int i = 0; i < 2; ++i) { int R, C; stage_rc(tid * 16 + i * 8192, R, C); sR[i] = R; sC[i] = C; const int Rb = P::PERM ? ((R & ~31) + perm32(R & 31)) : R; voffB[i] = (unsigned)(Rb * K + C) * 2u; }
    const size_t kstep = (size_t)(BK * 2);
    const size_t hstepB = (size_t)HALF * K * 2;
    const unsigned ldsw = (unsigned)wid * 1024u;
    const int aoff = lds_byte(wr * 64 + fr, fq * 8), boff = lds_byte(wc * 32 + fr, fq * 8);
#define PG8_SA(b, h) (((b) * 2 + (h)) * HTB)
#define PG8_SB(b, h) ((4 + (b) * 2 + (h)) * HTB)
#define PG8_STAGE(bufoff, gbase, voff) do { _Pragma("unroll") for (int _i = 0; _i < 2; ++_i) \
        __builtin_amdgcn_global_load_lds((const unsigned*)((const char*)(gbase) + (voff)[_i]), (LAS unsigned*)(lds + (bufoff) + ldsw + _i * 8192), 16, 0, 0); } while (0)
#define PG8_LDA(dst, b, h) do { _Pragma("unroll") for (int m = 0; m < 4; ++m) _Pragma("unroll") for (int k = 0; k < 2; ++k) dst[m][k] = *(const LAS bf16x8*)(lds + PG8_SA(b, h) + aoff + m * 2048 + k * 1024); } while (0)
#define PG8_LDB(dst, b, h) do { _Pragma("unroll") for (int n = 0; n < 2; ++n) _Pragma("unroll") for (int k = 0; k < 2; ++k) dst[n][k] = *(const LAS bf16x8*)(lds + PG8_SB(b, h) + boff + n * 2048 + k * 1024); } while (0)
#define PG8_MMA(ai, bj, At, Bt) do { __builtin_amdgcn_s_setprio(1); _Pragma("unroll") for (int m = 0; m < 4; ++m) _Pragma("unroll") for (int n = 0; n < 2; ++n) _Pragma("unroll") for (int k = 0; k < 2; ++k) \
        acc[ai][bj][m][n] = __builtin_amdgcn_mfma_f32_16x16x32_bf16(Bt[n][k], At[m][k], acc[ai][bj][m][n], 0, 0, 0); __builtin_amdgcn_s_setprio(0); } while (0)
#define PG8_WAIT_V(n) asm volatile("s_waitcnt vmcnt(" #n ")" ::: "memory")
#define PG8_WAIT_L(n) asm volatile("s_waitcnt lgkmcnt(" #n ")" ::: "memory")
#define PG8_BAR __builtin_amdgcn_s_barrier()
#define PG8_SCHED __builtin_amdgcn_sched_barrier(0)
    Unit cur, nxt; int ui = 0;
    if (!S.next(0, cur)) return;
    f32x4 acc[2][2][4][2];
#pragma unroll
    for (int a = 0; a < 2; ++a)
#pragma unroll
        for (int b = 0; b < 2; ++b)
#pragma unroll
            for (int m = 0; m < 4; ++m)
#pragma unroll
                for (int n = 0; n < 2; ++n) acc[a][b][m][n] = (f32x4){0.f, 0.f, 0.f, 0.f};
    bf16x8 At[4][2], B0[2][2], B1[2][2];
    unsigned vAc[2][2], vAn[2][2];
    S.a_voff(cur, sR, sC, vAc);
    const char* cA = S.a_base(cur); const char* cB = S.b_base(cur);
    PG8_STAGE(PG8_SB(0, 0), cB, voffB); PG8_STAGE(PG8_SB(0, 1), cB + hstepB, voffB); PG8_STAGE(PG8_SA(0, 0), cA, vAc[0]); PG8_STAGE(PG8_SA(0, 1), cA, vAc[1]);
    if (wr == 1) PG8_BAR;
    PG8_WAIT_V(2); PG8_BAR;
    PG8_STAGE(PG8_SB(1, 0), cB + kstep, voffB); PG8_STAGE(PG8_SA(1, 0), cA + kstep, vAc[0]); PG8_STAGE(PG8_SB(1, 1), cB + hstepB + kstep, voffB);
    PG8_WAIT_V(6); PG8_BAR;
    for (;;) {
        const bool has_next = S.next(ui + 1, nxt);
        const char* nA = has_next ? S.a_base(nxt) : cA; const char* nB = has_next ? S.b_base(nxt) : cB;
        if (has_next) S.a_voff(nxt, sR, sC, vAn); else { vAn[0][0] = vAc[0][0]; vAn[0][1] = vAc[0][1]; vAn[1][0] = vAc[1][0]; vAn[1][1] = vAc[1][1]; }
        for (int t = 0; t < nt; t += 2) {
            const bool last = (t == nt - 2);
            const char* a1 = cA + (size_t)(t + 1) * kstep;
            const char* a2 = last ? nA : cA + (size_t)(t + 2) * kstep; const char* b2 = last ? nB : cB + (size_t)(t + 2) * kstep;
            const char* a3 = a2 + kstep; const char* b3 = b2 + kstep;
            unsigned v2[2][2];
            v2[0][0] = last ? vAn[0][0] : vAc[0][0]; v2[0][1] = last ? vAn[0][1] : vAc[0][1]; v2[1][0] = last ? vAn[1][0] : vAc[1][0]; v2[1][1] = last ? vAn[1][1] : vAc[1][1];
            PG8_LDB(B0, 0, 0); PG8_LDB(B1, 0, 1); PG8_SCHED; PG8_LDA(At, 0, 0); PG8_STAGE(PG8_SA(1, 1), a1, vAc[1]);
            PG8_WAIT_V(8); PG8_WAIT_L(0); PG8_BAR; PG8_MMA(0, 0, At, B0); PG8_MMA(0, 1, At, B1); PG8_BAR; PG8_SCHED;
            PG8_LDA(At, 0, 1); PG8_STAGE(PG8_SB(0, 0), b2, voffB); PG8_STAGE(PG8_SB(0, 1), b2 + hstepB, voffB); PG8_STAGE(PG8_SA(0, 0), a2, v2[0]);
            PG8_WAIT_V(8); PG8_WAIT_L(0); PG8_BAR; PG8_MMA(1, 0, At, B0); PG8_MMA(1, 1, At, B1); PG8_BAR; PG8_SCHED;
            PG8_LDB(B0, 1, 0); PG8_LDB(B1, 1, 1); PG8_SCHED; PG8_LDA(At, 1, 0); PG8_STAGE(PG8_SA(0, 1), a2, v2[1]);
            PG8_WAIT_V(8); PG8_WAIT_L(0); PG8_BAR; PG8_MMA(0, 0, At, B0); PG8_MMA(0, 1, At, B1); PG8_BAR; PG8_SCHED;
            PG8_LDA(At, 1, 1); PG8_STAGE(PG8_SB(1, 0), b3, voffB); PG8_STAGE(PG8_SB(1, 1), b3 + hstepB, voffB); PG8_STAGE(PG8_SA(1, 0), a3, v2[0]);
            PG8_WAIT_V(8); PG8_WAIT_L(0); PG8_BAR; PG8_MMA(1, 0, At, B0); PG8_MMA(1, 1, At, B1); PG8_BAR; PG8_SCHED;
        }
        if (wr == 0) PG8_BAR;
        S.epi(acc, cur, wr, wc, fr, fq);
        if (!has_next) break;
#pragma unroll
        for (int a = 0; a < 2; ++a)
#pragma unroll
            for (int b = 0; b < 2; ++b)
#pragma unroll
                for (int m = 0; m < 4; ++m)
#pragma unroll
                    for (int n = 0; n < 2; ++n) acc[a][b][m][n] = (f32x4){0.f, 0.f, 0.f, 0.f};
        cur = nxt; cA = nA; cB = nB; ++ui;
        vAc[0][0] = vAn[0][0]; vAc[0][1] = vAn[0][1]; vAc[1][0] = vAn[1][0]; vAc[1][1] = vAn[1][1];
        if (wr == 1) PG8_BAR;
    }
    PG8_WAIT_V(0);
    PG8_BAR;
#undef PG8_SA
#undef PG8_SB
#undef PG8_STAGE
#undef PG8_LDA
#undef PG8_LDB
#undef PG8_MMA
#undef PG8_WAIT_V
#undef PG8_WAIT_L
#undef PG8_BAR
#undef PG8_SCHED
}
}

struct Frame {
    LAS unsigned char* lds;
    volatile LAS unsigned* MISC;
    gu32* ctl;
    int tid, lane, wave, vcu, G;
    const float* in[26]; float* out; unsigned char* ws;
};
struct Args { const float* in[26]; float* out; unsigned char* ws; int ph_lo, ph_hi; };

__device__ __forceinline__ float wave_sum(float v) {
#pragma unroll
    for (int o = 1; o < 64; o <<= 1) v += __shfl_xor(v, o);
    return v;
}

__device__ __forceinline__ void p0_transpose_item(const float* W, int Ksrc, int N, bf16_t* WT, int dst_row0, LAS float* scr, int k0, int n0, int lane) {
#pragma unroll 8
    for (int i = 0; i < 32; ++i) { const int kk = 2 * i + (lane >> 5); scr[kk * 33 + (lane & 31)] = W[(size_t)(k0 + kk) * N + n0 + (lane & 31)]; }
    LDS_WAIT(); asm volatile("" ::: "memory");
    const int c = lane & 7;
#pragma unroll
    for (int j = 0; j < 4; ++j) { const int n = (lane >> 3) + 8 * j; const LAS float* s = scr + (8 * c) * 33 + n;
        u32x4 o; o.x = pk2(s[0 * 33], s[1 * 33]); o.y = pk2(s[2 * 33], s[3 * 33]); o.z = pk2(s[4 * 33], s[5 * 33]); o.w = pk2(s[6 * 33], s[7 * 33]);
        *(GAS u32x4*)(WT + (size_t)(dst_row0 + n) * Ksrc + k0 + 8 * c) = o; }
    LDS_WAIT(); asm volatile("" ::: "memory");
}
__host__ __device__ __forceinline__ int map_in(int n) { return n < 512 ? 256 * (n >> 7) + (n & 127) : (n < 1024 ? 256 * ((n - 512) >> 7) + 128 + ((n - 512) & 127) : n); }

__device__ __forceinline__ void p0_prologue(Frame& F) {
    const float* c = F.in[1]; const float* w_ada = F.in[2]; const float* b_ada = F.in[3];
    {
        LAS float* cact = (LAS float*)(F.lds + RING_OFF);
        LAS float* red = (LAS float*)(F.lds + RING_OFF + 32768);
        for (int i = F.tid; i < NBATCH * DM; i += 512) { const float v = c[i]; cact[i] = v / (1.f + __expf(-v)); }
        __syncthreads();
        float* mod = (float*)(F.ws + WS_MOD);
        for (int cg = blockIdx.x; cg < 256; cg += F.G) {
            const int j0 = cg * 24, ks = F.tid >> 5, jj = F.tid & 31;
            float a[8] = {0.f, 0.f, 0.f, 0.f, 0.f, 0.f, 0.f, 0.f};
            if (jj < 24) {
                for (int k = ks * 64; k < ks * 64 + 64; ++k) { const float w = w_ada[(size_t)k * 6 * DM + j0 + jj];
#pragma unroll
                    for (int b = 0; b < 8; ++b) a[b] += cact[b * DM + k] * w; }
            }
#pragma unroll
            for (int b = 0; b < 8; ++b) red[(ks * 8 + b) * 32 + jj] = a[b];
            __syncthreads();
            if (F.tid < 8 * 24) { const int b = F.tid / 24, j = F.tid % 24; float s = 0.f;
                for (int q = 0; q < 16; ++q) s += red[(q * 8 + b) * 32 + j];
                mod[b * 6 * DM + j0 + j] = s + b_ada[j0 + j]; }
            __syncthreads();
        }
    }
    {
        const int gt = blockIdx.x * 512 + F.tid, NT = F.G * 512;
        float* bperm = (float*)(F.ws + WS_BPERM); const float* b_in = F.in[5];
        for (int n = gt; n < DIN; n += NT) bperm[map_in(n)] = b_in[n];
        bf16_t* wr_hi = (bf16_t*)(F.ws + WS_WR); bf16_t* wr_lo = wr_hi + 48 * DM;
        const float* wrg = F.in[17]; const float* wre = F.in[19];
        for (int i = gt; i < 48 * DM; i += NT) { const int j = i / DM, k = i % DM; float v = 0.f;
            if (j < 4) v = wrg[k * NG + j]; else if (j < 36) v = wre[k * NE + (j - 4)];
            const unsigned h = f2bf(v); const float r = v - bf2f((unsigned short)h); wr_hi[i] = (bf16_t)h; wr_lo[i] = (bf16_t)f2bf(r); }
    }
    {
        LAS float* scr = (LAS float*)(F.lds + RING_OFF + F.wave * 16384);
        const int gw = F.vcu * NWAVES + F.wave, NGW = F.G * NWAVES;
        constexpr int I_IN = 16 * 56, I_OUT = 16 * 32, I_G = 16 * 8, I_D = 4 * 32, I_E = 2 * I_G + I_D;
        constexpr int NITEMS = I_IN + I_OUT + NE * I_E;
        bf16_t* WI = (bf16_t*)(F.ws + WS_WI); bf16_t* WO = (bf16_t*)(F.ws + WS_WO); bf16_t* WGU = (bf16_t*)(F.ws + WS_WGU); bf16_t* WD = (bf16_t*)(F.ws + WS_WD);
        for (int it = gw; it < NITEMS; it += NGW) {
            int r = it;
            if (r < I_IN) { const int kb = r / 56, nb = r % 56; p0_transpose_item(F.in[4], DM, DIN, WI, map_in(32 * nb), scr, 64 * kb, 32 * nb, F.lane); continue; } r -= I_IN;
            if (r < I_OUT) { const int kb = r / 32, nb = r % 32; p0_transpose_item(F.in[13], DM, DM, WO, 32 * nb, scr, 64 * kb, 32 * nb, F.lane); continue; } r -= I_OUT;
            const int e = r / I_E; r -= e * I_E;
            if (r < I_G) { const int kb = r / 8, nb = r % 8, n0 = 32 * nb; p0_transpose_item(F.in[21] + (size_t)e * DM * DE, DM, DE, WGU + (size_t)e * 512 * DM, 256 * (n0 >> 7) + (n0 & 127), scr, 64 * kb, n0, F.lane); continue; } r -= I_G;
            if (r < I_G) { const int kb = r / 8, nb = r % 8, n0 = 32 * nb; p0_transpose_item(F.in[22] + (size_t)e * DM * DE, DM, DE, WGU + (size_t)e * 512 * DM, 256 * (n0 >> 7) + 128 + (n0 & 127), scr, 64 * kb, n0, F.lane); continue; } r -= I_G;
            { const int kb = r / 32, nb = r % 32; p0_transpose_item(F.in[23] + (size_t)e * DE * DM, DE, DM, WD + (size_t)e * DM * DE, 32 * nb, scr, 64 * kb, 32 * nb, F.lane); }
        }
    }
}

__device__ __forceinline__ void p1_modulate(Frame& F) {
    const float* x = F.in[0]; const float* mod = (const float*)(F.ws + WS_MOD); bf16_t* H = (bf16_t*)(F.ws + WS_H);
    const int cv = F.tid & 127, rsub = F.tid >> 7, col = cv * 8;
    for (int r0 = blockIdx.x * 16; r0 < T; r0 += F.G * 16) {
        const int b = r0 / SEQ; const float* mb = mod + b * 6 * DM;
        const f32x4 s0 = *(const f32x4*)(mb + DM + col) + 1.f, s1 = *(const f32x4*)(mb + DM + col + 4) + 1.f, h0 = *(const f32x4*)(mb + col), h1 = *(const f32x4*)(mb + col + 4);
        f32x4 xa[4], xb[4];
#pragma unroll
        for (int i = 0; i < 4; ++i) { const size_t e0 = (size_t)(r0 + rsub + 4 * i) * DM + col; xa[i] = *(const f32x4*)(x + e0); xb[i] = *(const f32x4*)(x + e0 + 4); }
#pragma unroll
        for (int i = 0; i < 4; ++i) { const size_t e0 = (size_t)(r0 + rsub + 4 * i) * DM + col; const f32x4 y0 = xa[i] * s0 + h0, y1 = xb[i] * s1 + h1;
            u32x4 o; o.x = pk2(y0[0], y0[1]); o.y = pk2(y0[2], y0[3]); o.z = pk2(y1[0], y1[1]); o.w = pk2(y1[2], y1[3]);
            *(u32x4*)(H + e0) = o; }
    }
}

struct InProj {
    static constexpr bool PERM = true;
    int K, G, c; const bf16_t* A; const bf16_t* Bt; const float* bias; bf16_t* VG; bf16_t* Q; bf16_t* KV;
    __device__ __forceinline__ bool next(int i, pg8::Unit& u) const { u.e = 0; return pg8::static_next(i, G, c, T / 256, DIN / 256, u.pm, u.pn); }
    __device__ __forceinline__ const char* a_base(const pg8::Unit& u) const { return (const char*)A + (size_t)u.pm * 256 * K * 2; }
    __device__ __forceinline__ const char* b_base(const pg8::Unit& u) const { return (const char*)Bt + (size_t)u.pn * 256 * K * 2; }
    __device__ __forceinline__ void a_voff(const pg8::Unit&, const int (&R)[2], const int (&C)[2], unsigned (&v)[2][2]) const {
#pragma unroll
        for (int i = 0; i < 2; ++i) { v[0][i] = (unsigned)(R[i] * K + C[i]) * 2u; v[1][i] = v[0][i] + (unsigned)(128 * K * 2); } }
    __device__ __forceinline__ void epi(const f32x4 (&acc)[2][2][4][2], const pg8::Unit& u, int wr, int wc, int fr, int fq) const {
        const int row0 = u.pm * 256 + wr * 64 + fr; const int bcol0 = u.pn * 256 + wc * 32 + 8 * fq;
        f32x4 bv[2][2];
#pragma unroll
        for (int bj = 0; bj < 2; ++bj)
#pragma unroll
            for (int n = 0; n < 2; ++n) bv[bj][n] = *(const f32x4*)(bias + bcol0 + bj * 128 + 4 * n);
        if (u.pn < 4) {
            bf16_t* base = VG + u.pn * 128 + wc * 32 + 8 * fq;
#pragma unroll
            for (int ai = 0; ai < 2; ++ai)
#pragma unroll
                for (int m = 0; m < 4; ++m) { bf16_t* rowp = base + (size_t)(row0 + ai * 128 + m * 16) * DCONV;
                    f32x4 a0 = acc[ai][0][m][0] + bv[0][0], a1 = acc[ai][0][m][1] + bv[0][1], g0 = acc[ai][1][m][0] + bv[1][0], g1 = acc[ai][1][m][1] + bv[1][1];
#pragma unroll
                    for (int j = 0; j < 4; ++j) { a0[j] *= fast_sigmoid(g0[j]); a1[j] *= fast_sigmoid(g1[j]); }
                    u32x4 w; w.x = cvt_pk_bf16(a0[0], a0[1]); w.y = cvt_pk_bf16(a0[2], a0[3]); w.z = cvt_pk_bf16(a1[0], a1[1]); w.w = cvt_pk_bf16(a1[2], a1[3]);
                    *(u32x4*)rowp = w; }
        } else {
            const bool isq = u.pn < 6; const float sc = isq ? QSCALE : 1.f; const int ldc = isq ? DATTN : 2 * DKV;
            bf16_t* base = (isq ? Q + (u.pn - 4) * 256 : KV) + wc * 32 + 8 * fq;
#pragma unroll
            for (int ai = 0; ai < 2; ++ai)
#pragma unroll
                for (int m = 0; m < 4; ++m) { bf16_t* rowp = base + (size_t)(row0 + ai * 128 + m * 16) * ldc;
#pragma unroll
                    for (int bj = 0; bj < 2; ++bj) { const f32x4 v0 = (acc[ai][bj][m][0] + bv[bj][0]) * sc, v1 = (acc[ai][bj][m][1] + bv[bj][1]) * sc;
                        u32x4 w; w.x = cvt_pk_bf16(v0[0], v0[1]); w.y = cvt_pk_bf16(v0[2], v0[3]); w.z = cvt_pk_bf16(v1[0], v1[1]); w.w = cvt_pk_bf16(v1[2], v1[3]);
                        *(u32x4*)(rowp + bj * 128) = w; } }
        }
    }
};


template <int R> __device__ __forceinline__ void conv_rows(float (&acc)[32], const float (&w)[31], const float (&vin)[62]) {
    if constexpr (R < 62) {
#pragma unroll
        for (int j = 0; j < 31; ++j) { const int o = R - j; if (o >= 0 && o < 32) acc[o] += w[j] * vin[R]; }
        conv_rows<R + 1>(acc, w, vin);
    }
}
__device__ __forceinline__ void conv_unit(Frame& F, int t0) {
    const bf16_t* VG = (const bf16_t*)(F.ws + WS_VG);
    const float* conv_w = F.in[6]; const float* conv_b = F.in[7]; const float* lng = F.in[8]; const float* lnb = F.in[9]; const float* outg = F.in[10];
    bf16_t* Y = (bf16_t*)(F.ws + WS_H);
    LAS float* tile = (LAS float*)(F.lds + RING_OFF);
    const int c = F.tid; const int s0 = t0 % SEQ; const int tb = t0 - s0;
    float w[31];
#pragma unroll
    for (int j = 0; j < 31; ++j) w[j] = conv_w[j * DCONV + c];
    float acc[32]; { const float cb = conv_b[c];
#pragma unroll
        for (int o = 0; o < 32; ++o) acc[o] = cb; }
    float vin[62];
#pragma unroll
    for (int r = 0; r < 62; ++r) { const int ss = s0 - 30 + r; const int tr = tb + (ss < 0 ? 0 : ss); const float v = bf2f(VG[(size_t)tr * DCONV + c]); vin[r] = ss < 0 ? 0.f : v; }
    conv_rows<0>(acc, w, vin);
#pragma unroll
    for (int o = 0; o < 32; ++o) tile[o * 516 + c] = acc[o];
    __syncthreads();
    {
        const int c8 = F.lane * 8;
        const f32x4 g0 = *(const f32x4*)(lng + c8), g1 = *(const f32x4*)(lng + c8 + 4), b0 = *(const f32x4*)(lnb + c8), b1 = *(const f32x4*)(lnb + c8 + 4), og0 = *(const f32x4*)(outg + c8), og1 = *(const f32x4*)(outg + c8 + 4);
#pragma unroll
        for (int i = 0; i < 4; ++i) { const int o = F.wave * 4 + i;
            f32x4 v0 = *(const LAS f32x4*)(tile + o * 516 + c8), v1 = *(const LAS f32x4*)(tile + o * 516 + c8 + 4);
            const float mean = wave_sum((v0[0] + v0[1]) + (v0[2] + v0[3]) + (v1[0] + v1[1]) + (v1[2] + v1[3])) * (1.f / DCONV);
            v0 = v0 - mean; v1 = v1 - mean;
            const float var = wave_sum((v0[0] * v0[0] + v0[1] * v0[1]) + (v0[2] * v0[2] + v0[3] * v0[3]) + (v1[0] * v1[0] + v1[1] * v1[1]) + (v1[2] * v1[2] + v1[3] * v1[3])) * (1.f / DCONV);
            const float rstd = rsqrtf(var + EPS);
            v0 = v0 * rstd * g0 + b0; v1 = v1 * rstd * g1 + b1;
            float q = 0.f;
#pragma unroll
            for (int j = 0; j < 4; ++j) { v0[j] = fast_silu(v0[j]); v1[j] = fast_silu(v1[j]); q += v0[j] * v0[j] + v1[j] * v1[j]; }
            q += __shfl_xor(q, 1); q += __shfl_xor(q, 2); q += __shfl_xor(q, 4);
            const float r2 = rsqrtf(q * (1.f / 64.f) + EPS);
            v0 = v0 * r2 * og0; v1 = v1 * r2 * og1;
            u32x4 ow; ow.x = pk2(v0[0], v0[1]); ow.y = pk2(v0[2], v0[3]); ow.z = pk2(v1[0], v1[1]); ow.w = pk2(v1[2], v1[3]);
            *(u32x4*)(Y + (size_t)(t0 + o) * DM + c8) = ow; }
    }
    __syncthreads();
}

namespace att {
constexpr int KCH = 4112;
constexpr int L_K = 0, L_V = 8 * KCH, L_O = L_V + 32768, OST = 8704, L_WS = L_O + 8 * OST, L_END = L_WS + 8 * 128;
static_assert(L_END <= RING_BYTES, "attention LDS");
typedef short s16x4 __attribute__((ext_vector_type(4)));
typedef float f32x16 __attribute__((ext_vector_type(16)));
typedef short v4i16_t __attribute__((ext_vector_type(4)));
__device__ __forceinline__ int crow(int r, int hi) { return (r & 3) + 8 * (r >> 2) + 4 * hi; }
__device__ __forceinline__ s16x4 vtr(const LAS unsigned char* p) { return __builtin_bit_cast(s16x4, __builtin_amdgcn_ds_read_tr16_b64_v4i16((LAS v4i16_t*)p)); }

__device__ __forceinline__ void attn_unit(Frame& F, int b, int kvh, int blk) {
    const bf16_t* Q = (const bf16_t*)(F.ws + WS_Q); const bf16_t* KV = (const bf16_t*)(F.ws + WS_KV); bf16_t* Y = (bf16_t*)(F.ws + WS_H);
    const float* sinks = F.in[11]; const float* outg = F.in[12];
    LAS unsigned char* lds = F.lds + RING_OFF;
    const int lane = F.lane, r32 = lane & 31, hi = lane >> 5, wave = F.wave;
    const int t0 = b * SEQ + blk * 128;
    bf16x8 qrr[2][4];
#pragma unroll
    for (int wi = 0; wi < 2; ++wi) { const int wu = wave + 8 * wi, hq = wu >> 2, sub = wu & 3;
        const bf16_t* qrow = Q + (size_t)(t0 + 32 * sub + r32) * DATTN + (kvh * 4 + hq) * 64 + hi * 8;
#pragma unroll
        for (int s = 0; s < 4; ++s) qrr[wi][s] = *(const bf16x8*)(qrow + 16 * s); }
    {
        u32x4 kq[4], vq[4];
#pragma unroll
        for (int i = 0; i < 4; ++i) { const int p = F.tid + 512 * i, key = p >> 3, ch = p & 7; const bool valid = (blk > 0) || key >= 128;
            const int tk = valid ? t0 - 128 + key : t0;
            const bf16_t* gk = KV + (size_t)tk * 256 + kvh * 64 + ch * 8;
            kq[i] = *(const u32x4*)gk; vq[i] = *(const u32x4*)(gk + 128);
            if (!valid) { kq[i] = (u32x4){0u, 0u, 0u, 0u}; vq[i] = kq[i]; } }
#pragma unroll
        for (int i = 0; i < 4; ++i) { const int p = F.tid + 512 * i, key = p >> 3, ch = p & 7;
            *(LAS u32x4*)(lds + L_K + ch * KCH + key * 16) = kq[i];
            *(LAS u32x4*)(lds + L_V + (key >> 6) * 8192 + ((ch >> 2) * 4 + ((key & 63) >> 4)) * 1024 + (key & 15) * 64 + (ch & 3) * 16) = vq[i]; }
    }
    __syncthreads();
    const int vlane = (4 * hi + ((lane & 15) >> 2)) * 64 + ((lane >> 4) & 1) * 32 + (lane & 3) * 8;
#pragma unroll
    for (int wi = 0; wi < 2; ++wi) {
        const int wu = wave + 8 * wi, hq = wu >> 2, sub = wu & 3, i0 = 32 * sub, h = kvh * 4 + hq;
        bf16x8 qr[4];
#pragma unroll
        for (int s = 0; s < 4; ++s) qr[s] = qrr[wi][s];
        f32x16 st[5];
#pragma unroll
        for (int t = 0; t < 5; ++t) {
#pragma unroll
            for (int r = 0; r < 16; ++r) st[t][r] = 0.f;
#pragma unroll
            for (int s = 0; s < 4; ++s) { const bf16x8 kf = *(const LAS bf16x8*)(lds + L_K + (2 * s + hi) * KCH + (i0 + 32 * t + r32) * 16);
                st[t] = __builtin_amdgcn_mfma_f32_32x32x16_bf16(kf, qr[s], st[t], 0, 0, 0); } }
        const float sinkl = sinks[h] * LOG2E;
        float m = sinkl;
#pragma unroll
        for (int t = 0; t < 5; ++t)
#pragma unroll
            for (int r = 0; r < 16; ++r) { const int cj = crow(r, hi); bool ok = true;
                if (t == 0) ok = cj >= r32 + 1; if (t == 4) ok = cj <= r32;
                if (blk == 0) ok = ok && (i0 + 32 * t + cj >= 128);
                const float v = ok ? st[t][r] : -1e30f; st[t][r] = v; m = fmaxf(m, v); }
        m = fmaxf(m, __shfl_xor(m, 32));
        float l = 0.f;
#pragma unroll
        for (int t = 0; t < 5; ++t)
#pragma unroll
            for (int r = 0; r < 16; ++r) { const float pv = __builtin_amdgcn_exp2f(st[t][r] - m); st[t][r] = pv; l += pv; }
        l += __shfl_xor(l, 32); l += __builtin_amdgcn_exp2f(sinkl - m);
        f32x16 o[2];
#pragma unroll
        for (int r = 0; r < 16; ++r) { o[0][r] = 0.f; o[1][r] = 0.f; }
#pragma unroll
        for (int t = 0; t < 5; ++t)
#pragma unroll
            for (int s2 = 0; s2 < 2; ++s2) {
                u32x4 pw; pw.x = cvt_pk_bf16(st[t][8 * s2 + 0], st[t][8 * s2 + 1]); pw.y = cvt_pk_bf16(st[t][8 * s2 + 2], st[t][8 * s2 + 3]); pw.z = cvt_pk_bf16(st[t][8 * s2 + 4], st[t][8 * s2 + 5]); pw.w = cvt_pk_bf16(st[t][8 * s2 + 6], st[t][8 * s2 + 7]);
                const bf16x8 pa = __builtin_bit_cast(bf16x8, pw);
                const int kk0 = i0 + 32 * t + 16 * s2, g = kk0 >> 6, pc = (kk0 & 63) >> 4;
#pragma unroll
                for (int d0 = 0; d0 < 2; ++d0) { const LAS unsigned char* vb = lds + L_V + g * 8192 + (d0 * 4 + pc) * 1024 + vlane;
                    const s16x4 lo = vtr(vb), hh = vtr(vb + 512);
                    const bf16x8 vf = (bf16x8){lo[0], lo[1], lo[2], lo[3], hh[0], hh[1], hh[2], hh[3]};
                    o[d0] = __builtin_amdgcn_mfma_f32_32x32x16_bf16(pa, vf, o[d0], 0, 0, 0); } }
        LAS float* wsf = (LAS float*)(lds + L_WS + wave * 128);
        LAS float* ost = (LAS float*)(lds + L_O + wave * OST);
        if (hi == 0) wsf[r32] = l;
#pragma unroll
        for (int r = 0; r < 16; ++r) { const int q = crow(r, hi); ost[q * 68 + r32] = o[0][r]; ost[q * 68 + 32 + r32] = o[1][r]; }
        LDS_WAIT(); asm volatile("" ::: "memory");
        { const int q = lane >> 1, half = lane & 1; const float rl = 1.f / wsf[q];
          f32x4 v[8]; float ss = 0.f;
#pragma unroll
          for (int j = 0; j < 8; ++j) { v[j] = *(const LAS f32x4*)(ost + q * 68 + half * 32 + 4 * j) * rl; ss += (v[j][0] * v[j][0] + v[j][1] * v[j][1]) + (v[j][2] * v[j][2] + v[j][3] * v[j][3]); }
          ss += __shfl_xor(ss, 1);
          const float rr = rsqrtf(ss * (1.f / 64.f) + EPS);
          const float* gp = outg + h * 64 + half * 32; bf16_t* yp = Y + (size_t)(t0 + i0 + q) * DM + DCONV + h * 64 + half * 32;
#pragma unroll
          for (int j = 0; j < 4; ++j) { const f32x4 a = v[2 * j] * rr * *(const f32x4*)(gp + 8 * j), c2 = v[2 * j + 1] * rr * *(const f32x4*)(gp + 8 * j + 4);
              u32x4 ow; ow.x = pk2(a[0], a[1]); ow.y = pk2(a[2], a[3]); ow.z = pk2(c2[0], c2[1]); ow.w = pk2(c2[2], c2[3]);
              *(u32x4*)(yp + 8 * j) = ow; } }
        LDS_WAIT(); asm volatile("" ::: "memory");
    }
    __syncthreads();
}
}

__device__ __forceinline__ void p3_attn_only(Frame& F) {
    for (int u = blockIdx.x; u < NBATCH * NKV * (SEQ / 128); u += F.G) { const int blk = u & 31, kvh = (u >> 5) & 1, b = u >> 6; att::attn_unit(F, b, kvh, blk); }
}
__device__ __forceinline__ void p3_conv_only(Frame& F) {
    for (int u = blockIdx.x; u < T / 32; u += F.G) conv_unit(F, 32 * u);
}
__device__ __forceinline__ void p3_mixers(Frame& F) {
#ifndef SKIP_ATTN
    for (int u = blockIdx.x; u < NBATCH * NKV * (SEQ / 128); u += F.G) { const int blk = u & 31, kvh = (u >> 5) & 1, b = u >> 6; att::attn_unit(F, b, kvh, blk); }
#endif
#ifndef SKIP_CONV
    for (int u = blockIdx.x; u < T / 32; u += F.G) conv_unit(F, 32 * u);
#endif
}

struct OutProj {
    static constexpr bool PERM = true;
    int K, G, c; const bf16_t* A; const bf16_t* Bt; const float* bo; bf16_t* MIX;
    __device__ __forceinline__ bool next(int i, pg8::Unit& u) const { u.e = 0; return pg8::static_next(i, G, c, T / 256, DM / 256, u.pm, u.pn); }
    __device__ __forceinline__ const char* a_base(const pg8::Unit& u) const { return (const char*)A + (size_t)u.pm * 256 * K * 2; }
    __device__ __forceinline__ const char* b_base(const pg8::Unit& u) const { return (const char*)Bt + (size_t)u.pn * 256 * K * 2; }
    __device__ __forceinline__ void a_voff(const pg8::Unit&, const int (&R)[2], const int (&C)[2], unsigned (&v)[2][2]) const {
#pragma unroll
        for (int i = 0; i < 2; ++i) { v[0][i] = (unsigned)(R[i] * K + C[i]) * 2u; v[1][i] = v[0][i] + (unsigned)(128 * K * 2); } }
    __device__ __forceinline__ void epi(const f32x4 (&acc)[2][2][4][2], const pg8::Unit& u, int wr, int wc, int fr, int fq) const {
        const int row0 = u.pm * 256 + wr * 64 + fr; const int col0 = u.pn * 256 + wc * 32 + 8 * fq;
        f32x4 bv[2][2];
#pragma unroll
        for (int bj = 0; bj < 2; ++bj)
#pragma unroll
            for (int n = 0; n < 2; ++n) bv[bj][n] = *(const f32x4*)(bo + col0 + bj * 128 + 4 * n);
#pragma unroll
        for (int ai = 0; ai < 2; ++ai)
#pragma unroll
            for (int m = 0; m < 4; ++m) { bf16_t* rowp = MIX + (size_t)(row0 + ai * 128 + m * 16) * DM + col0;
#pragma unroll
                for (int bj = 0; bj < 2; ++bj) { const f32x4 v0 = acc[ai][bj][m][0] + bv[bj][0], v1 = acc[ai][bj][m][1] + bv[bj][1];
                    u32x4 w; w.x = cvt_pk_bf16(v0[0], v0[1]); w.y = cvt_pk_bf16(v0[2], v0[3]); w.z = cvt_pk_bf16(v1[0], v1[1]); w.w = cvt_pk_bf16(v1[2], v1[3]);
                    *(u32x4*)(rowp + bj * 128) = w; } }
    }
};

constexpr int TAB_OFF = LDSCTL_OFF + 1024;
__device__ __forceinline__ void build_route_table(Frame& F) {
    volatile LAS int* tab = (volatile LAS int*)(F.lds + TAB_OFF);
    if (F.tid == 0) { int tp = 0;
        for (int e = 0; e < NE; ++e) { const int cn = (int)__hip_atomic_load(F.ctl + CW_ECNT + 64 * e, RLX_AGENT); tab[e] = cn; tab[32 + e] = tp; tp += (cn + 255) >> 8; }
        tab[64] = tp; }
    __syncthreads();
}

struct P5Chunk { f32x4 z0, z1, s0, s1, h0, h1; bf16x8 bh[3], bl[3]; };
__device__ __forceinline__ void p5_load(P5Chunk& c, const float* xr, const float* sc2, const float* sh2, const bf16_t* wr_hi, const bf16_t* wr_lo, int kc, int kq, int i16) {
    const int k0 = kc + 8 * kq;
    c.z0 = *(const f32x4*)(xr + kc); c.z1 = *(const f32x4*)(xr + kc + 4);
    c.s0 = *(const f32x4*)(sc2 + k0); c.s1 = *(const f32x4*)(sc2 + k0 + 4); c.h0 = *(const f32x4*)(sh2 + k0); c.h1 = *(const f32x4*)(sh2 + k0 + 4);
#pragma unroll
    for (int ct = 0; ct < 3; ++ct) { const size_t wo = (size_t)(16 * ct + i16) * DM + k0; c.bh[ct] = *(const bf16x8*)(wr_hi + wo); c.bl[ct] = *(const bf16x8*)(wr_lo + wo); }
}
__device__ __forceinline__ void p5_rows(Frame& F) {
    float* X = F.out; const float* xin = F.in[0]; const bf16_t* MIX = (const bf16_t*)(F.ws + WS_MIX); bf16_t* H2 = (bf16_t*)(F.ws + WS_H2);
    const float* ln_g = F.in[15]; const float* ln_b = F.in[16]; const float* mod = (const float*)(F.ws + WS_MOD);
    const bf16_t* wr_hi = (const bf16_t*)(F.ws + WS_WR); const bf16_t* wr_lo = wr_hi + 48 * DM;
    const float* brg = F.in[18]; const float* bre = F.in[20];
    int* list = (int*)(F.ws + WS_LIST); unsigned* tokrec = (unsigned*)(F.ws + WS_TOK);
    LAS float* lg = (LAS float*)(F.lds + RING_OFF + F.wave * 3072);
    volatile LAS int* lcnt = (volatile LAS int*)(F.lds + RING_OFF + 24576);
    const int lane = F.lane, i16 = lane & 15, kq = lane >> 4;
    for (int tile = blockIdx.x; tile < T / 128; tile += F.G) {
        if (F.tid < 64) lcnt[F.tid] = 0;
        __syncthreads();
        const int rbase = tile * 128 + F.wave * 16; const int b = (tile * 128) / SEQ;
        const float* sc2 = mod + b * 6 * DM + 4 * DM; const float* sh2 = mod + b * 6 * DM + 3 * DM;
        {
            const float* g1 = mod + b * 6 * DM + 2 * DM;
            f32x4 gg[4], lgv[4], lbv[4];
#pragma unroll
            for (int j = 0; j < 4; ++j) { const int col = 4 * lane + 256 * j; gg[j] = *(const f32x4*)(g1 + col); lgv[j] = *(const f32x4*)(ln_g + col); lbv[j] = *(const f32x4*)(ln_b + col); }
#pragma unroll 1
            for (int rb = 0; rb < 16; rb += 4) {
                f32x4 z[4][4]; u32x2 mv[4][4];
#pragma unroll
                for (int r = 0; r < 4; ++r)
#pragma unroll
                    for (int j = 0; j < 4; ++j) { const size_t o = (size_t)(rbase + rb + r) * DM + 4 * lane + 256 * j; z[r][j] = *(const f32x4*)(xin + o); mv[r][j] = *(const u32x2*)(MIX + o); }
                float sm[4];
#pragma unroll
                for (int r = 0; r < 4; ++r) { sm[r] = 0.f;
#pragma unroll
                    for (int j = 0; j < 4; ++j) { f32x4 m4; m4[0] = __builtin_bit_cast(float, mv[r][j].x << 16); m4[1] = __builtin_bit_cast(float, mv[r][j].x & 0xffff0000u); m4[2] = __builtin_bit_cast(float, mv[r][j].y << 16); m4[3] = __builtin_bit_cast(float, mv[r][j].y & 0xffff0000u);
                        z[r][j] = z[r][j] * ALPHA + gg[j] * m4; sm[r] += (z[r][j][0] + z[r][j][1]) + (z[r][j][2] + z[r][j][3]); } }
#pragma unroll
                for (int o = 1; o < 64; o <<= 1) {
#pragma unroll
                    for (int r = 0; r < 4; ++r) sm[r] += __shfl_xor(sm[r], o); }
                float sq[4];
#pragma unroll
                for (int r = 0; r < 4; ++r) { const float mean = sm[r] * (1.f / DM); sq[r] = 0.f;
#pragma unroll
                    for (int j = 0; j < 4; ++j) { z[r][j] = z[r][j] - mean; sq[r] += (z[r][j][0] * z[r][j][0] + z[r][j][1] * z[r][j][1]) + (z[r][j][2] * z[r][j][2] + z[r][j][3] * z[r][j][3]); } }
#pragma unroll
                for (int o = 1; o < 64; o <<= 1) {
#pragma unroll
                    for (int r = 0; r < 4; ++r) sq[r] += __shfl_xor(sq[r], o); }
#pragma unroll
                for (int r = 0; r < 4; ++r) { const float rstd = rsqrtf(sq[r] * (1.f / DM) + EPS);
#pragma unroll
                    for (int j = 0; j < 4; ++j) { const size_t o = (size_t)(rbase + rb + r) * DM + 4 * lane + 256 * j; *(f32x4*)(X + o) = z[r][j] * rstd * lgv[j] + lbv[j]; } }
            }
            asm volatile("s_waitcnt vmcnt(0)" ::: "memory");
        }
        const int row = rbase + i16;
        f32x4 acc[3];
#pragma unroll
        for (int ct = 0; ct < 3; ++ct) acc[ct] = (f32x4){0.f, 0.f, 0.f, 0.f};
        const float* xr = X + (size_t)row * DM + 8 * kq; bf16_t* hr = H2 + (size_t)row * DM + 8 * kq;
        P5Chunk cur; p5_load(cur, xr, sc2, sh2, wr_hi, wr_lo, 0, kq, i16);
#pragma unroll 2
        for (int kc = 0; kc < DM; kc += 32) {
            P5Chunk nxt; { const int kn = (kc + 32 < DM) ? kc + 32 : kc; p5_load(nxt, xr, sc2, sh2, wr_hi, wr_lo, kn, kq, i16); }
            const f32x4 t0 = cur.z0 * (cur.s0 + 1.f) + cur.h0, t1 = cur.z1 * (cur.s1 + 1.f) + cur.h1;
            u32x4 hw; hw.x = pk2(t0[0], t0[1]); hw.y = pk2(t0[2], t0[3]); hw.z = pk2(t1[0], t1[1]); hw.w = pk2(t1[2], t1[3]);
            *(u32x4*)(hr + kc) = hw;
            u32x4 lw;
            lw.x = pk2(t0[0] - __builtin_bit_cast(float, hw.x << 16), t0[1] - __builtin_bit_cast(float, hw.x & 0xffff0000u));
            lw.y = pk2(t0[2] - __builtin_bit_cast(float, hw.y << 16), t0[3] - __builtin_bit_cast(float, hw.y & 0xffff0000u));
            lw.z = pk2(t1[0] - __builtin_bit_cast(float, hw.z << 16), t1[1] - __builtin_bit_cast(float, hw.z & 0xffff0000u));
            lw.w = pk2(t1[2] - __builtin_bit_cast(float, hw.w << 16), t1[3] - __builtin_bit_cast(float, hw.w & 0xffff0000u));
            const bf16x8 ah = __builtin_bit_cast(bf16x8, hw), al = __builtin_bit_cast(bf16x8, lw);
#pragma unroll
            for (int ct = 0; ct < 3; ++ct) {
                acc[ct] = __builtin_amdgcn_mfma_f32_16x16x32_bf16(ah, cur.bh[ct], acc[ct], 0, 0, 0);
                acc[ct] = __builtin_amdgcn_mfma_f32_16x16x32_bf16(ah, cur.bl[ct], acc[ct], 0, 0, 0);
                acc[ct] = __builtin_amdgcn_mfma_f32_16x16x32_bf16(al, cur.bh[ct], acc[ct], 0, 0, 0); }
            cur = nxt;
        }
#pragma unroll
        for (int ct = 0; ct < 3; ++ct)
#pragma unroll
            for (int r = 0; r < 4; ++r) lg[(4 * kq + r) * 48 + 16 * ct + i16] = acc[ct][r];
        LDS_WAIT(); asm volatile("" ::: "memory");
        int e1 = 0, e2 = 0, rk1 = 0, rk2 = 0; float w1 = 0.f, w2 = 0.f;
        if (lane < 16) {
            const LAS float* L = lg + lane * 48;
            float gl[4];
#pragma unroll
            for (int j = 0; j < 4; ++j) gl[j] = L[j] + brg[j];
            int gi = 0; float gm = gl[0];
#pragma unroll
            for (int j = 1; j < 4; ++j) if (gl[j] > gm) { gm = gl[j]; gi = j; }
            float gs = 0.f;
#pragma unroll
            for (int j = 0; j < 4; ++j) gs += __expf(gl[j] - gm);
            const float ptop = 1.f / gs;
            float el[8];
#pragma unroll
            for (int j = 0; j < 8; ++j) el[j] = L[4 + gi * 8 + j] + bre[gi * 8 + j];
            int i1 = 0; float m1 = el[0];
#pragma unroll
            for (int j = 1; j < 8; ++j) if (el[j] > m1) { m1 = el[j]; i1 = j; }
            int i2 = -1; float m2 = -3e38f;
#pragma unroll
            for (int j = 0; j < 8; ++j) if (j != i1 && el[j] > m2) { m2 = el[j]; i2 = j; }
            const float pb = __expf(m2 - m1), inv = ptop / (1.f + pb);
            e1 = gi * 8 + i1; e2 = gi * 8 + i2; w1 = inv; w2 = pb * inv;
            rk1 = __hip_atomic_fetch_add((LAS int*)lcnt + e1, 1, __ATOMIC_RELAXED, __HIP_MEMORY_SCOPE_WORKGROUP);
            rk2 = __hip_atomic_fetch_add((LAS int*)lcnt + e2, 1, __ATOMIC_RELAXED, __HIP_MEMORY_SCOPE_WORKGROUP);
        }
        __syncthreads();
        if (F.tid < 32) { const int n = lcnt[F.tid]; int base = 0; if (n > 0) base = (int)__hip_atomic_fetch_add(F.ctl + CW_ECNT + 64 * F.tid, (unsigned)n, RLX_AGENT); lcnt[32 + F.tid] = base; }
        __syncthreads();
        if (lane < 16) { const int tok = tile * 128 + F.wave * 16 + lane; const int s1 = lcnt[32 + e1] + rk1, s2 = lcnt[32 + e2] + rk2;
            list[(size_t)e1 * T + s1] = tok; list[(size_t)e2 * T + s2] = tok;
            u32x4 r0; r0.x = (unsigned)e1; r0.y = (unsigned)s1; r0.z = (unsigned)e2; r0.w = (unsigned)s2;
            u32x4 r1; r1.x = __builtin_bit_cast(unsigned, w1); r1.y = __builtin_bit_cast(unsigned, w2); r1.z = 0u; r1.w = 0u;
            *(u32x4*)(tokrec + (size_t)tok * 8) = r0; *(u32x4*)(tokrec + (size_t)tok * 8 + 4) = r1; }
        __syncthreads();
    }
}

__device__ __forceinline__ bool moe_next(const volatile LAS int* tab, int i, int G, int c, int NT, pg8::Unit& u) {
    const int nwg = tab[64] * NT; const long L = (long)i * G + c; if (L >= nwg) return false;
    int wgid = (int)L; { const int q = nwg / 8, r = nwg % 8, xcd = wgid % 8, off = wgid / 8; wgid = (xcd < r ? xcd * (q + 1) : r * (q + 1) + (xcd - r) * q) + off; }
    const int mtg = wgid / NT; int e = 0;
    for (int k = 1; k < NE; ++k) e += (tab[32 + k] <= mtg) ? 1 : 0;
    u.e = __builtin_amdgcn_readfirstlane(e); u.pm = __builtin_amdgcn_readfirstlane(mtg - tab[32 + e]); u.pn = __builtin_amdgcn_readfirstlane(wgid % NT); return true;
}
struct MoeUp {
    static constexpr bool PERM = true;
    int K, G, c; const volatile LAS int* tab; const bf16_t* H2; const bf16_t* WGU; const int* list; bf16_t* ACT;
    __device__ __forceinline__ bool next(int i, pg8::Unit& u) const { return moe_next(tab, i, G, c, 2, u); }
    __device__ __forceinline__ const char* a_base(const pg8::Unit&) const { return (const char*)H2; }
    __device__ __forceinline__ const char* b_base(const pg8::Unit& u) const { return (const char*)WGU + ((size_t)u.e * 512 + u.pn * 256) * K * 2; }
    __device__ __forceinline__ void a_voff(const pg8::Unit& u, const int (&R)[2], const int (&C)[2], unsigned (&v)[2][2]) const {
        const int cn = tab[u.e]; const int* lp = list + (size_t)u.e * T;
#pragma unroll
        for (int h = 0; h < 2; ++h)
#pragma unroll
            for (int i = 0; i < 2; ++i) { const int idx = u.pm * 256 + h * 128 + R[i]; const int tok = lp[idx < cn ? idx : 0]; v[h][i] = (unsigned)(tok * K + C[i]) * 2u; } }
    __device__ __forceinline__ void epi(const f32x4 (&acc)[2][2][4][2], const pg8::Unit& u, int wr, int wc, int fr, int fq) const {
        const int row0 = tab[32 + u.e] * 256 + u.pm * 256 + wr * 64 + fr;
        bf16_t* base = ACT + u.pn * 128 + wc * 32 + 8 * fq;
#pragma unroll
        for (int ai = 0; ai < 2; ++ai)
#pragma unroll
            for (int m = 0; m < 4; ++m) { bf16_t* rowp = base + (size_t)(row0 + ai * 128 + m * 16) * DE;
                f32x4 g0 = acc[ai][0][m][0], g1 = acc[ai][0][m][1]; const f32x4 u0 = acc[ai][1][m][0], u1 = acc[ai][1][m][1];
#pragma unroll
                for (int j = 0; j < 4; ++j) { g0[j] = fast_silu(g0[j]) * u0[j]; g1[j] = fast_silu(g1[j]) * u1[j]; }
                u32x4 w; w.x = cvt_pk_bf16(g0[0], g0[1]); w.y = cvt_pk_bf16(g0[2], g0[3]); w.z = cvt_pk_bf16(g1[0], g1[1]); w.w = cvt_pk_bf16(g1[2], g1[3]);
                *(u32x4*)rowp = w; }
    }
};
struct MoeDown {
    static constexpr bool PERM = true;
    int K, G, c; const volatile LAS int* tab; const bf16_t* ACT; const bf16_t* WD; bf16_t* YS;
    __device__ __forceinline__ bool next(int i, pg8::Unit& u) const { return moe_next(tab, i, G, c, 4, u); }
    __device__ __forceinline__ const char* a_base(const pg8::Unit& u) const { return (const char*)ACT + ((size_t)tab[32 + u.e] * 256 + u.pm * 256) * K * 2; }
    __device__ __forceinline__ const char* b_base(const pg8::Unit& u) const { return (const char*)WD + ((size_t)u.e * DM + u.pn * 256) * K * 2; }
    __device__ __forceinline__ void a_voff(const pg8::Unit&, const int (&R)[2], const int (&C)[2], unsigned (&v)[2][2]) const {
#pragma unroll
        for (int i = 0; i < 2; ++i) { v[0][i] = (unsigned)(R[i] * K + C[i]) * 2u; v[1][i] = v[0][i] + (unsigned)(128 * K * 2); } }
    __device__ __forceinline__ void epi(const f32x4 (&acc)[2][2][4][2], const pg8::Unit& u, int wr, int wc, int fr, int fq) const {
        const int row0 = tab[32 + u.e] * 256 + u.pm * 256 + wr * 64 + fr;
        bf16_t* base = YS + u.pn * 256 + wc * 32 + 8 * fq;
#pragma unroll
        for (int ai = 0; ai < 2; ++ai)
#pragma unroll
            for (int m = 0; m < 4; ++m) { bf16_t* rowp = base + (size_t)(row0 + ai * 128 + m * 16) * DM;
#pragma unroll
                for (int bj = 0; bj < 2; ++bj) { const f32x4 v0 = acc[ai][bj][m][0], v1 = acc[ai][bj][m][1];
                    u32x4 w; w.x = cvt_pk_bf16(v0[0], v0[1]); w.y = cvt_pk_bf16(v0[2], v0[3]); w.z = cvt_pk_bf16(v1[0], v1[1]); w.w = cvt_pk_bf16(v1[2], v1[3]);
                    *(u32x4*)(rowp + bj * 128) = w; } }
    }
};

__device__ __forceinline__ void p8_final(Frame& F) {
    float* X = F.out; const bf16_t* YS = (const bf16_t*)(F.ws + WS_YS); const unsigned* tokrec = (const unsigned*)(F.ws + WS_TOK);
    const float* mod = (const float*)(F.ws + WS_MOD); const float* lg = F.in[24]; const float* lb = F.in[25];
    volatile LAS int* tab = (volatile LAS int*)(F.lds + TAB_OFF);
    const int lane = F.lane; const int gw = blockIdx.x * NWAVES + F.wave, NGW = F.G * NWAVES;
    f32x4 lgv[4], lbv[4];
#pragma unroll
    for (int j = 0; j < 4; ++j) { const int col = 4 * lane + 256 * j; lgv[j] = *(const f32x4*)(lg + col); lbv[j] = *(const f32x4*)(lb + col); }
#pragma unroll 1
    for (int base = gw; base < T; base += 2 * NGW) {
        int tr[2]; bool ok[2]; u32x4 r0[2]; u32x2 r1[2];
#pragma unroll
        for (int r = 0; r < 2; ++r) { const int t = base + r * NGW; ok[r] = t < T; tr[r] = ok[r] ? t : base; r0[r] = *(const u32x4*)(tokrec + (size_t)tr[r] * 8); r1[r] = *(const u32x2*)(tokrec + (size_t)tr[r] * 8 + 4); }
        f32x4 z[2][4]; u32x2 ya[2][4], yb[2][4]; float w1[2], w2[2]; f32x4 gv[2][4];
#pragma unroll
        for (int r = 0; r < 2; ++r) {
            const int e1 = __builtin_amdgcn_readfirstlane((int)r0[r].x), s1 = __builtin_amdgcn_readfirstlane((int)r0[r].y), e2 = __builtin_amdgcn_readfirstlane((int)r0[r].z), s2 = __builtin_amdgcn_readfirstlane((int)r0[r].w);
            w1[r] = __builtin_bit_cast(float, __builtin_amdgcn_readfirstlane(r1[r].x)); w2[r] = __builtin_bit_cast(float, __builtin_amdgcn_readfirstlane(r1[r].y));
            const size_t ra = (size_t)(tab[32 + e1] * 256 + s1), rb = (size_t)(tab[32 + e2] * 256 + s2);
            const float* g2 = mod + (tr[r] / SEQ) * 6 * DM + 5 * DM;
#pragma unroll
            for (int j = 0; j < 4; ++j) { const int col = 4 * lane + 256 * j;
                z[r][j] = *(const f32x4*)(X + (size_t)tr[r] * DM + col); gv[r][j] = *(const f32x4*)(g2 + col);
                ya[r][j] = *(const u32x2*)(YS + ra * DM + col); yb[r][j] = *(const u32x2*)(YS + rb * DM + col); } }
        float sm[2];
#pragma unroll
        for (int r = 0; r < 2; ++r) { sm[r] = 0.f;
#pragma unroll
            for (int j = 0; j < 4; ++j) { f32x4 f;
                f[0] = w1[r] * __builtin_bit_cast(float, ya[r][j].x << 16) + w2[r] * __builtin_bit_cast(float, yb[r][j].x << 16);
                f[1] = w1[r] * __builtin_bit_cast(float, ya[r][j].x & 0xffff0000u) + w2[r] * __builtin_bit_cast(float, yb[r][j].x & 0xffff0000u);
                f[2] = w1[r] * __builtin_bit_cast(float, ya[r][j].y << 16) + w2[r] * __builtin_bit_cast(float, yb[r][j].y << 16);
                f[3] = w1[r] * __builtin_bit_cast(float, ya[r][j].y & 0xffff0000u) + w2[r] * __builtin_bit_cast(float, yb[r][j].y & 0xffff0000u);
                z[r][j] = z[r][j] * ALPHA + gv[r][j] * f; sm[r] += (z[r][j][0] + z[r][j][1]) + (z[r][j][2] + z[r][j][3]); } }
#pragma unroll
        for (int o = 1; o < 64; o <<= 1) {
#pragma unroll
            for (int r = 0; r < 2; ++r) sm[r] += __shfl_xor(sm[r], o); }
        float sq[2];
#pragma unroll
        for (int r = 0; r < 2; ++r) { const float mean = sm[r] * (1.f / DM); sq[r] = 0.f;
#pragma unroll
            for (int j = 0; j < 4; ++j) { z[r][j] = z[r][j] - mean; sq[r] += (z[r][j][0] * z[r][j][0] + z[r][j][1] * z[r][j][1]) + (z[r][j][2] * z[r][j][2] + z[r][j][3] * z[r][j][3]); } }
#pragma unroll
        for (int o = 1; o < 64; o <<= 1) {
#pragma unroll
            for (int r = 0; r < 2; ++r) sq[r] += __shfl_xor(sq[r], o); }
#pragma unroll
        for (int r = 0; r < 2; ++r) { const float rstd = rsqrtf(sq[r] * (1.f / DM) + EPS);
            if (ok[r]) {
#pragma unroll
                for (int j = 0; j < 4; ++j) { const int col = 4 * lane + 256 * j; *(f32x4*)(X + (size_t)tr[r] * DM + col) = z[r][j] * rstd * lgv[j] + lbv[j]; } } }
    }
}

__global__ void __launch_bounds__(NWAVES * 64, 2) mega_fwd(Args args) {
    extern __shared__ __attribute__((aligned(16))) unsigned char lds[];
    Frame F;
    F.lds = (LAS unsigned char*)lds;
    F.MISC = (volatile LAS unsigned*)(F.lds + MISC_OFF);
    F.tid = threadIdx.x; F.lane = F.tid & 63; F.wave = __builtin_amdgcn_readfirstlane(F.tid >> 6);
    F.G = gridDim.x; { const int bx = blockIdx.x; F.vcu = (F.G % 8 == 0) ? (bx % 8) * (F.G / 8) + bx / 8 : bx; }
    F.ws = args.ws; F.out = args.out; F.ctl = (gu32*)(args.ws + WS_CTL);
#pragma unroll
    for (int i = 0; i < 26; ++i) F.in[i] = args.in[i];
    for (int u = F.tid; u < (LDS_BYTES - LDSCTL_OFF) / 4; u += NWAVES * 64) ((LAS unsigned*)(F.lds + LDSCTL_OFF))[u] = 0u;
    __syncthreads();
    XcdBarrier bar = xcd_barrier_post((unsigned*)(F.ctl + CW_BAR), F.MISC + 8);
    const int lo = args.ph_lo, hi = args.ph_hi;
#define IN(k) (lo <= (k) && (k) < hi)
#define BOTH(k) (IN(k) && IN((k) + 1))
    if (IN(0)) { p0_prologue(F); if (DUP_PHASE == 0) { xcd_barrier(bar); p0_prologue(F); } if (BOTH(0)) xcd_barrier(bar); }
    if (IN(1)) { p1_modulate(F); if (DUP_PHASE == 1) { xcd_barrier(bar); p1_modulate(F); } if (BOTH(1)) xcd_barrier(bar); }
    if (IN(2)) {
        InProj S; S.K = DM; S.G = F.G; S.c = (int)blockIdx.x; S.A = (const bf16_t*)(F.ws + WS_H); S.Bt = (const bf16_t*)(F.ws + WS_WI); S.bias = (const float*)(F.ws + WS_BPERM);
        S.VG = (bf16_t*)(F.ws + WS_VG); S.Q = (bf16_t*)(F.ws + WS_Q); S.KV = (bf16_t*)(F.ws + WS_KV);
        pg8::gemm_phase<InProj>(F.lds + RING_OFF, S);
        if (DUP_PHASE == 2) { xcd_barrier(bar); pg8::gemm_phase<InProj>(F.lds + RING_OFF, S); }
        if (BOTH(2)) xcd_barrier(bar);
    }
    if (IN(3)) { p3_mixers(F); if (DUP_PHASE == 3) { xcd_barrier(bar); p3_mixers(F); } if (DUP_PHASE == 30) { xcd_barrier(bar); p3_attn_only(F); } if (DUP_PHASE == 31) { xcd_barrier(bar); p3_conv_only(F); } if (BOTH(3)) xcd_barrier(bar); }
    if (IN(4)) {
        OutProj S; S.K = DM; S.G = F.G; S.c = (int)blockIdx.x; S.A = (const bf16_t*)(F.ws + WS_H); S.Bt = (const bf16_t*)(F.ws + WS_WO); S.bo = F.in[14]; S.MIX = (bf16_t*)(F.ws + WS_MIX);
        pg8::gemm_phase<OutProj>(F.lds + RING_OFF, S);
        if (DUP_PHASE == 4) { xcd_barrier(bar); pg8::gemm_phase<OutProj>(F.lds + RING_OFF, S); }
        if (BOTH(4)) xcd_barrier(bar);
    }
    if (IN(5)) { p5_rows(F); if (BOTH(5)) xcd_barrier(bar); }
    if (IN(6) || IN(7) || IN(8)) build_route_table(F);
    if (IN(6)) {
        MoeUp S; S.K = DM; S.G = F.G; S.c = (int)blockIdx.x; S.tab = (const volatile LAS int*)(F.lds + TAB_OFF); S.H2 = (const bf16_t*)(F.ws + WS_H2); S.WGU = (const bf16_t*)(F.ws + WS_WGU);
        S.list = (const int*)(F.ws + WS_LIST); S.ACT = (bf16_t*)(F.ws + WS_ACT);
        pg8::gemm_phase<MoeUp>(F.lds + RING_OFF, S);
        if (DUP_PHASE == 6) { xcd_barrier(bar); pg8::gemm_phase<MoeUp>(F.lds + RING_OFF, S); }
        if (BOTH(6)) xcd_barrier(bar);
    }
    if (IN(7)) {
        MoeDown S; S.K = DE; S.G = F.G; S.c = (int)blockIdx.x; S.tab = (const volatile LAS int*)(F.lds + TAB_OFF); S.ACT = (const bf16_t*)(F.ws + WS_ACT); S.WD = (const bf16_t*)(F.ws + WS_WD); S.YS = (bf16_t*)(F.ws + WS_YS);
        pg8::gemm_phase<MoeDown>(F.lds + RING_OFF, S);
        if (DUP_PHASE == 7) { xcd_barrier(bar); pg8::gemm_phase<MoeDown>(F.lds + RING_OFF, S); }
        if (BOTH(7)) xcd_barrier(bar);
    }
    if (IN(8)) { p8_final(F); }
#undef IN
#undef BOTH
}

namespace nv {
__device__ __forceinline__ float sigmoidf_(float v) { return 1.f / (1.f + __expf(-v)); }
__device__ __forceinline__ float siluf_(float v) { return v / (1.f + __expf(-v)); }
__global__ void __launch_bounds__(256) k_gemm(const float* A, const float* B, const float* bias, float* C, int M, int N, int K) {
    __shared__ float As[16][65]; __shared__ float Bs[16][64];
    int tx = threadIdx.x % 16, ty = threadIdx.x / 16; int m0 = blockIdx.y * 64, n0 = blockIdx.x * 64;
    float acc[4][4] = {};
    for (int k0 = 0; k0 < K; k0 += 16) {
        for (int i = threadIdx.x; i < 64 * 16; i += 256) { int r = i / 16, kk = i % 16; As[kk][r] = A[(size_t)(m0 + r) * K + k0 + kk]; }
        for (int i = threadIdx.x; i < 16 * 64; i += 256) { int kk = i / 64, cc = i % 64; Bs[kk][cc] = B[(size_t)(k0 + kk) * N + n0 + cc]; }
        __syncthreads();
#pragma unroll
        for (int kk = 0; kk < 16; ++kk) { float a[4], b[4];
#pragma unroll
            for (int i = 0; i < 4; ++i) { a[i] = As[kk][ty * 4 + i]; b[i] = Bs[kk][tx * 4 + i]; }
#pragma unroll
            for (int i = 0; i < 4; ++i)
#pragma unroll
                for (int j = 0; j < 4; ++j) acc[i][j] += a[i] * b[j]; }
        __syncthreads();
    }
    for (int i = 0; i < 4; ++i) for (int j = 0; j < 4; ++j) { int r = m0 + ty * 4 + i, cc = n0 + tx * 4 + j; C[(size_t)r * N + cc] = acc[i][j] + (bias ? bias[cc] : 0.f); }
}
__device__ __forceinline__ float block_sum512(float v, float* red) {
    for (int o = 32; o > 0; o >>= 1) v += __shfl_xor(v, o);
    __syncthreads();
    if ((threadIdx.x & 63) == 0) red[threadIdx.x >> 6] = v;
    __syncthreads();
    float s = 0.f; for (int i = 0; i < 8; ++i) s += red[i];
    return s;
}
__global__ void __launch_bounds__(512) k_conv2(const bf16_t* VG, const float* conv_w, const float* conv_b, const float* lng, const float* lnb, const float* outg, float* ycat) {
    __shared__ float red[8];
    int t = blockIdx.x, c = threadIdx.x; int s = t % SEQ;
    float acc = 0.f;
    for (int j = 0; j < CW; ++j) { int ss = s - (CW - 1) + j; if (ss < 0) continue; acc += conv_w[j * DCONV + c] * bf2f(VG[(size_t)(t - (CW - 1) + j) * DCONV + c]); }
    acc += conv_b[c];
    float mean = block_sum512(acc, red) * (1.f / DCONV); float d = acc - mean;
    float var = block_sum512(d * d, red) * (1.f / DCONV);
    float y = d * rsqrtf(var + EPS) * lng[c] + lnb[c];
    y = siluf_(y);
    float q = y * y; for (int o = 32; o > 0; o >>= 1) q += __shfl_xor(q, o);
    y = y * rsqrtf(q * (1.f / 64.f) + EPS) * outg[c];
    ycat[(size_t)t * DM + c] = y;
}
__global__ void __launch_bounds__(512) k_attn2(const bf16_t* Q, const bf16_t* KV, const float* sinks, const float* outg, float* ycat) {
    __shared__ float ps[8][128];
    int t = blockIdx.x, h = threadIdx.x >> 6, lane = threadIdx.x & 63; int s = t % SEQ; int kvh = h / 4;
    const bf16_t* q = Q + (size_t)t * DATTN + h * HD;
    float sc[2];
    for (int i = 0; i < 2; ++i) { int d = lane + 64 * i; int ss = s - d; float v = -1e30f;
        if (ss >= 0) { const bf16_t* k = KV + (size_t)(t - d) * 256 + kvh * HD; float a = 0.f; for (int e = 0; e < HD; ++e) a += bf2f(q[e]) * bf2f(k[e]); v = a; }
        sc[i] = v; }
    float sk = sinks[h] * LOG2E; float m = fmaxf(fmaxf(sc[0], sc[1]), sk);
    for (int o = 32; o > 0; o >>= 1) m = fmaxf(m, __shfl_xor(m, o));
    float p0 = (sc[0] > -1e29f) ? exp2f(sc[0] - m) : 0.f, p1 = (sc[1] > -1e29f) ? exp2f(sc[1] - m) : 0.f;
    float l = p0 + p1; for (int o = 32; o > 0; o >>= 1) l += __shfl_xor(l, o);
    l += exp2f(sk - m);
    ps[h][lane] = p0 / l; ps[h][lane + 64] = p1 / l;
    __syncthreads();
    float o = 0.f; int nd = (s + 1 < WIN) ? s + 1 : WIN;
    for (int d = 0; d < nd; ++d) o += ps[h][d] * bf2f(KV[(size_t)(t - d) * 256 + DKV + kvh * HD + lane]);
    float qq = o * o; for (int oo = 32; oo > 0; oo >>= 1) qq += __shfl_xor(qq, oo);
    ycat[(size_t)t * DM + DCONV + h * HD + lane] = o * rsqrtf(qq * (1.f / 64.f) + EPS) * outg[h * HD + lane];
}
__device__ __forceinline__ float block_sum256(float v, float* red) {
    for (int o = 32; o > 0; o >>= 1) v += __shfl_xor(v, o);
    __syncthreads();
    if ((threadIdx.x & 63) == 0) red[threadIdx.x >> 6] = v;
    __syncthreads();
    return red[0] + red[1] + red[2] + red[3];
}
__global__ void __launch_bounds__(256) k_ln1(const float* x, const float* mix, const float* mod, const float* g, const float* bta, float* x1) {
    __shared__ float red[4];
    int t = blockIdx.x, b = t / SEQ; float z[4]; float s = 0.f;
    for (int i = 0; i < 4; ++i) { int c = threadIdx.x + 256 * i; z[i] = ALPHA * x[(size_t)t * DM + c] + mod[b * 6 * DM + 2 * DM + c] * mix[(size_t)t * DM + c]; s += z[i]; }
    float mean = block_sum256(s, red) * (1.f / DM); float q = 0.f;
    for (int i = 0; i < 4; ++i) { z[i] -= mean; q += z[i] * z[i]; }
    float rstd = rsqrtf(block_sum256(q, red) * (1.f / DM) + EPS);
    for (int i = 0; i < 4; ++i) { int c = threadIdx.x + 256 * i; x1[(size_t)t * DM + c] = z[i] * rstd * g[c] + bta[c]; }
}
__global__ void k_bf2f(const bf16_t* in, float* out, size_t n) { size_t i = (size_t)blockIdx.x * blockDim.x + threadIdx.x; if (i < n) out[i] = bf2f(in[i]); }
__global__ void __launch_bounds__(256) k_moe(float* io, const float* mod, const float* wrg, const float* brg, const float* wre, const float* bre,
                                            const float* wg, const float* wu, const float* wd, const float* g2ln, const float* b2ln) {
    __shared__ float h2[DM]; __shared__ float part[4][64]; __shared__ float logit[64]; __shared__ float act[DE]; __shared__ int se[2]; __shared__ float sw[2]; __shared__ float red[4];
    int t = blockIdx.x, b = t / SEQ, tid = threadIdx.x;
    float x1v[4];
    for (int i = 0; i < 4; ++i) { int c = tid + 256 * i; x1v[i] = io[(size_t)t * DM + c]; h2[c] = x1v[i] * (1.f + mod[b * 6 * DM + 4 * DM + c]) + mod[b * 6 * DM + 3 * DM + c]; }
    __syncthreads();
    { int j = tid & 63, kp = tid >> 6; float a = 0.f;
      if (j < 36) { for (int k = kp * 256; k < kp * 256 + 256; ++k) a += h2[k] * (j < 4 ? wrg[k * NG + j] : wre[k * NE + (j - 4)]); }
      part[kp][j] = a; }
    __syncthreads();
    if (tid < 36) logit[tid] = part[0][tid] + part[1][tid] + part[2][tid] + part[3][tid] + (tid < 4 ? brg[tid] : bre[tid - 4]);
    __syncthreads();
    if (tid == 0) {
        float m = logit[0]; int gi = 0; for (int i = 1; i < 4; ++i) if (logit[i] > m) { m = logit[i]; gi = i; }
        float ssum = 0.f; for (int i = 0; i < 4; ++i) ssum += __expf(logit[i] - m); float ptop = 1.f / ssum;
        const float* el = logit + 4 + gi * 8; float em = el[0]; int i1 = 0; for (int i = 1; i < 8; ++i) if (el[i] > em) { em = el[i]; i1 = i; }
        float e2m = -3e38f; int i2 = -1; for (int i = 0; i < 8; ++i) if (i != i1 && el[i] > e2m) { e2m = el[i]; i2 = i; }
        float pa = 1.f, pb = __expf(e2m - em); float inv = ptop / (pa + pb);
        se[0] = gi * 8 + i1; se[1] = gi * 8 + i2; sw[0] = pa * inv; sw[1] = pb * inv;
    }
    __syncthreads();
    float y[4] = {0.f, 0.f, 0.f, 0.f};
    for (int s = 0; s < 2; ++s) {
        int e = se[s]; float w = sw[s];
        const float* G = wg + (size_t)e * DM * DE; const float* U = wu + (size_t)e * DM * DE; const float* Dn = wd + (size_t)e * DE * DM;
        float ga = 0.f, ua = 0.f;
        for (int k = 0; k < DM; ++k) { float hv = h2[k]; ga += hv * G[(size_t)k * DE + tid]; ua += hv * U[(size_t)k * DE + tid]; }
        __syncthreads();
        act[tid] = siluf_(ga) * ua;
        __syncthreads();
        for (int j = 0; j < DE; ++j) { float av = act[j] * w; for (int i = 0; i < 4; ++i) y[i] += av * Dn[(size_t)j * DM + tid + 256 * i]; }
    }
    float z[4]; float sm = 0.f;
    for (int i = 0; i < 4; ++i) { int c = tid + 256 * i; z[i] = ALPHA * x1v[i] + mod[b * 6 * DM + 5 * DM + c] * y[i]; sm += z[i]; }
    float mean = block_sum256(sm, red) * (1.f / DM); float q = 0.f;
    for (int i = 0; i < 4; ++i) { z[i] -= mean; q += z[i] * z[i]; }
    float rstd = rsqrtf(block_sum256(q, red) * (1.f / DM) + EPS);
    for (int i = 0; i < 4; ++i) { int c = tid + 256 * i; io[(size_t)t * DM + c] = z[i] * rstd * g2ln[c] + b2ln[c]; }
}
}

extern "C" void kernel_launch(void* const* d_in, const int* in_sizes, int n_in, void* d_out, int out_size, void* d_ws, size_t ws_size, hipStream_t stream) {
    static int grid = 0;
    if (grid == 0) {
        int dev = 0, cus = 0;
        if (hipGetDevice(&dev) != hipSuccess || hipDeviceGetAttribute(&cus, hipDeviceAttributeMultiprocessorCount, dev) != hipSuccess) { fprintf(stderr, "kernel_launch: device query failed\n"); grid = -1; return; }
        if (hipFuncSetAttribute((const void*)mega_fwd, hipFuncAttributeMaxDynamicSharedMemorySize, LDS_BYTES) != hipSuccess) { fprintf(stderr, "kernel_launch: hipFuncSetAttribute failed\n"); grid = -1; return; }
        int per_cu = 0;
        if (hipOccupancyMaxActiveBlocksPerMultiprocessor(&per_cu, (const void*)mega_fwd, NWAVES * 64, LDS_BYTES) != hipSuccess || per_cu < 1) fprintf(stderr, "kernel_launch: occupancy query reports %d\n", per_cu);
        (void)hipGetLastError();
        grid = cus;
    }
    if (grid < 0) return;
    (void)hipMemsetAsync((char*)d_ws + WS_CTL, 0, CTL_ZERO_BYTES, stream);
    Args a{};
    for (int i = 0; i < 26; ++i) a.in[i] = (const float*)d_in[i];
    a.out = (float*)d_out; a.ws = (unsigned char*)d_ws; a.ph_lo = 0; a.ph_hi = DEV_STAGE + 1;
    hipLaunchKernelGGL(mega_fwd, dim3(grid), dim3(NWAVES * 64), LDS_BYTES, stream, a);
    {
        using namespace nv;
        char* ws = (char*)d_ws; float* out = (float*)d_out;
        const float* x = (const float*)d_in[0];
        const float* mod = (const float*)(ws + WS_MOD);
        float* ycat = (float*)(ws + WS_DEV1);
        float* mix = (float*)(ws + 56 * MiB);
#if DEV_STAGE == 3
        k_bf2f<<<(unsigned)((size_t)T * DM / 256), 256, 0, stream>>>((const bf16_t*)(ws + WS_H), ycat, (size_t)T * DM);
        mix = (float*)(ws + 120 * MiB);
        k_gemm<<<dim3(DM / 64, T / 64), 256, 0, stream>>>(ycat, (const float*)d_in[13], (const float*)d_in[14], mix, T, DM, DM);
        k_ln1<<<T, 256, 0, stream>>>(x, mix, mod, (const float*)d_in[15], (const float*)d_in[16], out);
        k_moe<<<T, 256, 0, stream>>>(out, mod, (const float*)d_in[17], (const float*)d_in[18], (const float*)d_in[19], (const float*)d_in[20], (const float*)d_in[21], (const float*)d_in[22], (const float*)d_in[23], (const float*)d_in[24], (const float*)d_in[25]);
#endif
#if DEV_STAGE == 2
        k_conv2<<<T, 512, 0, stream>>>((const bf16_t*)(ws + WS_VG), (const float*)d_in[6], (const float*)d_in[7], (const float*)d_in[8], (const float*)d_in[9], (const float*)d_in[10], ycat);
        k_attn2<<<T, 512, 0, stream>>>((const bf16_t*)(ws + WS_Q), (const bf16_t*)(ws + WS_KV), (const float*)d_in[11], (const float*)d_in[12], ycat);
        k_gemm<<<dim3(DM / 64, T / 64), 256, 0, stream>>>(ycat, (const float*)d_in[13], (const float*)d_in[14], mix, T, DM, DM);
        k_ln1<<<T, 256, 0, stream>>>(x, mix, mod, (const float*)d_in[15], (const float*)d_in[16], out);
        k_moe<<<T, 256, 0, stream>>>(out, mod, (const float*)d_in[17], (const float*)d_in[18], (const float*)d_in[19], (const float*)d_in[20], (const float*)d_in[21], (const float*)d_in[22], (const float*)d_in[23], (const float*)d_in[24], (const float*)d_in[25]);
#endif
    }
}
```

```cpp
#include <hip/hip_runtime.h>
#include <cstdio>
#include <cstdint>

#ifndef DIAG
#define DIAG 0
#endif
#ifndef DIAG_A
#define DIAG_A 9
#endif
#ifndef DIAG_B
#define DIAG_B 9
#endif
#ifndef DUP_PHASE
#define DUP_PHASE -1
#endif
#ifndef DEV_STAGE
#define DEV_STAGE 8
#endif

#define LAS __attribute__((address_space(3)))
#define GAS __attribute__((address_space(1)))
typedef unsigned short bf16_t;
typedef short bf16x8 __attribute__((ext_vector_type(8)));
typedef float f32x4 __attribute__((ext_vector_type(4)));
typedef float f32x2 __attribute__((ext_vector_type(2)));
typedef unsigned u32x4 __attribute__((ext_vector_type(4)));
typedef unsigned u32x2 __attribute__((ext_vector_type(2)));
typedef GAS unsigned gu32;

constexpr int DM = 1024, NBATCH = 8, SEQ = 4096, T = NBATCH * SEQ;
constexpr int DCONV = 512, CW = 31, NH = 8, NKV = 2, HD = 64, DATTN = 512, DKV = 128, WIN = 128;
constexpr int DIN = 1792, NG = 4, EPG = 8, NE = 32, DE = 256;
constexpr float ALPHA = 1.189207115002721f, EPS = 1e-5f;
constexpr float LOG2E = 1.4426950408889634f;
constexpr float QSCALE = 0.125f * LOG2E;

constexpr size_t MiB = 1u << 20;
constexpr size_t WS_CTL = 0, CTL_ZERO_BYTES = 1 * MiB;
constexpr size_t WS_MOD = 1 * MiB;
constexpr size_t WS_BPERM = 1 * MiB + 256 * 1024;
constexpr size_t WS_WR = 1 * MiB + 512 * 1024;
constexpr size_t WS_WI = 2 * MiB;
constexpr size_t WS_WO = 6 * MiB;
constexpr size_t WS_WGU = 8 * MiB;
constexpr size_t WS_WD = 40 * MiB;
constexpr size_t WS_H = 56 * MiB;
constexpr size_t WS_VG = 120 * MiB;
constexpr size_t WS_Q = 152 * MiB;
constexpr size_t WS_KV = 184 * MiB;
constexpr size_t WS_H2 = 200 * MiB;
constexpr size_t WS_ACT = 264 * MiB;
constexpr size_t WS_LIST = 300 * MiB;
constexpr size_t WS_TOK = 304 * MiB;
constexpr size_t WS_MIX = 120 * MiB;
constexpr size_t WS_YS = 56 * MiB;
constexpr size_t WS_DEV1 = 320 * MiB;
constexpr int CW_BAR = 4096;
constexpr int CW_ECNT = 16384;

constexpr int RING_OFF = 0, RING_BYTES = 139264;
constexpr int LDSCTL_OFF = RING_BYTES, MISC_OFF = LDSCTL_OFF + 320;
constexpr int LDS_BYTES = 147456;
constexpr int NWAVES = 8;

#define RLX_AGENT __ATOMIC_RELAXED, __HIP_MEMORY_SCOPE_AGENT
#define LDS_WAIT() asm volatile("s_waitcnt lgkmcnt(0)" ::: "memory")
#define VM_WAIT() asm volatile("s_waitcnt vmcnt(0)" ::: "memory")

__device__ __forceinline__ unsigned f2bf(float f) { unsigned u = __builtin_bit_cast(unsigned, f); return (u + 0x7fffu + ((u >> 16) & 1u)) >> 16; }
__device__ __forceinline__ unsigned pk2(float lo, float hi) { return f2bf(lo) | (f2bf(hi) << 16); }
__device__ __forceinline__ float bf2f(unsigned short b) { return __builtin_bit_cast(float, (unsigned)b << 16); }
__device__ __forceinline__ unsigned cvt_pk_bf16(float lo, float hi) { unsigned r; asm volatile("v_cvt_pk_bf16_f32 %0, %1, %2" : "=v"(r) : "v"(lo), "v"(hi)); return r; }
__device__ __forceinline__ float fast_sigmoid(float v) { return __builtin_amdgcn_rcpf(1.f + __builtin_amdgcn_exp2f(-v * LOG2E)); }
__device__ __forceinline__ float fast_silu(float v) { return v * fast_sigmoid(v); }

#define XB_TMO      128
#define XB_XCNT(j)  (256  + 64 * (j))
#define XB_XSUB(j)  (1280 + 64 * (j))
#define XB_XGEN(j)  (2304 + 64 * (j))
#define XB_TOP      3328
#define XB_TOPGEN   3392
#define XCD_BAR_WORDS 3456
#define XB_SPIN_CAP (1u << 18)
__device__ __forceinline__ unsigned xb_ld(unsigned* p)              { return __hip_atomic_load(p, __ATOMIC_RELAXED, __HIP_MEMORY_SCOPE_AGENT); }
__device__ __forceinline__ unsigned xb_add(unsigned* p, unsigned v) { return __hip_atomic_fetch_add(p, v, __ATOMIC_RELAXED, __HIP_MEMORY_SCOPE_AGENT); }
__device__ __forceinline__ unsigned xb_xcc_id() { return (unsigned)__builtin_amdgcn_s_getreg((3 << 11) | 20) & 0xFu; }
#define XB_SPIN(cond, bar) do { unsigned _sp = 0; while (cond) { __builtin_amdgcn_s_sleep(1); \
    if ((++_sp & 255u) == 0u) { if (xb_ld(&(bar)[XB_TMO])) break; if (_sp > XB_SPIN_CAP) { atomicAdd(&(bar)[XB_TMO], 1u); break; } } } } while (0)
struct XcdBarrier { unsigned* bar; unsigned x; volatile LAS unsigned* st; };
__device__ __forceinline__ XcdBarrier xcd_barrier_post(unsigned* bar, volatile LAS unsigned* st) {
    XcdBarrier b; b.bar = bar; b.x = xb_xcc_id(); b.st = st;
    if (threadIdx.x == 0) (void)xb_add(&bar[XB_XCNT(b.x)], 1u);
    return b;
}
__device__ __forceinline__ void xcd_barrier_complete(unsigned* bar, unsigned x, unsigned& nloc, unsigned& nx) {
    const unsigned G = gridDim.x * gridDim.y * gridDim.z;
    unsigned sum, cnt, mine, sp = 0u;
    for (;;) {
        sum = 0u; cnt = 0u; mine = 0u;
#pragma unroll
        for (unsigned j = 0; j < 16; ++j) { const unsigned c = xb_ld(&bar[XB_XCNT(j)]); sum += c; cnt += (c > 0u) ? 1u : 0u; mine = (j == x) ? c : mine; }
        if (sum == G) break;
        __builtin_amdgcn_s_sleep(1);
        if ((++sp & 255u) == 0u) { if (xb_ld(&bar[XB_TMO])) break; if (sp > XB_SPIN_CAP) { atomicAdd(&bar[XB_TMO], 1u); break; } }
    }
    nloc = mine > 0u ? mine : 1u; nx = cnt > 0u ? cnt : 1u;
}
__device__ __forceinline__ void xcd_barrier(const XcdBarrier& b) {
    asm volatile("s_waitcnt vmcnt(0)" ::: "memory");
    __syncthreads();
    if (threadIdx.x == 0) {
        unsigned* bar = b.bar;
        __builtin_amdgcn_s_waitcnt(0);
        unsigned nloc = b.st[0], nx = b.st[1];
        if (nloc == 0u) { xcd_barrier_complete(bar, b.x, nloc, nx); b.st[0] = nloc; b.st[1] = nx; }
        const unsigned old = xb_add(&bar[XB_XSUB(b.x)], 1u);
        const unsigned gen = old / nloc;
        if (old + 1u == (gen + 1u) * nloc) {
            __builtin_amdgcn_fence(__ATOMIC_RELEASE, "agent");
            asm volatile("s_waitcnt vmcnt(0)" ::: "memory");
            const unsigned og = xb_add(&bar[XB_TOP], 1u);
            const unsigned tg = og / nx;
            if (og + 1u == (tg + 1u) * nx) xb_add(&bar[XB_TOPGEN], 1u);
            else XB_SPIN(xb_ld(&bar[XB_TOPGEN]) == tg, bar);
            __builtin_amdgcn_fence(__ATOMIC_ACQUIRE, "agent");
            xb_add(&bar[XB_XGEN(b.x)], 1u);
            asm volatile("s_waitcnt vmcnt(0)" ::: "memory");
        } else {
            XB_SPIN(xb_ld(&bar[XB_XGEN(b.x)]) == gen, bar);
            __builtin_amdgcn_fence(__ATOMIC_ACQUIRE, "agent");
            asm volatile("s_waitcnt vmcnt(0)" ::: "memory");
        }
    }
    __syncthreads();
}

namespace pg8 {
constexpr int BM = 256, BK = 64, HALF = 128, HTB = HALF * BK * 2, STAGE_BYTES = 8 * HTB, NXCD = 8, WGM = 8;
__host__ __device__ __forceinline__ int lds_byte(int r, int c) { const int st = (r >> 4) * 2 + (c >> 5), rr = r & 15, cc = c & 31, ob = rr * 64 + cc * 2; return st * 1024 + (ob ^ (((ob >> 9) & 1) << 5)); }
__host__ __device__ __forceinline__ void stage_rc(int b, int& R, int& C) { const int st = b / 1024, sb = b % 1024, swz = sb ^ (((sb >> 9) & 1) << 5); R = (st >> 1) * 16 + swz / 64; C = (st & 1) * 32 + (swz % 64) / 2; }
__host__ __device__ __forceinline__ int perm32(int rho) { const int n = rho >> 4, i = rho & 15; return 8 * (i >> 2) + 4 * n + (i & 3); }

struct Unit { int pm, pn, e; };
__device__ __forceinline__ bool static_next(int i, int G, int c, int nM, int nN, int& pm, int& pn) {
    const int nwg = nM * nN; const long L = (long)i * G + c; if (L >= nwg) return false;
    int wgid = (int)L; { const int q = nwg / NXCD, r = nwg % NXCD, xcd = wgid % NXCD, off = wgid / NXCD; wgid = (xcd < r ? xcd * (q + 1) : r * (q + 1) + (xcd - r) * q) + off; }
    const int nig = WGM * nN, gid = wgid / nig, fm = gid * WGM, gsz = (nM - fm) < WGM ? (nM - fm) : WGM;
    pm = fm + ((wgid % nig) % gsz); pn = (wgid % nig) / gsz; return true;
}

template <class P>
__device__ __forceinline__ void gemm_phase(LAS unsigned char* lds, const P& S) {
    const int tid = threadIdx.x, wid = __builtin_amdgcn_readfirstlane(tid >> 6), lane = tid & 63, wr = wid >> 2, wc = wid & 3, fr = lane & 15, fq = lane >> 4;
    const int K = S.K, nt = K / BK;
    int sR[2], sC[2]; unsigned voffB[2];
#pragma unroll
    for (int i = 0; i < 2; ++i) { int R, C; stage_rc(tid * 16 + i * 8192, R, C); sR[i] = R; sC[i] = C; const int Rb = P::PERM ? ((R & ~31) + perm32(R & 31)) : R; voffB[i] = (unsigned)(Rb * K + C) * 2u; }
    const size_t kstep = (size_t)(BK * 2);
    const size_t hstepB = (size_t)HALF * K * 2;
    const unsigned ldsw = (unsigned)wid * 1024u;
    const int aoff = lds_byte(wr * 64 + fr, fq * 8), boff = lds_byte(wc * 32 + fr, fq * 8);
#define PG8_SA(b, h) (((b) * 2 + (h)) * HTB)
#define PG8_SB(b, h) ((4 + (b) * 2 + (h)) * HTB)
#define PG8_STAGE(bufoff, gbase, voff) do { _Pragma("unroll") for (int _i = 0; _i < 2; ++_i) \
        __builtin_amdgcn_global_load_lds((const unsigned*)((const char*)(gbase) + (voff)[_i]), (LAS unsigned*)(lds + (bufoff) + ldsw + _i * 8192), 16, 0, 0); } while (0)
#define PG8_LDA(dst, b, h) do { _Pragma("unroll") for (int m = 0; m < 4; ++m) _Pragma("unroll") for (int k = 0; k < 2; ++k) dst[m][k] = *(const LAS bf16x8*)(lds + PG8_SA(b, h) + aoff + m * 2048 + k * 1024); } while (0)
#define PG8_LDB(dst, b, h) do { _Pragma("unroll") for (int n = 0; n < 2; ++n) _Pragma("unroll") for (int k = 0; k < 2; ++k) dst[n][k] = *(const LAS bf16x8*)(lds + PG8_SB(b, h) + boff + n * 2048 + k * 1024); } while (0)
#define PG8_MMA(ai, bj, At, Bt) do { __builtin_amdgcn_s_setprio(1); _Pragma("unroll") for (int m = 0; m < 4; ++m) _Pragma("unroll") for (int n = 0; n < 2; ++n) _Pragma("unroll") for (int k = 0; k < 2; ++k) \
        acc[ai][bj][m][n] = __builtin_amdgcn_mfma_f32_16x16x32_bf16(Bt[n][k], At[m][k], acc[ai][bj][m][n], 0, 0, 0); __builtin_amdgcn_s_setprio(0); } while (0)
#define PG8_WAIT_V(n) asm volatile("s_waitcnt vmcnt(" #n ")" ::: "memory")
#define PG8_WAIT_L(n) asm volatile("s_waitcnt lgkmcnt(" #n ")" ::: "memory")
#define PG8_BAR __builtin_amdgcn_s_barrier()
#define PG8_SCHED __builtin_amdgcn_sched_barrier(0)
    Unit cur, nxt; int ui = 0;
    if (!S.next(0, cur)) return;
    f32x4 acc[2][2][4][2];
#pragma unroll
    for (int a = 0; a < 2; ++a)
#pragma unroll
        for (int b = 0; b < 2; ++b)
#pragma unroll
            for (int m = 0; m < 4; ++m)
#pragma unroll
                for (int n = 0; n < 2; ++n) acc[a][b][m][n] = (f32x4){0.f, 0.f, 0.f, 0.f};
    bf16x8 At[4][2], B0[2][2], B1[2][2];
    unsigned vAc[2][2], vAn[2][2];
    S.a_voff(cur, sR, sC, vAc);
    const char* cA = S.a_base(cur); const char* cB = S.b_base(cur);
    PG8_STAGE(PG8_SB(0, 0), cB, voffB); PG8_STAGE(PG8_SB(0, 1), cB + hstepB, voffB); PG8_STAGE(PG8_SA(0, 0), cA, vAc[0]); PG8_STAGE(PG8_SA(0, 1), cA, vAc[1]);
    if (wr == 1) PG8_BAR;
    PG8_WAIT_V(2); PG8_BAR;
    PG8_STAGE(PG8_SB(1, 0), cB + kstep, voffB); PG8_STAGE(PG8_SA(1, 0), cA + kstep, vAc[0]); PG8_STAGE(PG8_SB(1, 1), cB + hstepB + kstep, voffB);
    PG8_WAIT_V(6); PG8_BAR;
    for (;;) {
        const bool has_next = S.next(ui + 1, nxt);
        const char* nA = has_next ? S.a_base(nxt) : cA; const char* nB = has_next ? S.b_base(nxt) : cB;
        if (has_next) S.a_voff(nxt, sR, sC, vAn); else { vAn[0][0] = vAc[0][0]; vAn[0][1] = vAc[0][1]; vAn[1][0] = vAc[1][0]; vAn[1][1] = vAc[1][1]; }
        for (int t = 0; t < nt; t += 2) {
            const bool last = (t == nt - 2);
            const char* a1 = cA + (size_t)(t + 1) * kstep;
            const char* a2 = last ? nA : cA + (size_t)(t + 2) * kstep; const char* b2 = last ? nB : cB + (size_t)(t + 2) * kstep;
            const char* a3 = a2 + kstep; const char* b3 = b2 + kstep;
            unsigned v2[2][2];
            v2[0][0] = last ? vAn[0][0] : vAc[0][0]; v2[0][1] = last ? vAn[0][1] : vAc[0][1]; v2[1][0] = last ? vAn[1][0] : vAc[1][0]; v2[1][1] = last ? vAn[1][1] : vAc[1][1];
            PG8_LDB(B0, 0, 0); PG8_LDB(B1, 0, 1); PG8_SCHED; PG8_LDA(At, 0, 0); PG8_STAGE(PG8_SA(1, 1), a1, vAc[1]);
            PG8_WAIT_V(8); PG8_WAIT_L(0); PG8_BAR; PG8_MMA(0, 0, At, B0); PG8_MMA(0, 1, At, B1); PG8_BAR; PG8_SCHED;
            PG8_LDA(At, 0, 1); PG8_STAGE(PG8_SB(0, 0), b2, voffB); PG8_STAGE(PG8_SB(0, 1), b2 + hstepB, voffB); PG8_STAGE(PG8_SA(0, 0), a2, v2[0]);
            PG8_WAIT_V(8); PG8_WAIT_L(0); PG8_BAR; PG8_MMA(1, 0, At, B0); PG8_MMA(1, 1, At, B1); PG8_BAR; PG8_SCHED;
            PG8_LDB(B0, 1, 0); PG8_LDB(B1, 1, 1); PG8_SCHED; PG8_LDA(At, 1, 0); PG8_STAGE(PG8_SA(0, 1), a2, v2[1]);
            PG8_WAIT_V(8); PG8_WAIT_L(0); PG8_BAR; PG8_MMA(0, 0, At, B0); PG8_MMA(0, 1, At, B1); PG8_BAR; PG8_SCHED;
            PG8_LDA(At, 1, 1); PG8_STAGE(PG8_SB(1, 0), b3, voffB); PG8_STAGE(PG8_SB(1, 1), b3 + hstepB, voffB); PG8_STAGE(PG8_SA(1, 0), a3, v2[0]);
            PG8_WAIT_V(8); PG8_WAIT_L(0); PG8_BAR; PG8_MMA(1, 0, At, B0); PG8_MMA(1, 1, At, B1); PG8_BAR; PG8_SCHED;
        }
        if (wr == 0) PG8_BAR;
        S.epi(acc, cur, wr, wc, fr, fq);
        if (!has_next) break;
#pragma unroll
        for (int a = 0; a < 2; ++a)
#pragma unroll
            for (int b = 0; b < 2; ++b)
#pragma unroll
                for (int m = 0; m < 4; ++m)
#pragma unroll
                    for (int n = 0; n < 2; ++n) acc[a][b][m][n] = (f32x4){0.f, 0.f, 0.f, 0.f};
        cur = nxt; cA = nA; cB = nB; ++ui;
        vAc[0][0] = vAn[0][0]; vAc[0][1] = vAn[0][1]; vAc[1][0] = vAn[1][0]; vAc[1][1] = vAn[1][1];
        if (wr == 1) PG8_BAR;
    }
    PG8_WAIT_V(0);
    PG8_BAR;
#undef PG8_SA
#undef PG8_SB
#undef PG8_STAGE
#undef PG8_LDA
#undef PG8_LDB
#undef PG8_MMA
#undef PG8_WAIT_V
#undef PG8_WAIT_L
#undef PG8_BAR
#undef PG8_SCHED
}
}

struct Frame {
    LAS unsigned char* lds;
    volatile LAS unsigned* MISC;
    gu32* ctl;
    int tid, lane, wave, vcu, G;
    const float* in[26]; float* out; unsigned char* ws;
};
struct Args { const float* in[26]; float* out; unsigned char* ws; int ph_lo, ph_hi; };

__device__ __forceinline__ float wave_sum(float v) {
#pragma unroll
    for (int o = 1; o < 64; o <<= 1) v += __shfl_xor(v, o);
    return v;
}

__device__ __forceinline__ void p0_transpose_item(const float* W, int Ksrc, int N, bf16_t* WT, int dst_row0, LAS float* scr, int k0, int n0, int lane) {
    { const int r = lane >> 3, c4 = (lane & 7) * 4; f32x4 v[8];
#pragma unroll
      for (int i = 0; i < 8; ++i) v[i] = *(const f32x4*)(W + (size_t)(k0 + 8 * i + r) * N + n0 + c4);
#pragma unroll
      for (int i = 0; i < 8; ++i) { LAS float* d = scr + (8 * i + r) * 33 + c4; d[0] = v[i][0]; d[1] = v[i][1]; d[2] = v[i][2]; d[3] = v[i][3]; } }
    LDS_WAIT(); asm volatile("" ::: "memory");
    const int c = lane & 7;
#pragma unroll
    for (int j = 0; j < 4; ++j) { const int n = (lane >> 3) + 8 * j; const LAS float* s = scr + (8 * c) * 33 + n;
        u32x4 o; o.x = pk2(s[0 * 33], s[1 * 33]); o.y = pk2(s[2 * 33], s[3 * 33]); o.z = pk2(s[4 * 33], s[5 * 33]); o.w = pk2(s[6 * 33], s[7 * 33]);
        *(GAS u32x4*)(WT + (size_t)(dst_row0 + n) * Ksrc + k0 + 8 * c) = o; }
    LDS_WAIT(); asm volatile("" ::: "memory");
}
__host__ __device__ __forceinline__ int map_in(int n) { return n < 512 ? 256 * (n >> 7) + (n & 127) : (n < 1024 ? 256 * ((n - 512) >> 7) + 128 + ((n - 512) & 127) : n); }

__device__ __forceinline__ void p0_prologue(Frame& F) {
    const float* c = F.in[1]; const float* w_ada = F.in[2]; const float* b_ada = F.in[3];
    {
        LAS float* cact = (LAS float*)(F.lds + RING_OFF);
        LAS float* red = (LAS float*)(F.lds + RING_OFF + 32768);
        for (int i = F.tid; i < NBATCH * DM; i += 512) { const float v = c[i]; cact[i] = v / (1.f + __expf(-v)); }
        __syncthreads();
        float* mod = (float*)(F.ws + WS_MOD);
        for (int cg = blockIdx.x; cg < 256; cg += F.G) {
            const int j0 = cg * 24, ks = F.tid >> 5, jj = F.tid & 31;
            float a[8] = {0.f, 0.f, 0.f, 0.f, 0.f, 0.f, 0.f, 0.f};
            if (jj < 24) {
#pragma unroll 8
                for (int k = ks * 64; k < ks * 64 + 64; ++k) { const float w = w_ada[(size_t)k * 6 * DM + j0 + jj];
#pragma unroll
                    for (int b = 0; b < 8; ++b) a[b] += cact[b * DM + k] * w; }
            }
#pragma unroll
            for (int b = 0; b < 8; ++b) red[(ks * 8 + b) * 32 + jj] = a[b];
            __syncthreads();
            if (F.tid < 8 * 24) { const int b = F.tid / 24, j = F.tid % 24; float s = 0.f;
                for (int q = 0; q < 16; ++q) s += red[(q * 8 + b) * 32 + j];
                mod[b * 6 * DM + j0 + j] = s + b_ada[j0 + j]; }
            __syncthreads();
        }
    }
    {
        const int gt = blockIdx.x * 512 + F.tid, NT = F.G * 512;
        float* bperm = (float*)(F.ws + WS_BPERM); const float* b_in = F.in[5];
        for (int n = gt; n < DIN; n += NT) bperm[map_in(n)] = b_in[n];
        bf16_t* wr_hi = (bf16_t*)(F.ws + WS_WR); bf16_t* wr_lo = wr_hi + 48 * DM;
        const float* wrg = F.in[17]; const float* wre = F.in[19];
        for (int i = gt; i < 48 * DM; i += NT) { const int j = i / DM, k = i % DM; float v = 0.f;
            if (j < 4) v = wrg[k * NG + j]; else if (j < 36) v = wre[k * NE + (j - 4)];
            const unsigned h = f2bf(v); const float r = v - bf2f((unsigned short)h); wr_hi[i] = (bf16_t)h; wr_lo[i] = (bf16_t)f2bf(r); }
    }
    {
        LAS float* scr = (LAS float*)(F.lds + RING_OFF + F.wave * 16384);
        const int gw = F.vcu * NWAVES + F.wave, NGW = F.G * NWAVES;
        constexpr int I_IN = 16 * 56, I_OUT = 16 * 32, I_G = 16 * 8, I_D = 4 * 32, I_E = 2 * I_G + I_D;
        constexpr int NITEMS = I_IN + I_OUT + NE * I_E;
        bf16_t* WI = (bf16_t*)(F.ws + WS_WI); bf16_t* WO = (bf16_t*)(F.ws + WS_WO); bf16_t* WGU = (bf16_t*)(F.ws + WS_WGU); bf16_t* WD = (bf16_t*)(F.ws + WS_WD);
        for (int it = gw; it < NITEMS; it += NGW) {
            int r = it;
            if (r < I_IN) { const int kb = r / 56, nb = r % 56; p0_transpose_item(F.in[4], DM, DIN, WI, map_in(32 * nb), scr, 64 * kb, 32 * nb, F.lane); continue; } r -= I_IN;
            if (r < I_OUT) { const int kb = r / 32, nb = r % 32; p0_transpose_item(F.in[13], DM, DM, WO, 32 * nb, scr, 64 * kb, 32 * nb, F.lane); continue; } r -= I_OUT;
            const int e = r / I_E; r -= e * I_E;
            if (r < I_G) { const int kb = r / 8, nb = r % 8, n0 = 32 * nb; p0_transpose_item(F.in[21] + (size_t)e * DM * DE, DM, DE, WGU + (size_t)e * 512 * DM, 256 * (n0 >> 7) + (n0 & 127), scr, 64 * kb, n0, F.lane); continue; } r -= I_G;
            if (r < I_G) { const int kb = r / 8, nb = r % 8, n0 = 32 * nb; p0_transpose_item(F.in[22] + (size_t)e * DM * DE, DM, DE, WGU + (size_t)e * 512 * DM, 256 * (n0 >> 7) + 128 + (n0 & 127), scr, 64 * kb, n0, F.lane); continue; } r -= I_G;
            { const int kb = r / 32, nb = r % 32; p0_transpose_item(F.in[23] + (size_t)e * DE * DM, DE, DM, WD + (size_t)e * DM * DE, 32 * nb, scr, 64 * kb, 32 * nb, F.lane); }
        }
    }
}

__device__ __forceinline__ void p1_modulate(Frame& F) {
    const float* x = F.in[0]; const float* mod = (const float*)(F.ws + WS_MOD); bf16_t* H = (bf16_t*)(F.ws + WS_H);
    const int cv = F.tid & 127, rsub = F.tid >> 7, col = cv * 8;
    for (int r0 = blockIdx.x * 16; r0 < T; r0 += F.G * 16) {
        const int b = r0 / SEQ; const float* mb = mod + b * 6 * DM;
        const f32x4 s0 = *(const f32x4*)(mb + DM + col) + 1.f, s1 = *(const f32x4*)(mb + DM + col + 4) + 1.f, h0 = *(const f32x4*)(mb + col), h1 = *(const f32x4*)(mb + col + 4);
        f32x4 xa[4], xb[4];
#pragma unroll
        for (int i = 0; i < 4; ++i) { const size_t e0 = (size_t)(r0 + rsub + 4 * i) * DM + col; xa[i] = *(const f32x4*)(x + e0); xb[i] = *(const f32x4*)(x + e0 + 4); }
#pragma unroll
        for (int i = 0; i < 4; ++i) { const size_t e0 = (size_t)(r0 + rsub + 4 * i) * DM + col; const f32x4 y0 = xa[i] * s0 + h0, y1 = xb[i] * s1 + h1;
            u32x4 o; o.x = pk2(y0[0], y0[1]); o.y = pk2(y0[2], y0[3]); o.z = pk2(y1[0], y1[1]); o.w = pk2(y1[2], y1[3]);
            *(u32x4*)(H + e0) = o; }
    }
}

struct InProj {
    static constexpr bool PERM = true;
    int K, G, c; const bf16_t* A; const bf16_t* Bt; const float* bias; bf16_t* VG; bf16_t* Q; bf16_t* KV;
    __device__ __forceinline__ bool next(int i, pg8::Unit& u) const { u.e = 0; return pg8::static_next(i, G, c, T / 256, DIN / 256, u.pm, u.pn); }
    __device__ __forceinline__ const char* a_base(const pg8::Unit& u) const { return (const char*)A + (size_t)u.pm * 256 * K * 2; }
    __device__ __forceinline__ const char* b_base(const pg8::Unit& u) const { return (const char*)Bt + (size_t)u.pn * 256 * K * 2; }
    __device__ __forceinline__ void a_voff(const pg8::Unit&, const int (&R)[2], const int (&C)[2], unsigned (&v)[2][2]) const {
#pragma unroll
        for (int i = 0; i < 2; ++i) { v[0][i] = (unsigned)(R[i] * K + C[i]) * 2u; v[1][i] = v[0][i] + (unsigned)(128 * K * 2); } }
    __device__ __forceinline__ void epi(const f32x4 (&acc)[2][2][4][2], const pg8::Unit& u, int wr, int wc, int fr, int fq) const {
        const int row0 = u.pm * 256 + wr * 64 + fr; const int bcol0 = u.pn * 256 + wc * 32 + 8 * fq;
        f32x4 bv[2][2];
#pragma unroll
        for (int bj = 0; bj < 2; ++bj)
#pragma unroll
            for (int n = 0; n < 2; ++n) bv[bj][n] = *(const f32x4*)(bias + bcol0 + bj * 128 + 4 * n);
        if (u.pn < 4) {
            bf16_t* base = VG + u.pn * 128 + wc * 32 + 8 * fq;
#pragma unroll
            for (int ai = 0; ai < 2; ++ai)
#pragma unroll
                for (int m = 0; m < 4; ++m) { bf16_t* rowp = base + (size_t)(row0 + ai * 128 + m * 16) * DCONV;
                    f32x4 a0 = acc[ai][0][m][0] + bv[0][0], a1 = acc[ai][0][m][1] + bv[0][1], g0 = acc[ai][1][m][0] + bv[1][0], g1 = acc[ai][1][m][1] + bv[1][1];
#pragma unroll
                    for (int j = 0; j < 4; ++j) { a0[j] *= fast_sigmoid(g0[j]); a1[j] *= fast_sigmoid(g1[j]); }
                    u32x4 w; w.x = cvt_pk_bf16(a0[0], a0[1]); w.y = cvt_pk_bf16(a0[2], a0[3]); w.z = cvt_pk_bf16(a1[0], a1[1]); w.w = cvt_pk_bf16(a1[2], a1[3]);
                    *(u32x4*)rowp = w; }
        } else {
            const bool isq = u.pn < 6; const float sc = isq ? QSCALE : 1.f; const int ldc = isq ? DATTN : 2 * DKV;
            bf16_t* base = (isq ? Q + (u.pn - 4) * 256 : KV) + wc * 32 + 8 * fq;
#pragma unroll
            for (int ai = 0; ai < 2; ++ai)
#pragma unroll
                for (int m = 0; m < 4; ++m) { bf16_t* rowp = base + (size_t)(row0 + ai * 128 + m * 16) * ldc;
#pragma unroll
                    for (int bj = 0; bj < 2; ++bj) { const f32x4 v0 = (acc[ai][bj][m][0] + bv[bj][0]) * sc, v1 = (acc[ai][bj][m][1] + bv[bj][1]) * sc;
                        u32x4 w; w.x = cvt_pk_bf16(v0[0], v0[1]); w.y = cvt_pk_bf16(v0[2], v0[3]); w.z = cvt_pk_bf16(v1[0], v1[1]); w.w = cvt_pk_bf16(v1[2], v1[3]);
                        *(u32x4*)(rowp + bj * 128) = w; } }
        }
    }
};


template <int R> __device__ __forceinline__ void conv_rows(float (&acc)[32], const float (&w)[31], const float (&vin)[62]) {
    if constexpr (R < 62) {
#pragma unroll
        for (int j = 0; j < 31; ++j) { const int o = R - j; if (o >= 0 && o < 32) acc[o] += w[j] * vin[R]; }
        conv_rows<R + 1>(acc, w, vin);
    }
}
__device__ __forceinline__ void conv_unit(Frame& F, int t0) {
    const bf16_t* VG = (const bf16_t*)(F.ws + WS_VG);
    const float* conv_w = F.in[6]; const float* conv_b = F.in[7]; const float* lng = F.in[8]; const float* lnb = F.in[9]; const float* outg = F.in[10];
    bf16_t* Y = (bf16_t*)(F.ws + WS_H);
    LAS float* tile = (LAS float*)(F.lds + RING_OFF);
    const int c = F.tid; const int s0 = t0 % SEQ; const int tb = t0 - s0;
    float w[31];
#pragma unroll
    for (int j = 0; j < 31; ++j) w[j] = conv_w[j * DCONV + c];
    float acc[32]; { const float cb = conv_b[c];
#pragma unroll
        for (int o = 0; o < 32; ++o) acc[o] = cb; }
    float vin[62];
#pragma unroll
    for (int r = 0; r < 62; ++r) { const int ss = s0 - 30 + r; const int tr = tb + (ss < 0 ? 0 : ss); const float v = bf2f(VG[(size_t)tr * DCONV + c]); vin[r] = ss < 0 ? 0.f : v; }
    conv_rows<0>(acc, w, vin);
#pragma unroll
    for (int o = 0; o < 32; ++o) tile[o * 516 + c] = acc[o];
    __syncthreads();
    {
        const int c8 = F.lane * 8;
        const f32x4 g0 = *(const f32x4*)(lng + c8), g1 = *(const f32x4*)(lng + c8 + 4), b0 = *(const f32x4*)(lnb + c8), b1 = *(const f32x4*)(lnb + c8 + 4), og0 = *(const f32x4*)(outg + c8), og1 = *(const f32x4*)(outg + c8 + 4);
#pragma unroll
        for (int i = 0; i < 4; ++i) { const int o = F.wave * 4 + i;
            f32x4 v0 = *(const LAS f32x4*)(tile + o * 516 + c8), v1 = *(const LAS f32x4*)(tile + o * 516 + c8 + 4);
            const float mean = wave_sum((v0[0] + v0[1]) + (v0[2] + v0[3]) + (v1[0] + v1[1]) + (v1[2] + v1[3])) * (1.f / DCONV);
            v0 = v0 - mean; v1 = v1 - mean;
            const float var = wave_sum((v0[0] * v0[0] + v0[1] * v0[1]) + (v0[2] * v0[2] + v0[3] * v0[3]) + (v1[0] * v1[0] + v1[1] * v1[1]) + (v1[2] * v1[2] + v1[3] * v1[3])) * (1.f / DCONV);
            const float rstd = rsqrtf(var + EPS);
            v0 = v0 * rstd * g0 + b0; v1 = v1 * rstd * g1 + b1;
            float q = 0.f;
#pragma unroll
            for (int j = 0; j < 4; ++j) { v0[j] = fast_silu(v0[j]); v1[j] = fast_silu(v1[j]); q += v0[j] * v0[j] + v1[j] * v1[j]; }
            q += __shfl_xor(q, 1); q += __shfl_xor(q, 2); q += __shfl_xor(q, 4);
            const float r2 = rsqrtf(q * (1.f / 64.f) + EPS);
            v0 = v0 * r2 * og0; v1 = v1 * r2 * og1;
            u32x4 ow; ow.x = pk2(v0[0], v0[1]); ow.y = pk2(v0[2], v0[3]); ow.z = pk2(v1[0], v1[1]); ow.w = pk2(v1[2], v1[3]);
            *(u32x4*)(Y + (size_t)(t0 + o) * DM + c8) = ow; }
    }
    __syncthreads();
}

namespace att {
constexpr int KCH = 4112;
constexpr int L_K = 0, L_V = 8 * KCH, L_O = L_V + 32768, OST = 8704, L_WS = L_O + 8 * OST, L_END = L_WS + 8 * 128;
static_assert(L_END <= RING_BYTES, "attention LDS");
typedef short s16x4 __attribute__((ext_vector_type(4)));
typedef float f32x16 __attribute__((ext_vector_type(16)));
typedef short v4i16_t __attribute__((ext_vector_type(4)));
__device__ __forceinline__ int crow(int r, int hi) { return (r & 3) + 8 * (r >> 2) + 4 * hi; }
__device__ __forceinline__ s16x4 vtr(const LAS unsigned char* p) { return __builtin_bit_cast(s16x4, __builtin_amdgcn_ds_read_tr16_b64_v4i16((LAS v4i16_t*)p)); }

__device__ __forceinline__ void attn_unit(Frame& F, int b, int kvh, int blk) {
    const bf16_t* Q = (const bf16_t*)(F.ws + WS_Q); const bf16_t* KV = (const bf16_t*)(F.ws + WS_KV); bf16_t* Y = (bf16_t*)(F.ws + WS_H);
    const float* sinks = F.in[11]; const float* outg = F.in[12];
    LAS unsigned char* lds = F.lds + RING_OFF;
    const int lane = F.lane, r32 = lane & 31, hi = lane >> 5, wave = F.wave;
    const int t0 = b * SEQ + blk * 128;
    bf16x8 qrr[2][4];
#pragma unroll
    for (int wi = 0; wi < 2; ++wi) { const int wu = wave + 8 * wi, hq = wu >> 2, sub = wu & 3;
        const bf16_t* qrow = Q + (size_t)(t0 + 32 * sub + r32) * DATTN + (kvh * 4 + hq) * 64 + hi * 8;
#pragma unroll
        for (int s = 0; s < 4; ++s) qrr[wi][s] = *(const bf16x8*)(qrow + 16 * s); }
    {
        u32x4 kq[4], vq[4];
#pragma unroll
        for (int i = 0; i < 4; ++i) { const int p = F.tid + 512 * i, key = p >> 3, ch = p & 7; const bool valid = (blk > 0) || key >= 128;
            const int tk = valid ? t0 - 128 + key : t0;
            const bf16_t* gk = KV + (size_t)tk * 256 + kvh * 64 + ch * 8;
            kq[i] = *(const u32x4*)gk; vq[i] = *(const u32x4*)(gk + 128);
            if (!valid) { kq[i] = (u32x4){0u, 0u, 0u, 0u}; vq[i] = kq[i]; } }
#pragma unroll
        for (int i = 0; i < 4; ++i) { const int p = F.tid + 512 * i, key = p >> 3, ch = p & 7;
            *(LAS u32x4*)(lds + L_K + ch * KCH + key * 16) = kq[i];
            *(LAS u32x4*)(lds + L_V + (key >> 6) * 8192 + ((ch >> 2) * 4 + ((key & 63) >> 4)) * 1024 + (key & 15) * 64 + (ch & 3) * 16) = vq[i]; }
    }
    __syncthreads();
    const int vlane = (4 * hi + ((lane & 15) >> 2)) * 64 + ((lane >> 4) & 1) * 32 + (lane & 3) * 8;
#pragma unroll
    for (int wi = 0; wi < 2; ++wi) {
        const int wu = wave + 8 * wi, hq = wu >> 2, sub = wu & 3, i0 = 32 * sub, h = kvh * 4 + hq;
        bf16x8 qr[4];
#pragma unroll
        for (int s = 0; s < 4; ++s) qr[s] = qrr[wi][s];
        f32x16 st[5];
#pragma unroll
        for (int t = 0; t < 5; ++t) {
#pragma unroll
            for (int r = 0; r < 16; ++r) st[t][r] = 0.f;
#pragma unroll
            for (int s = 0; s < 4; ++s) { const bf16x8 kf = *(const LAS bf16x8*)(lds + L_K + (2 * s + hi) * KCH + (i0 + 32 * t + r32) * 16);
                st[t] = __builtin_amdgcn_mfma_f32_32x32x16_bf16(kf, qr[s], st[t], 0, 0, 0); } }
        const float sinkl = sinks[h] * LOG2E;
        float m = sinkl;
#pragma unroll
        for (int t = 0; t < 5; ++t)
#pragma unroll
            for (int r = 0; r < 16; ++r) { const int cj = crow(r, hi); bool ok = true;
                if (t == 0) ok = cj >= r32 + 1; if (t == 4) ok = cj <= r32;
                if (blk == 0) ok = ok && (i0 + 32 * t + cj >= 128);
                const float v = ok ? st[t][r] : -1e30f; st[t][r] = v; m = fmaxf(m, v); }
        m = fmaxf(m, __shfl_xor(m, 32));
        float l = 0.f;
#pragma unroll
        for (int t = 0; t < 5; ++t)
#pragma unroll
            for (int r = 0; r < 16; ++r) { const float pv = __builtin_amdgcn_exp2f(st[t][r] - m); st[t][r] = pv; l += pv; }
        l += __shfl_xor(l, 32); l += __builtin_amdgcn_exp2f(sinkl - m);
        f32x16 o[2];
#pragma unroll
        for (int r = 0; r < 16; ++r) { o[0][r] = 0.f; o[1][r] = 0.f; }
#pragma unroll
        for (int t = 0; t < 5; ++t)
#pragma unroll
            for (int s2 = 0; s2 < 2; ++s2) {
                u32x4 pw; pw.x = cvt_pk_bf16(st[t][8 * s2 + 0], st[t][8 * s2 + 1]); pw.y = cvt_pk_bf16(st[t][8 * s2 + 2], st[t][8 * s2 + 3]); pw.z = cvt_pk_bf16(st[t][8 * s2 + 4], st[t][8 * s2 + 5]); pw.w = cvt_pk_bf16(st[t][8 * s2 + 6], st[t][8 * s2 + 7]);
                const bf16x8 pa = __builtin_bit_cast(bf16x8, pw);
                const int kk0 = i0 + 32 * t + 16 * s2, g = kk0 >> 6, pc = (kk0 & 63) >> 4;
#pragma unroll
                for (int d0 = 0; d0 < 2; ++d0) { const LAS unsigned char* vb = lds + L_V + g * 8192 + (d0 * 4 + pc) * 1024 + vlane;
                    const s16x4 lo = vtr(vb), hh = vtr(vb + 512);
                    const bf16x8 vf = (bf16x8){lo[0], lo[1], lo[2], lo[3], hh[0], hh[1], hh[2], hh[3]};
                    o[d0] = __builtin_amdgcn_mfma_f32_32x32x16_bf16(pa, vf, o[d0], 0, 0, 0); } }
        LAS float* wsf = (LAS float*)(lds + L_WS + wave * 128);
        LAS float* ost = (LAS float*)(lds + L_O + wave * OST);
        if (hi == 0) wsf[r32] = l;
#pragma unroll
        for (int r = 0; r < 16; ++r) { const int q = crow(r, hi); ost[q * 68 + r32] = o[0][r]; ost[q * 68 + 32 + r32] = o[1][r]; }
        LDS_WAIT(); asm volatile("" ::: "memory");
        { const int q = lane >> 1, half = lane & 1; const float rl = 1.f / wsf[q];
          f32x4 v[8]; float ss = 0.f;
#pragma unroll
          for (int j = 0; j < 8; ++j) { v[j] = *(const LAS f32x4*)(ost + q * 68 + half * 32 + 4 * j) * rl; ss += (v[j][0] * v[j][0] + v[j][1] * v[j][1]) + (v[j][2] * v[j][2] + v[j][3] * v[j][3]); }
          ss += __shfl_xor(ss, 1);
          const float rr = rsqrtf(ss * (1.f / 64.f) + EPS);
          const float* gp = outg + h * 64 + half * 32; bf16_t* yp = Y + (size_t)(t0 + i0 + q) * DM + DCONV + h * 64 + half * 32;
#pragma unroll
          for (int j = 0; j < 4; ++j) { const f32x4 a = v[2 * j] * rr * *(const f32x4*)(gp + 8 * j), c2 = v[2 * j + 1] * rr * *(const f32x4*)(gp + 8 * j + 4);
              u32x4 ow; ow.x = pk2(a[0], a[1]); ow.y = pk2(a[2], a[3]); ow.z = pk2(c2[0], c2[1]); ow.w = pk2(c2[2], c2[3]);
              *(u32x4*)(yp + 8 * j) = ow; } }
        LDS_WAIT(); asm volatile("" ::: "memory");
    }
    __syncthreads();
}
}

__device__ __forceinline__ void p3_attn_only(Frame& F) {
    for (int u = blockIdx.x; u < NBATCH * NKV * (SEQ / 128); u += F.G) { const int blk = u & 31, kvh = (u >> 5) & 1, b = u >> 6; att::attn_unit(F, b, kvh, blk); }
}
__device__ __forceinline__ void p3_conv_only(Frame& F) {
    for (int u = blockIdx.x; u < T / 32; u += F.G) conv_unit(F, 32 * u);
}
__device__ __forceinline__ void p3_mixers(Frame& F) {
#ifndef SKIP_ATTN
    for (int u = blockIdx.x; u < NBATCH * NKV * (SEQ / 128); u += F.G) { const int blk = u & 31, kvh = (u >> 5) & 1, b = u >> 6; att::attn_unit(F, b, kvh, blk); }
#endif
#ifndef SKIP_CONV
    for (int u = blockIdx.x; u < T / 32; u += F.G) conv_unit(F, 32 * u);
#endif
}

struct OutProj {
    static constexpr bool PERM = true;
    int K, G, c; const bf16_t* A; const bf16_t* Bt; const float* bo; bf16_t* MIX;
    __device__ __forceinline__ bool next(int i, pg8::Unit& u) const { u.e = 0; return pg8::static_next(i, G, c, T / 256, DM / 256, u.pm, u.pn); }
    __device__ __forceinline__ const char* a_base(const pg8::Unit& u) const { return (const char*)A + (size_t)u.pm * 256 * K * 2; }
    __device__ __forceinline__ const char* b_base(const pg8::Unit& u) const { return (const char*)Bt + (size_t)u.pn * 256 * K * 2; }
    __device__ __forceinline__ void a_voff(const pg8::Unit&, const int (&R)[2], const int (&C)[2], unsigned (&v)[2][2]) const {
#pragma unroll
        for (int i = 0; i < 2; ++i) { v[0][i] = (unsigned)(R[i] * K + C[i]) * 2u; v[1][i] = v[0][i] + (unsigned)(128 * K * 2); } }
    __device__ __forceinline__ void epi(const f32x4 (&acc)[2][2][4][2], const pg8::Unit& u, int wr, int wc, int fr, int fq) const {
        const int row0 = u.pm * 256 + wr * 64 + fr; const int col0 = u.pn * 256 + wc * 32 + 8 * fq;
        f32x4 bv[2][2];
#pragma unroll
        for (int bj = 0; bj < 2; ++bj)
#pragma unroll
            for (int n = 0; n < 2; ++n) bv[bj][n] = *(const f32x4*)(bo + col0 + bj * 128 + 4 * n);
#pragma unroll
        for (int ai = 0; ai < 2; ++ai)
#pragma unroll
            for (int m = 0; m < 4; ++m) { bf16_t* rowp = MIX + (size_t)(row0 + ai * 128 + m * 16) * DM + col0;
#pragma unroll
                for (int bj = 0; bj < 2; ++bj) { const f32x4 v0 = acc[ai][bj][m][0] + bv[bj][0], v1 = acc[ai][bj][m][1] + bv[bj][1];
                    u32x4 w; w.x = cvt_pk_bf16(v0[0], v0[1]); w.y = cvt_pk_bf16(v0[2], v0[3]); w.z = cvt_pk_bf16(v1[0], v1[1]); w.w = cvt_pk_bf16(v1[2], v1[3]);
                    *(u32x4*)(rowp + bj * 128) = w; } }
    }
};

constexpr int TAB_OFF = LDSCTL_OFF + 1024;
__device__ __forceinline__ void build_route_table(Frame& F) {
    volatile LAS int* tab = (volatile LAS int*)(F.lds + TAB_OFF);
    if (F.tid == 0) { int tp = 0;
        for (int e = 0; e < NE; ++e) { const int cn = (int)__hip_atomic_load(F.ctl + CW_ECNT + 64 * e, RLX_AGENT); tab[e] = cn; tab[32 + e] = tp; tp += (cn + 255) >> 8; }
        tab[64] = tp; }
    __syncthreads();
}

__device__ __forceinline__ void p5_rows(Frame& F) {
    float* X = F.out; const float* xin = F.in[0]; const bf16_t* MIX = (const bf16_t*)(F.ws + WS_MIX); bf16_t* H2 = (bf16_t*)(F.ws + WS_H2);
    const float* ln_g = F.in[15]; const float* ln_b = F.in[16]; const float* mod = (const float*)(F.ws + WS_MOD);
    const bf16_t* wr_hi = (const bf16_t*)(F.ws + WS_WR); const bf16_t* wr_lo = wr_hi + 48 * DM;
    const float* brg = F.in[18]; const float* bre = F.in[20];
    int* list = (int*)(F.ws + WS_LIST); unsigned* tokrec = (unsigned*)(F.ws + WS_TOK);
    LAS float* lg = (LAS float*)(F.lds + RING_OFF + F.wave * 3072);
    volatile LAS int* lcnt = (volatile LAS int*)(F.lds + RING_OFF + 24576);
    const int lane = F.lane, i16 = lane & 15, kq = lane >> 4;
    for (int tile = blockIdx.x; tile < T / 128; tile += F.G) {
        if (F.tid < 64) lcnt[F.tid] = 0;
        __syncthreads();
        const int rbase = tile * 128 + F.wave * 16; const int b = (tile * 128) / SEQ;
        const float* sc2 = mod + b * 6 * DM + 4 * DM; const float* sh2 = mod + b * 6 * DM + 3 * DM;
        {
            const float* g1 = mod + b * 6 * DM + 2 * DM;
            f32x4 gg[4], lgv[4], lbv[4], scv[4], shv[4];
#pragma unroll
            for (int j = 0; j < 4; ++j) { const int col = 4 * lane + 256 * j; gg[j] = *(const f32x4*)(g1 + col); lgv[j] = *(const f32x4*)(ln_g + col); lbv[j] = *(const f32x4*)(ln_b + col);
                scv[j] = *(const f32x4*)(sc2 + col) + 1.f; shv[j] = *(const f32x4*)(sh2 + col); }
#pragma unroll 1
            for (int rb = 0; rb < 16; rb += 2) {
                f32x4 z[2][4]; u32x2 mv[2][4];
#pragma unroll
                for (int r = 0; r < 2; ++r)
#pragma unroll
                    for (int j = 0; j < 4; ++j) { const size_t o = (size_t)(rbase + rb + r) * DM + 4 * lane + 256 * j; z[r][j] = *(const f32x4*)(xin + o); mv[r][j] = *(const u32x2*)(MIX + o); }
                float sm[2];
#pragma unroll
                for (int r = 0; r < 2; ++r) { sm[r] = 0.f;
#pragma unroll
                    for (int j = 0; j < 4; ++j) { f32x4 m4; m4[0] = __builtin_bit_cast(float, mv[r][j].x << 16); m4[1] = __builtin_bit_cast(float, mv[r][j].x & 0xffff0000u); m4[2] = __builtin_bit_cast(float, mv[r][j].y << 16); m4[3] = __builtin_bit_cast(float, mv[r][j].y & 0xffff0000u);
                        z[r][j] = z[r][j] * ALPHA + gg[j] * m4; sm[r] += (z[r][j][0] + z[r][j][1]) + (z[r][j][2] + z[r][j][3]); } }
#pragma unroll
                for (int o = 1; o < 64; o <<= 1) {
#pragma unroll
                    for (int r = 0; r < 2; ++r) sm[r] += __shfl_xor(sm[r], o); }
                float sq[2];
#pragma unroll
                for (int r = 0; r < 2; ++r) { const float mean = sm[r] * (1.f / DM); sq[r] = 0.f;
#pragma unroll
                    for (int j = 0; j < 4; ++j) { z[r][j] = z[r][j] - mean; sq[r] += (z[r][j][0] * z[r][j][0] + z[r][j][1] * z[r][j][1]) + (z[r][j][2] * z[r][j][2] + z[r][j][3] * z[r][j][3]); } }
#pragma unroll
                for (int o = 1; o < 64; o <<= 1) {
#pragma unroll
                    for (int r = 0; r < 2; ++r) sq[r] += __shfl_xor(sq[r], o); }
#pragma unroll
                for (int r = 0; r < 2; ++r) { const float rstd = rsqrtf(sq[r] * (1.f / DM) + EPS);
#pragma unroll
                    for (int j = 0; j < 4; ++j) { const size_t o = (size_t)(rbase + rb + r) * DM + 4 * lane + 256 * j; const f32x4 x1 = z[r][j] * rstd * lgv[j] + lbv[j];
                        *(f32x4*)(X + o) = x1; const f32x4 t = x1 * scv[j] + shv[j];
                        u32x2 hw; hw.x = pk2(t[0], t[1]); hw.y = pk2(t[2], t[3]); *(u32x2*)(H2 + o) = hw; } }
            }
            asm volatile("s_waitcnt vmcnt(0)" ::: "memory");
        }
        const int row = rbase + i16;
        f32x4 acc[3];
#pragma unroll
        for (int ct = 0; ct < 3; ++ct) acc[ct] = (f32x4){0.f, 0.f, 0.f, 0.f};
        { const bf16_t* hr = H2 + (size_t)row * DM + 8 * kq; const bf16_t* wp = wr_hi + (size_t)i16 * DM + 8 * kq;
#pragma unroll 1
          for (int kc = 0; kc < DM; kc += 128) {
              bf16x8 ah[4], bh[4][3];
#pragma unroll
              for (int u = 0; u < 4; ++u) { ah[u] = *(const bf16x8*)(hr + kc + 32 * u);
#pragma unroll
                  for (int ct = 0; ct < 3; ++ct) bh[u][ct] = *(const bf16x8*)(wp + (size_t)(16 * ct) * DM + kc + 32 * u); }
#pragma unroll
              for (int u = 0; u < 4; ++u)
#pragma unroll
                  for (int ct = 0; ct < 3; ++ct) acc[ct] = __builtin_amdgcn_mfma_f32_16x16x32_bf16(ah[u], bh[u][ct], acc[ct], 0, 0, 0);
          } }
#pragma unroll
        for (int ct = 0; ct < 3; ++ct)
#pragma unroll
            for (int r = 0; r < 4; ++r) lg[(4 * kq + r) * 48 + 16 * ct + i16] = acc[ct][r];
        LDS_WAIT(); asm volatile("" ::: "memory");
        int e1 = 0, e2 = 0, rk1 = 0, rk2 = 0; float w1 = 0.f, w2 = 0.f;
        if (lane < 16) {
            const LAS float* L = lg + lane * 48;
            float gl[4];
#pragma unroll
            for (int j = 0; j < 4; ++j) gl[j] = L[j] + brg[j];
            int gi = 0; float gm = gl[0];
#pragma unroll
            for (int j = 1; j < 4; ++j) if (gl[j] > gm) { gm = gl[j]; gi = j; }
            float gs = 0.f;
#pragma unroll
            for (int j = 0; j < 4; ++j) gs += __expf(gl[j] - gm);
            const float ptop = 1.f / gs;
            float el[8];
#pragma unroll
            for (int j = 0; j < 8; ++j) el[j] = L[4 + gi * 8 + j] + bre[gi * 8 + j];
            int i1 = 0; float m1 = el[0];
#pragma unroll
            for (int j = 1; j < 8; ++j) if (el[j] > m1) { m1 = el[j]; i1 = j; }
            int i2 = -1; float m2 = -3e38f;
#pragma unroll
            for (int j = 0; j < 8; ++j) if (j != i1 && el[j] > m2) { m2 = el[j]; i2 = j; }
            const float pb = __expf(m2 - m1), inv = ptop / (1.f + pb);
            e1 = gi * 8 + i1; e2 = gi * 8 + i2; w1 = inv; w2 = pb * inv;
            rk1 = __hip_atomic_fetch_add((LAS int*)lcnt + e1, 1, __ATOMIC_RELAXED, __HIP_MEMORY_SCOPE_WORKGROUP);
            rk2 = __hip_atomic_fetch_add((LAS int*)lcnt + e2, 1, __ATOMIC_RELAXED, __HIP_MEMORY_SCOPE_WORKGROUP);
        }
        __syncthreads();
        if (F.tid < 32) { const int n = lcnt[F.tid]; int base = 0; if (n > 0) base = (int)__hip_atomic_fetch_add(F.ctl + CW_ECNT + 64 * F.tid, (unsigned)n, RLX_AGENT); lcnt[32 + F.tid] = base; }
        __syncthreads();
        if (lane < 16) { const int tok = tile * 128 + F.wave * 16 + lane; const int s1 = lcnt[32 + e1] + rk1, s2 = lcnt[32 + e2] + rk2;
            list[(size_t)e1 * T + s1] = tok; list[(size_t)e2 * T + s2] = tok;
            u32x4 r0; r0.x = (unsigned)e1; r0.y = (unsigned)s1; r0.z = (unsigned)e2; r0.w = (unsigned)s2;
            u32x4 r1; r1.x = __builtin_bit_cast(unsigned, w1); r1.y = __builtin_bit_cast(unsigned, w2); r1.z = 0u; r1.w = 0u;
            *(u32x4*)(tokrec + (size_t)tok * 8) = r0; *(u32x4*)(tokrec + (size_t)tok * 8 + 4) = r1; }
        __syncthreads();
    }
}

__device__ __forceinline__ bool moe_next(const volatile LAS int* tab, int i, int G, int c, int NT, pg8::Unit& u) {
    const int nwg = tab[64] * NT; const long L = (long)i * G + c; if (L >= nwg) return false;
    int wgid = (int)L; { const int q = nwg / 8, r = nwg % 8, xcd = wgid % 8, off = wgid / 8; wgid = (xcd < r ? xcd * (q + 1) : r * (q + 1) + (xcd - r) * q) + off; }
    const int mtg = wgid / NT; int e = 0;
    for (int k = 1; k < NE; ++k) e += (tab[32 + k] <= mtg) ? 1 : 0;
    u.e = __builtin_amdgcn_readfirstlane(e); u.pm = __builtin_amdgcn_readfirstlane(mtg - tab[32 + e]); u.pn = __builtin_amdgcn_readfirstlane(wgid % NT); return true;
}
struct MoeUp {
    static constexpr bool PERM = true;
    int K, G, c; const volatile LAS int* tab; const bf16_t* H2; const bf16_t* WGU; const int* list; bf16_t* ACT;
    __device__ __forceinline__ bool next(int i, pg8::Unit& u) const { return moe_next(tab, i, G, c, 2, u); }
    __device__ __forceinline__ const char* a_base(const pg8::Unit&) const { return (const char*)H2; }
    __device__ __forceinline__ const char* b_base(const pg8::Unit& u) const { return (const char*)WGU + ((size_t)u.e * 512 + u.pn * 256) * K * 2; }
    __device__ __forceinline__ void a_voff(const pg8::Unit& u, const int (&R)[2], const int (&C)[2], unsigned (&v)[2][2]) const {
        const int cn = tab[u.e]; const int* lp = list + (size_t)u.e * T;
#pragma unroll
        for (int h = 0; h < 2; ++h)
#pragma unroll
            for (int i = 0; i < 2; ++i) { const int idx = u.pm * 256 + h * 128 + R[i]; const int tok = lp[idx < cn ? idx : 0]; v[h][i] = (unsigned)(tok * K + C[i]) * 2u; } }
    __device__ __forceinline__ void epi(const f32x4 (&acc)[2][2][4][2], const pg8::Unit& u, int wr, int wc, int fr, int fq) const {
        const int row0 = tab[32 + u.e] * 256 + u.pm * 256 + wr * 64 + fr;
        bf16_t* base = ACT + u.pn * 128 + wc * 32 + 8 * fq;
#pragma unroll
        for (int ai = 0; ai < 2; ++ai)
#pragma unroll
            for (int m = 0; m < 4; ++m) { bf16_t* rowp = base + (size_t)(row0 + ai * 128 + m * 16) * DE;
                f32x4 g0 = acc[ai][0][m][0], g1 = acc[ai][0][m][1]; const f32x4 u0 = acc[ai][1][m][0], u1 = acc[ai][1][m][1];
#pragma unroll
                for (int j = 0; j < 4; ++j) { g0[j] = fast_silu(g0[j]) * u0[j]; g1[j] = fast_silu(g1[j]) * u1[j]; }
                u32x4 w; w.x = cvt_pk_bf16(g0[0], g0[1]); w.y = cvt_pk_bf16(g0[2], g0[3]); w.z = cvt_pk_bf16(g1[0], g1[1]); w.w = cvt_pk_bf16(g1[2], g1[3]);
                *(u32x4*)rowp = w; }
    }
};
struct MoeDown {
    static constexpr bool PERM = true;
    int K, G, c; const volatile LAS int* tab; const bf16_t* ACT; const bf16_t* WD; bf16_t* YS;
    __device__ __forceinline__ bool next(int i, pg8::Unit& u) const { return moe_next(tab, i, G, c, 4, u); }
    __device__ __forceinline__ const char* a_base(const pg8::Unit& u) const { return (const char*)ACT + ((size_t)tab[32 + u.e] * 256 + u.pm * 256) * K * 2; }
    __device__ __forceinline__ const char* b_base(const pg8::Unit& u) const { return (const char*)WD + ((size_t)u.e * DM + u.pn * 256) * K * 2; }
    __device__ __forceinline__ void a_voff(const pg8::Unit&, const int (&R)[2], const int (&C)[2], unsigned (&v)[2][2]) const {
#pragma unroll
        for (int i = 0; i < 2; ++i) { v[0][i] = (unsigned)(R[i] * K + C[i]) * 2u; v[1][i] = v[0][i] + (unsigned)(128 * K * 2); } }
    __device__ __forceinline__ void epi(const f32x4 (&acc)[2][2][4][2], const pg8::Unit& u, int wr, int wc, int fr, int fq) const {
        const int row0 = tab[32 + u.e] * 256 + u.pm * 256 + wr * 64 + fr;
        bf16_t* base = YS + u.pn * 256 + wc * 32 + 8 * fq;
#pragma unroll
        for (int ai = 0; ai < 2; ++ai)
#pragma unroll
            for (int m = 0; m < 4; ++m) { bf16_t* rowp = base + (size_t)(row0 + ai * 128 + m * 16) * DM;
#pragma unroll
                for (int bj = 0; bj < 2; ++bj) { const f32x4 v0 = acc[ai][bj][m][0], v1 = acc[ai][bj][m][1];
                    u32x4 w; w.x = cvt_pk_bf16(v0[0], v0[1]); w.y = cvt_pk_bf16(v0[2], v0[3]); w.z = cvt_pk_bf16(v1[0], v1[1]); w.w = cvt_pk_bf16(v1[2], v1[3]);
                    *(u32x4*)(rowp + bj * 128) = w; } }
    }
};

__device__ __forceinline__ void p8_final(Frame& F) {
    float* X = F.out; const bf16_t* YS = (const bf16_t*)(F.ws + WS_YS); const unsigned* tokrec = (const unsigned*)(F.ws + WS_TOK);
    const float* mod = (const float*)(F.ws + WS_MOD); const float* lg = F.in[24]; const float* lb = F.in[25];
    volatile LAS int* tab = (volatile LAS int*)(F.lds + TAB_OFF);
    const int lane = F.lane; const int gw = blockIdx.x * NWAVES + F.wave, NGW = F.G * NWAVES;
    f32x4 lgv[4], lbv[4];
#pragma unroll
    for (int j = 0; j < 4; ++j) { const int col = 4 * lane + 256 * j; lgv[j] = *(const f32x4*)(lg + col); lbv[j] = *(const f32x4*)(lb + col); }
#pragma unroll 1
    for (int base = gw; base < T; base += 2 * NGW) {
        int tr[2]; bool ok[2]; u32x4 r0[2]; u32x2 r1[2];
#pragma unroll
        for (int r = 0; r < 2; ++r) { const int t = base + r * NGW; ok[r] = t < T; tr[r] = ok[r] ? t : base; r0[r] = *(const u32x4*)(tokrec + (size_t)tr[r] * 8); r1[r] = *(const u32x2*)(tokrec + (size_t)tr[r] * 8 + 4); }
        f32x4 z[2][4]; u32x2 ya[2][4], yb[2][4]; float w1[2], w2[2]; f32x4 gv[2][4];
#pragma unroll
        for (int r = 0; r < 2; ++r) {
            const int e1 = __builtin_amdgcn_readfirstlane((int)r0[r].x), s1 = __builtin_amdgcn_readfirstlane((int)r0[r].y), e2 = __builtin_amdgcn_readfirstlane((int)r0[r].z), s2 = __builtin_amdgcn_readfirstlane((int)r0[r].w);
            w1[r] = __builtin_bit_cast(float, __builtin_amdgcn_readfirstlane(r1[r].x)); w2[r] = __builtin_bit_cast(float, __builtin_amdgcn_readfirstlane(r1[r].y));
            const size_t ra = (size_t)(tab[32 + e1] * 256 + s1), rb = (size_t)(tab[32 + e2] * 256 + s2);
            const float* g2 = mod + (tr[r] / SEQ) * 6 * DM + 5 * DM;
#pragma unroll
            for (int j = 0; j < 4; ++j) { const int col = 4 * lane + 256 * j;
                z[r][j] = *(const f32x4*)(X + (size_t)tr[r] * DM + col); gv[r][j] = *(const f32x4*)(g2 + col);
                ya[r][j] = *(const u32x2*)(YS + ra * DM + col); yb[r][j] = *(const u32x2*)(YS + rb * DM + col); } }
        float sm[2];
#pragma unroll
        for (int r = 0; r < 2; ++r) { sm[r] = 0.f;
#pragma unroll
            for (int j = 0; j < 4; ++j) { f32x4 f;
                f[0] = w1[r] * __builtin_bit_cast(float, ya[r][j].x << 16) + w2[r] * __builtin_bit_cast(float, yb[r][j].x << 16);
                f[1] = w1[r] * __builtin_bit_cast(float, ya[r][j].x & 0xffff0000u) + w2[r] * __builtin_bit_cast(float, yb[r][j].x & 0xffff0000u);
                f[2] = w1[r] * __builtin_bit_cast(float, ya[r][j].y << 16) + w2[r] * __builtin_bit_cast(float, yb[r][j].y << 16);
                f[3] = w1[r] * __builtin_bit_cast(float, ya[r][j].y & 0xffff0000u) + w2[r] * __builtin_bit_cast(float, yb[r][j].y & 0xffff0000u);
                z[r][j] = z[r][j] * ALPHA + gv[r][j] * f; sm[r] += (z[r][j][0] + z[r][j][1]) + (z[r][j][2] + z[r][j][3]); } }
#pragma unroll
        for (int o = 1; o < 64; o <<= 1) {
#pragma unroll
            for (int r = 0; r < 2; ++r) sm[r] += __shfl_xor(sm[r], o); }
        float sq[2];
#pragma unroll
        for (int r = 0; r < 2; ++r) { const float mean = sm[r] * (1.f / DM); sq[r] = 0.f;
#pragma unroll
            for (int j = 0; j < 4; ++j) { z[r][j] = z[r][j] - mean; sq[r] += (z[r][j][0] * z[r][j][0] + z[r][j][1] * z[r][j][1]) + (z[r][j][2] * z[r][j][2] + z[r][j][3] * z[r][j][3]); } }
#pragma unroll
        for (int o = 1; o < 64; o <<= 1) {
#pragma unroll
            for (int r = 0; r < 2; ++r) sq[r] += __shfl_xor(sq[r], o); }
#pragma unroll
        for (int r = 0; r < 2; ++r) { const float rstd = rsqrtf(sq[r] * (1.f / DM) + EPS);
            if (ok[r]) {
#pragma unroll
                for (int j = 0; j < 4; ++j) { const int col = 4 * lane + 256 * j; *(f32x4*)(X + (size_t)tr[r] * DM + col) = z[r][j] * rstd * lgv[j] + lbv[j]; } } }
    }
}

__global__ void __launch_bounds__(NWAVES * 64, 2) mega_fwd(Args args) {
    extern __shared__ __attribute__((aligned(16))) unsigned char lds[];
    Frame F;
    F.lds = (LAS unsigned char*)lds;
    F.MISC = (volatile LAS unsigned*)(F.lds + MISC_OFF);
    F.tid = threadIdx.x; F.lane = F.tid & 63; F.wave = __builtin_amdgcn_readfirstlane(F.tid >> 6);
    F.G = gridDim.x; { const int bx = blockIdx.x; F.vcu = (F.G % 8 == 0) ? (bx % 8) * (F.G / 8) + bx / 8 : bx; }
    F.ws = args.ws; F.out = args.out; F.ctl = (gu32*)(args.ws + WS_CTL);
#pragma unroll
    for (int i = 0; i < 26; ++i) F.in[i] = args.in[i];
    for (int u = F.tid; u < (LDS_BYTES - LDSCTL_OFF) / 4; u += NWAVES * 64) ((LAS unsigned*)(F.lds + LDSCTL_OFF))[u] = 0u;
    __syncthreads();
    XcdBarrier bar = xcd_barrier_post((unsigned*)(F.ctl + CW_BAR), F.MISC + 8);
    volatile LAS unsigned* TS = (volatile LAS unsigned*)(F.lds + LDSCTL_OFF + 2048);
#define STAMP(k) do { if (DIAG && blockIdx.x == 0 && F.tid == 0) TS[k] = (unsigned)__builtin_amdgcn_s_memrealtime(); } while (0)
    STAMP(0);
    const int lo = args.ph_lo, hi = args.ph_hi;
#define IN(k) (lo <= (k) && (k) < hi)
#define BOTH(k) (IN(k) && IN((k) + 1))
    if (IN(0)) { p0_prologue(F); if (DUP_PHASE == 0) { xcd_barrier(bar); p0_prologue(F); } if (BOTH(0)) xcd_barrier(bar); STAMP(1); }
    if (IN(1)) { p1_modulate(F); if (DUP_PHASE == 1) { xcd_barrier(bar); p1_modulate(F); } if (BOTH(1)) xcd_barrier(bar); STAMP(2); }
    if (IN(2)) {
        InProj S; S.K = DM; S.G = F.G; S.c = (int)blockIdx.x; S.A = (const bf16_t*)(F.ws + WS_H); S.Bt = (const bf16_t*)(F.ws + WS_WI); S.bias = (const float*)(F.ws + WS_BPERM);
        S.VG = (bf16_t*)(F.ws + WS_VG); S.Q = (bf16_t*)(F.ws + WS_Q); S.KV = (bf16_t*)(F.ws + WS_KV);
        pg8::gemm_phase<InProj>(F.lds + RING_OFF, S);
        if (DUP_PHASE == 2) { xcd_barrier(bar); pg8::gemm_phase<InProj>(F.lds + RING_OFF, S); }
        if (BOTH(2)) xcd_barrier(bar); STAMP(3);
    }
    if (IN(3)) { p3_mixers(F); if (DUP_PHASE == 3) { xcd_barrier(bar); p3_mixers(F); } if (DUP_PHASE == 30) { xcd_barrier(bar); p3_attn_only(F); } if (DUP_PHASE == 31) { xcd_barrier(bar); p3_conv_only(F); } if (BOTH(3)) xcd_barrier(bar); STAMP(4); }
    if (IN(4)) {
        OutProj S; S.K = DM; S.G = F.G; S.c = (int)blockIdx.x; S.A = (const bf16_t*)(F.ws + WS_H); S.Bt = (const bf16_t*)(F.ws + WS_WO); S.bo = F.in[14]; S.MIX = (bf16_t*)(F.ws + WS_MIX);
        pg8::gemm_phase<OutProj>(F.lds + RING_OFF, S);
        if (DUP_PHASE == 4) { xcd_barrier(bar); pg8::gemm_phase<OutProj>(F.lds + RING_OFF, S); }
        if (BOTH(4)) xcd_barrier(bar); STAMP(5);
    }
    if (IN(5)) { p5_rows(F); if (BOTH(5)) xcd_barrier(bar); STAMP(6); }
    if (IN(6) || IN(7) || IN(8)) build_route_table(F);
    if (IN(6)) {
        MoeUp S; S.K = DM; S.G = F.G; S.c = (int)blockIdx.x; S.tab = (const volatile LAS int*)(F.lds + TAB_OFF); S.H2 = (const bf16_t*)(F.ws + WS_H2); S.WGU = (const bf16_t*)(F.ws + WS_WGU);
        S.list = (const int*)(F.ws + WS_LIST); S.ACT = (bf16_t*)(F.ws + WS_ACT);
        pg8::gemm_phase<MoeUp>(F.lds + RING_OFF, S);
        if (DUP_PHASE == 6) { xcd_barrier(bar); pg8::gemm_phase<MoeUp>(F.lds + RING_OFF, S); }
        if (BOTH(6)) xcd_barrier(bar); STAMP(7);
    }
    if (IN(7)) {
        MoeDown S; S.K = DE; S.G = F.G; S.c = (int)blockIdx.x; S.tab = (const volatile LAS int*)(F.lds + TAB_OFF); S.ACT = (const bf16_t*)(F.ws + WS_ACT); S.WD = (const bf16_t*)(F.ws + WS_WD); S.YS = (bf16_t*)(F.ws + WS_YS);
        pg8::gemm_phase<MoeDown>(F.lds + RING_OFF, S);
        if (DUP_PHASE == 7) { xcd_barrier(bar); pg8::gemm_phase<MoeDown>(F.lds + RING_OFF, S); }
        if (BOTH(7)) xcd_barrier(bar); STAMP(8);
    }
    if (IN(8)) { p8_final(F); }
#if DIAG
    {
        xcd_barrier(bar); STAMP(9);
        __syncthreads();
        const unsigned ta = (DIAG_A == 9) ? TS[9] - TS[0] : TS[DIAG_A + 1] - TS[DIAG_A];
        const unsigned tb = (DIAG_B == 9) ? TS[9] - TS[0] : TS[DIAG_B + 1] - TS[DIAG_B];
        if (blockIdx.x == 0) {
            const float da = (float)ta * 0.01f, db = (float)tb * 0.01f;
            int n = (int)(db * 500.f); if (n > 126000) n = 126000;
            const int NGW = F.G * NWAVES;
            for (int e = F.tid; e < n; e += 512) { const int ee = e + 1024; const int ri = ee >> 10, col = ee & 1023; const int row = (ri & 7) + (ri >> 3) * NGW; F.out[(size_t)row * DM + col] += 0.05f; }
            if (F.tid == 0) F.out[0] += 1.f + da * 0.02f;
        }
    }
#endif
#undef IN
#undef BOTH
}

namespace nv {
__device__ __forceinline__ float sigmoidf_(float v) { return 1.f / (1.f + __expf(-v)); }
__device__ __forceinline__ float siluf_(float v) { return v / (1.f + __expf(-v)); }
__global__ void __launch_bounds__(256) k_gemm(const float* A, const float* B, const float* bias, float* C, int M, int N, int K) {
    __shared__ float As[16][65]; __shared__ float Bs[16][64];
    int tx = threadIdx.x % 16, ty = threadIdx.x / 16; int m0 = blockIdx.y * 64, n0 = blockIdx.x * 64;
    float acc[4][4] = {};
    for (int k0 = 0; k0 < K; k0 += 16) {
        for (int i = threadIdx.x; i < 64 * 16; i += 256) { int r = i / 16, kk = i % 16; As[kk][r] = A[(size_t)(m0 + r) * K + k0 + kk]; }
        for (int i = threadIdx.x; i < 16 * 64; i += 256) { int kk = i / 64, cc = i % 64; Bs[kk][cc] = B[(size_t)(k0 + kk) * N + n0 + cc]; }
        __syncthreads();
#pragma unroll
        for (int kk = 0; kk < 16; ++kk) { float a[4], b[4];
#pragma unroll
            for (int i = 0; i < 4; ++i) { a[i] = As[kk][ty * 4 + i]; b[i] = Bs[kk][tx * 4 + i]; }
#pragma unroll
            for (int i = 0; i < 4; ++i)
#pragma unroll
                for (int j = 0; j < 4; ++j) acc[i][j] += a[i] * b[j]; }
        __syncthreads();
    }
    for (int i = 0; i < 4; ++i) for (int j = 0; j < 4; ++j) { int r = m0 + ty * 4 + i, cc = n0 + tx * 4 + j; C[(size_t)r * N + cc] = acc[i][j] + (bias ? bias[cc] : 0.f); }
}
__device__ __forceinline__ float block_sum512(float v, float* red) {
    for (int o = 32; o > 0; o >>= 1) v += __shfl_xor(v, o);
    __syncthreads();
    if ((threadIdx.x & 63) == 0) red[threadIdx.x >> 6] = v;
    __syncthreads();
    float s = 0.f; for (int i = 0; i < 8; ++i) s += red[i];
    return s;
}
__global__ void __launch_bounds__(512) k_conv2(const bf16_t* VG, const float* conv_w, const float* conv_b, const float* lng, const float* lnb, const float* outg, float* ycat) {
    __shared__ float red[8];
    int t = blockIdx.x, c = threadIdx.x; int s = t % SEQ;
    float acc = 0.f;
    for (int j = 0; j < CW; ++j) { int ss = s - (CW - 1) + j; if (ss < 0) continue; acc += conv_w[j * DCONV + c] * bf2f(VG[(size_t)(t - (CW - 1) + j) * DCONV + c]); }
    acc += conv_b[c];
    float mean = block_sum512(acc, red) * (1.f / DCONV); float d = acc - mean;
    float var = block_sum512(d * d, red) * (1.f / DCONV);
    float y = d * rsqrtf(var + EPS) * lng[c] + lnb[c];
    y = siluf_(y);
    float q = y * y; for (int o = 32; o > 0; o >>= 1) q += __shfl_xor(q, o);
    y = y * rsqrtf(q * (1.f / 64.f) + EPS) * outg[c];
    ycat[(size_t)t * DM + c] = y;
}
__global__ void __launch_bounds__(512) k_attn2(const bf16_t* Q, const bf16_t* KV, const float* sinks, const float* outg, float* ycat) {
    __shared__ float ps[8][128];
    int t = blockIdx.x, h = threadIdx.x >> 6, lane = threadIdx.x & 63; int s = t % SEQ; int kvh = h / 4;
    const bf16_t* q = Q + (size_t)t * DATTN + h * HD;
    float sc[2];
    for (int i = 0; i < 2; ++i) { int d = lane + 64 * i; int ss = s - d; float v = -1e30f;
        if (ss >= 0) { const bf16_t* k = KV + (size_t)(t - d) * 256 + kvh * HD; float a = 0.f; for (int e = 0; e < HD; ++e) a += bf2f(q[e]) * bf2f(k[e]); v = a; }
        sc[i] = v; }
    float sk = sinks[h] * LOG2E; float m = fmaxf(fmaxf(sc[0], sc[1]), sk);
    for (int o = 32; o > 0; o >>= 1) m = fmaxf(m, __shfl_xor(m, o));
    float p0 = (sc[0] > -1e29f) ? exp2f(sc[0] - m) : 0.f, p1 = (sc[1] > -1e29f) ? exp2f(sc[1] - m) : 0.f;
    float l = p0 + p1; for (int o = 32; o > 0; o >>= 1) l += __shfl_xor(l, o);
    l += exp2f(sk - m);
    ps[h][lane] = p0 / l; ps[h][lane + 64] = p1 / l;
    __syncthreads();
    float o = 0.f; int nd = (s + 1 < WIN) ? s + 1 : WIN;
    for (int d = 0; d < nd; ++d) o += ps[h][d] * bf2f(KV[(size_t)(t - d) * 256 + DKV + kvh * HD + lane]);
    float qq = o * o; for (int oo = 32; oo > 0; oo >>= 1) qq += __shfl_xor(qq, oo);
    ycat[(size_t)t * DM + DCONV + h * HD + lane] = o * rsqrtf(qq * (1.f / 64.f) + EPS) * outg[h * HD + lane];
}
__device__ __forceinline__ float block_sum256(float v, float* red) {
    for (int o = 32; o > 0; o >>= 1) v += __shfl_xor(v, o);
    __syncthreads();
    if ((threadIdx.x & 63) == 0) red[threadIdx.x >> 6] = v;
    __syncthreads();
    return red[0] + red[1] + red[2] + red[3];
}
__global__ void __launch_bounds__(256) k_ln1(const float* x, const float* mix, const float* mod, const float* g, const float* bta, float* x1) {
    __shared__ float red[4];
    int t = blockIdx.x, b = t / SEQ; float z[4]; float s = 0.f;
    for (int i = 0; i < 4; ++i) { int c = threadIdx.x + 256 * i; z[i] = ALPHA * x[(size_t)t * DM + c] + mod[b * 6 * DM + 2 * DM + c] * mix[(size_t)t * DM + c]; s += z[i]; }
    float mean = block_sum256(s, red) * (1.f / DM); float q = 0.f;
    for (int i = 0; i < 4; ++i) { z[i] -= mean; q += z[i] * z[i]; }
    float rstd = rsqrtf(block_sum256(q, red) * (1.f / DM) + EPS);
    for (int i = 0; i < 4; ++i) { int c = threadIdx.x + 256 * i; x1[(size_t)t * DM + c] = z[i] * rstd * g[c] + bta[c]; }
}
__global__ void k_bf2f(const bf16_t* in, float* out, size_t n) { size_t i = (size_t)blockIdx.x * blockDim.x + threadIdx.x; if (i < n) out[i] = bf2f(in[i]); }
__global__ void __launch_bounds__(256) k_moe(float* io, const float* mod, const float* wrg, const float* brg, const float* wre, const float* bre,
                                            const float* wg, const float* wu, const float* wd, const float* g2ln, const float* b2ln) {
    __shared__ float h2[DM]; __shared__ float part[4][64]; __shared__ float logit[64]; __shared__ float act[DE]; __shared__ int se[2]; __shared__ float sw[2]; __shared__ float red[4];
    int t = blockIdx.x, b = t / SEQ, tid = threadIdx.x;
    float x1v[4];
    for (int i = 0; i < 4; ++i) { int c = tid + 256 * i; x1v[i] = io[(size_t)t * DM + c]; h2[c] = x1v[i] * (1.f + mod[b * 6 * DM + 4 * DM + c]) + mod[b * 6 * DM + 3 * DM + c]; }
    __syncthreads();
    { int j = tid & 63, kp = tid >> 6; float a = 0.f;
      if (j < 36) { for (int k = kp * 256; k < kp * 256 + 256; ++k) a += h2[k] * (j < 4 ? wrg[k * NG + j] : wre[k * NE + (j - 4)]); }
      part[kp][j] = a; }
    __syncthreads();
    if (tid < 36) logit[tid] = part[0][tid] + part[1][tid] + part[2][tid] + part[3][tid] + (tid < 4 ? brg[tid] : bre[tid - 4]);
    __syncthreads();
    if (tid == 0) {
        float m = logit[0]; int gi = 0; for (int i = 1; i < 4; ++i) if (logit[i] > m) { m = logit[i]; gi = i; }
        float ssum = 0.f; for (int i = 0; i < 4; ++i) ssum += __expf(logit[i] - m); float ptop = 1.f / ssum;
        const float* el = logit + 4 + gi * 8; float em = el[0]; int i1 = 0; for (int i = 1; i < 8; ++i) if (el[i] > em) { em = el[i]; i1 = i; }
        float e2m = -3e38f; int i2 = -1; for (int i = 0; i < 8; ++i) if (i != i1 && el[i] > e2m) { e2m = el[i]; i2 = i; }
        float pa = 1.f, pb = __expf(e2m - em); float inv = ptop / (pa + pb);
        se[0] = gi * 8 + i1; se[1] = gi * 8 + i2; sw[0] = pa * inv; sw[1] = pb * inv;
    }
    __syncthreads();
    float y[4] = {0.f, 0.f, 0.f, 0.f};
    for (int s = 0; s < 2; ++s) {
        int e = se[s]; float w = sw[s];
        const float* G = wg + (size_t)e * DM * DE; const float* U = wu + (size_t)e * DM * DE; const float* Dn = wd + (size_t)e * DE * DM;
        float ga = 0.f, ua = 0.f;
        for (int k = 0; k < DM; ++k) { float hv = h2[k]; ga += hv * G[(size_t)k * DE + tid]; ua += hv * U[(size_t)k * DE + tid]; }
        __syncthreads();
        act[tid] = siluf_(ga) * ua;
        __syncthreads();
        for (int j = 0; j < DE; ++j) { float av = act[j] * w; for (int i = 0; i < 4; ++i) y[i] += av * Dn[(size_t)j * DM + tid + 256 * i]; }
    }
    float z[4]; float sm = 0.f;
    for (int i = 0; i < 4; ++i) { int c = tid + 256 * i; z[i] = ALPHA * x1v[i] + mod[b * 6 * DM + 5 * DM + c] * y[i]; sm += z[i]; }
    float mean = block_sum256(sm, red) * (1.f / DM); float q = 0.f;
    for (int i = 0; i < 4; ++i) { z[i] -= mean; q += z[i] * z[i]; }
    float rstd = rsqrtf(block_sum256(q, red) * (1.f / DM) + EPS);
    for (int i = 0; i < 4; ++i) { int c = tid + 256 * i; io[(size_t)t * DM + c] = z[i] * rstd * g2ln[c] + b2ln[c]; }
}
}

extern "C" void kernel_launch(void* const* d_in, const int* in_sizes, int n_in, void* d_out, int out_size, void* d_ws, size_t ws_size, hipStream_t stream) {
    static int grid = 0;
    if (grid == 0) {
        int dev = 0, cus = 0;
        if (hipGetDevice(&dev) != hipSuccess || hipDeviceGetAttribute(&cus, hipDeviceAttributeMultiprocessorCount, dev) != hipSuccess) { fprintf(stderr, "kernel_launch: device query failed\n"); grid = -1; return; }
        if (hipFuncSetAttribute((const void*)mega_fwd, hipFuncAttributeMaxDynamicSharedMemorySize, LDS_BYTES) != hipSuccess) { fprintf(stderr, "kernel_launch: hipFuncSetAttribute failed\n"); grid = -1; return; }
        int per_cu = 0;
        if (hipOccupancyMaxActiveBlocksPerMultiprocessor(&per_cu, (const void*)mega_fwd, NWAVES * 64, LDS_BYTES) != hipSuccess || per_cu < 1) fprintf(stderr, "kernel_launch: occupancy query reports %d\n", per_cu);
        (void)hipGetLastError();
        grid = cus;
    }
    if (grid < 0) return;
    (void)hipMemsetAsync((char*)d_ws + WS_CTL, 0, CTL_ZERO_BYTES, stream);
    Args a{};
    for (int i = 0; i < 26; ++i) a.in[i] = (const float*)d_in[i];
    a.out = (float*)d_out; a.ws = (unsigned char*)d_ws; a.ph_lo = 0; a.ph_hi = DEV_STAGE + 1;
    hipLaunchKernelGGL(mega_fwd, dim3(grid), dim3(NWAVES * 64), LDS_BYTES, stream, a);
    {
        using namespace nv;
        char* ws = (char*)d_ws; float* out = (float*)d_out;
        const float* x = (const float*)d_in[0];
        const float* mod = (const float*)(ws + WS_MOD);
        float* ycat = (float*)(ws + WS_DEV1);
        float* mix = (float*)(ws + 56 * MiB);
#if DEV_STAGE == 3
        k_bf2f<<<(unsigned)((size_t)T * DM / 256), 256, 0, stream>>>((const bf16_t*)(ws + WS_H), ycat, (size_t)T * DM);
        mix = (float*)(ws + 120 * MiB);
        k_gemm<<<dim3(DM / 64, T / 64), 256, 0, stream>>>(ycat, (const float*)d_in[13], (const float*)d_in[14], mix, T, DM, DM);
        k_ln1<<<T, 256, 0, stream>>>(x, mix, mod, (const float*)d_in[15], (const float*)d_in[16], out);
        k_moe<<<T, 256, 0, stream>>>(out, mod, (const float*)d_in[17], (const float*)d_in[18], (const float*)d_in[19], (const float*)d_in[20], (const float*)d_in[21], (const float*)d_in[22], (const float*)d_in[23], (const float*)d_in[24], (const float*)d_in[25]);
#endif
#if DEV_STAGE == 2
        k_conv2<<<T, 512, 0, stream>>>((const bf16_t*)(ws + WS_VG), (const float*)d_in[6], (const float*)d_in[7], (const float*)d_in[8], (const float*)d_in[9], (const float*)d_in[10], ycat);
        k_attn2<<<T, 512, 0, stream>>>((const bf16_t*)(ws + WS_Q), (const bf16_t*)(ws + WS_KV), (const float*)d_in[11], (const float*)d_in[12], ycat);
        k_gemm<<<dim3(DM / 64, T / 64), 256, 0, stream>>>(ycat, (const float*)d_in[13], (const float*)d_in[14], mix, T, DM, DM);
        k_ln1<<<T, 256, 0, stream>>>(x, mix, mod, (const float*)d_in[15], (const float*)d_in[16], out);
        k_moe<<<T, 256, 0, stream>>>(out, mod, (const float*)d_in[17], (const float*)d_in[18], (const float*)d_in[19], (const float*)d_in[20], (const float*)d_in[21], (const float*)d_in[22], (const float*)d_in[23], (const float*)d_in[24], (const float*)d_in[25]);
#endif
    }
}
```

```cpp
#include <hip/hip_runtime.h>
#include <cstdio>
#include <cstdint>

#ifndef DIAG
#define DIAG 0
#endif
#ifndef DIAG_A
#define DIAG_A 9
#endif
#ifndef DIAG_B
#define DIAG_B 9
#endif
#ifndef DUP_PHASE
#define DUP_PHASE -1
#endif
#ifndef DEV_STAGE
#define DEV_STAGE 8
#endif

#define LAS __attribute__((address_space(3)))
#define GAS __attribute__((address_space(1)))
typedef unsigned short bf16_t;
typedef short bf16x8 __attribute__((ext_vector_type(8)));
typedef float f32x4 __attribute__((ext_vector_type(4)));
typedef float f32x2 __attribute__((ext_vector_type(2)));
typedef unsigned u32x4 __attribute__((ext_vector_type(4)));
typedef unsigned u32x2 __attribute__((ext_vector_type(2)));
typedef GAS unsigned gu32;

constexpr int DM = 1024, NBATCH = 8, SEQ = 4096, T = NBATCH * SEQ;
constexpr int DCONV = 512, CW = 31, NH = 8, NKV = 2, HD = 64, DATTN = 512, DKV = 128, WIN = 128;
constexpr int DIN = 1792, NG = 4, EPG = 8, NE = 32, DE = 256;
constexpr float ALPHA = 1.189207115002721f, EPS = 1e-5f;
constexpr float LOG2E = 1.4426950408889634f;
constexpr float QSCALE = 0.125f * LOG2E;

constexpr size_t MiB = 1u << 20;
constexpr size_t WS_CTL = 0, CTL_ZERO_BYTES = 1 * MiB;
constexpr size_t WS_MOD = 1 * MiB;
constexpr size_t WS_BPERM = 1 * MiB + 256 * 1024;
constexpr size_t WS_WR = 1 * MiB + 512 * 1024;
constexpr size_t WS_WI = 2 * MiB;
constexpr size_t WS_WO = 6 * MiB;
constexpr size_t WS_WGU = 8 * MiB;
constexpr size_t WS_WD = 40 * MiB;
constexpr size_t WS_H = 56 * MiB;
constexpr size_t WS_VG = 120 * MiB;
constexpr size_t WS_Q = 152 * MiB;
constexpr size_t WS_KV = 184 * MiB;
constexpr size_t WS_H2 = 200 * MiB;
constexpr size_t WS_ACT = 264 * MiB;
constexpr size_t WS_LIST = 300 * MiB;
constexpr size_t WS_TOK = 304 * MiB;
constexpr size_t WS_MIX = 120 * MiB;
constexpr size_t WS_YS = 56 * MiB;
constexpr size_t WS_DEV1 = 320 * MiB;
constexpr int CW_BAR = 4096;
constexpr int CW_ECNT = 16384;

constexpr int RING_OFF = 0, RING_BYTES = 139264;
constexpr int LDSCTL_OFF = RING_BYTES, MISC_OFF = LDSCTL_OFF + 320;
constexpr int LDS_BYTES = 147456;
constexpr int NWAVES = 8;

#define RLX_AGENT __ATOMIC_RELAXED, __HIP_MEMORY_SCOPE_AGENT
#define LDS_WAIT() asm volatile("s_waitcnt lgkmcnt(0)" ::: "memory")
#define VM_WAIT() asm volatile("s_waitcnt vmcnt(0)" ::: "memory")

__device__ __forceinline__ unsigned f2bf(float f) { unsigned u = __builtin_bit_cast(unsigned, f); return (u + 0x7fffu + ((u >> 16) & 1u)) >> 16; }
__device__ __forceinline__ unsigned pk2(float lo, float hi) { return f2bf(lo) | (f2bf(hi) << 16); }
__device__ __forceinline__ float bf2f(unsigned short b) { return __builtin_bit_cast(float, (unsigned)b << 16); }
__device__ __forceinline__ unsigned cvt_pk_bf16(float lo, float hi) { unsigned r; asm volatile("v_cvt_pk_bf16_f32 %0, %1, %2" : "=v"(r) : "v"(lo), "v"(hi)); return r; }
__device__ __forceinline__ float fast_sigmoid(float v) { return __builtin_amdgcn_rcpf(1.f + __builtin_amdgcn_exp2f(-v * LOG2E)); }
__device__ __forceinline__ float fast_silu(float v) { return v * fast_sigmoid(v); }

#define XB_TMO      128
#define XB_XCNT(j)  (256  + 64 * (j))
#define XB_XSUB(j)  (1280 + 64 * (j))
#define XB_XGEN(j)  (2304 + 64 * (j))
#define XB_TOP      3328
#define XB_TOPGEN   3392
#define XCD_BAR_WORDS 3456
#define XB_SPIN_CAP (1u << 18)
__device__ __forceinline__ unsigned xb_ld(unsigned* p)              { return __hip_atomic_load(p, __ATOMIC_RELAXED, __HIP_MEMORY_SCOPE_AGENT); }
__device__ __forceinline__ unsigned xb_add(unsigned* p, unsigned v) { return __hip_atomic_fetch_add(p, v, __ATOMIC_RELAXED, __HIP_MEMORY_SCOPE_AGENT); }
__device__ __forceinline__ unsigned xb_xcc_id() { return (unsigned)__builtin_amdgcn_s_getreg((3 << 11) | 20) & 0xFu; }
#define XB_SPIN(cond, bar) do { unsigned _sp = 0; while (cond) { __builtin_amdgcn_s_sleep(1); \
    if ((++_sp & 255u) == 0u) { if (xb_ld(&(bar)[XB_TMO])) break; if (_sp > XB_SPIN_CAP) { atomicAdd(&(bar)[XB_TMO], 1u); break; } } } } while (0)
struct XcdBarrier { unsigned* bar; unsigned x; volatile LAS unsigned* st; };
__device__ __forceinline__ XcdBarrier xcd_barrier_post(unsigned* bar, volatile LAS unsigned* st) {
    XcdBarrier b; b.bar = bar; b.x = xb_xcc_id(); b.st = st;
    if (threadIdx.x == 0) (void)xb_add(&bar[XB_XCNT(b.x)], 1u);
    return b;
}
__device__ __forceinline__ void xcd_barrier_complete(unsigned* bar, unsigned x, unsigned& nloc, unsigned& nx) {
    const unsigned G = gridDim.x * gridDim.y * gridDim.z;
    unsigned sum, cnt, mine, sp = 0u;
    for (;;) {
        sum = 0u; cnt = 0u; mine = 0u;
#pragma unroll
        for (unsigned j = 0; j < 16; ++j) { const unsigned c = xb_ld(&bar[XB_XCNT(j)]); sum += c; cnt += (c > 0u) ? 1u : 0u; mine = (j == x) ? c : mine; }
        if (sum == G) break;
        __builtin_amdgcn_s_sleep(1);
        if ((++sp & 255u) == 0u) { if (xb_ld(&bar[XB_TMO])) break; if (sp > XB_SPIN_CAP) { atomicAdd(&bar[XB_TMO], 1u); break; } }
    }
    nloc = mine > 0u ? mine : 1u; nx = cnt > 0u ? cnt : 1u;
}
__device__ __forceinline__ void xcd_barrier(const XcdBarrier& b) {
    asm volatile("s_waitcnt vmcnt(0)" ::: "memory");
    __syncthreads();
    if (threadIdx.x == 0) {
        unsigned* bar = b.bar;
        __builtin_amdgcn_s_waitcnt(0);
        unsigned nloc = b.st[0], nx = b.st[1];
        if (nloc == 0u) { xcd_barrier_complete(bar, b.x, nloc, nx); b.st[0] = nloc; b.st[1] = nx; }
        const unsigned old = xb_add(&bar[XB_XSUB(b.x)], 1u);
        const unsigned gen = old / nloc;
        if (old + 1u == (gen + 1u) * nloc) {
            __builtin_amdgcn_fence(__ATOMIC_RELEASE, "agent");
            asm volatile("s_waitcnt vmcnt(0)" ::: "memory");
            const unsigned og = xb_add(&bar[XB_TOP], 1u);
            const unsigned tg = og / nx;
            if (og + 1u == (tg + 1u) * nx) xb_add(&bar[XB_TOPGEN], 1u);
            else XB_SPIN(xb_ld(&bar[XB_TOPGEN]) == tg, bar);
            __builtin_amdgcn_fence(__ATOMIC_ACQUIRE, "agent");
            xb_add(&bar[XB_XGEN(b.x)], 1u);
            asm volatile("s_waitcnt vmcnt(0)" ::: "memory");
        } else {
            XB_SPIN(xb_ld(&bar[XB_XGEN(b.x)]) == gen, bar);
            __builtin_amdgcn_fence(__ATOMIC_ACQUIRE, "agent");
            asm volatile("s_waitcnt vmcnt(0)" ::: "memory");
        }
    }
    __syncthreads();
}

namespace pg8 {
constexpr int BM = 256, BK = 64, HALF = 128, HTB = HALF * BK * 2, STAGE_BYTES = 8 * HTB, NXCD = 8, WGM = 8;
__host__ __device__ __forceinline__ int lds_byte(int r, int c) { const int st = (r >> 4) * 2 + (c >> 5), rr = r & 15, cc = c & 31, ob = rr * 64 + cc * 2; return st * 1024 + (ob ^ (((ob >> 9) & 1) << 5)); }
__host__ __device__ __forceinline__ void stage_rc(int b, int& R, int& C) { const int st = b / 1024, sb = b % 1024, swz = sb ^ (((sb >> 9) & 1) << 5); R = (st >> 1) * 16 + swz / 64; C = (st & 1) * 32 + (swz % 64) / 2; }
__host__ __device__ __forceinline__ int perm32(int rho) { const int n = rho >> 4, i = rho & 15; return 8 * (i >> 2) + 4 * n + (i & 3); }

struct Unit { int pm, pn, e; };
__device__ __forceinline__ bool static_next(int i, int G, int c, int nM, int nN, int& pm, int& pn) {
    const int nwg = nM * nN; const long L = (long)i * G + c; if (L >= nwg) return false;
    int wgid = (int)L; { const int q = nwg / NXCD, r = nwg % NXCD, xcd = wgid % NXCD, off = wgid / NXCD; wgid = (xcd < r ? xcd * (q + 1) : r * (q + 1) + (xcd - r) * q) + off; }
    const int nig = WGM * nN, gid = wgid / nig, fm = gid * WGM, gsz = (nM - fm) < WGM ? (nM - fm) : WGM;
    pm = fm + ((wgid % nig) % gsz); pn = (wgid % nig) / gsz; return true;
}

template <class P>
__device__ __forceinline__ void gemm_phase(LAS unsigned char* lds, const P& S) {
    const int tid = threadIdx.x, wid = __builtin_amdgcn_readfirstlane(tid >> 6), lane = tid & 63, wr = wid >> 2, wc = wid & 3, fr = lane & 15, fq = lane >> 4;
    const int K = S.K, nt = K / BK;
    int sR[2], sC[2]; unsigned voffB[2];
#pragma unroll
    for (int i = 0; i < 2; ++i) { int R, C; stage_rc(tid * 16 + i * 8192, R, C); sR[i] = R; sC[i] = C; const int Rb = P::PERM ? ((R & ~31) + perm32(R & 31)) : R; voffB[i] = (unsigned)(Rb * K + C) * 2u; }
    const size_t kstep = (size_t)(BK * 2);
    const size_t hstepB = (size_t)HALF * K * 2;
    const unsigned ldsw = (unsigned)wid * 1024u;
    const int aoff = lds_byte(wr * 64 + fr, fq * 8), boff = lds_byte(wc * 32 + fr, fq * 8);
#define PG8_SA(b, h) (((b) * 2 + (h)) * HTB)
#define PG8_SB(b, h) ((4 + (b) * 2 + (h)) * HTB)
#define PG8_STAGE(bufoff, gbase, voff) do { _Pragma("unroll") for (int _i = 0; _i < 2; ++_i) \
        __builtin_amdgcn_global_load_lds((const unsigned*)((const char*)(gbase) + (voff)[_i]), (LAS unsigned*)(lds + (bufoff) + ldsw + _i * 8192), 16, 0, 0); } while (0)
#define PG8_LDA(dst, b, h) do { _Pragma("unroll") for (int m = 0; m < 4; ++m) _Pragma("unroll") for (int k = 0; k < 2; ++k) dst[m][k] = *(const LAS bf16x8*)(lds + PG8_SA(b, h) + aoff + m * 2048 + k * 1024); } while (0)
#define PG8_LDB(dst, b, h) do { _Pragma("unroll") for (int n = 0; n < 2; ++n) _Pragma("unroll") for (int k = 0; k < 2; ++k) dst[n][k] = *(const LAS bf16x8*)(lds + PG8_SB(b, h) + boff + n * 2048 + k * 1024); } while (0)
#define PG8_MMA(ai, bj, At, Bt) do { __builtin_amdgcn_s_setprio(1); _Pragma("unroll") for (int m = 0; m < 4; ++m) _Pragma("unroll") for (int n = 0; n < 2; ++n) _Pragma("unroll") for (int k = 0; k < 2; ++k) \
        acc[ai][bj][m][n] = __builtin_amdgcn_mfma_f32_16x16x32_bf16(Bt[n][k], At[m][k], acc[ai][bj][m][n], 0, 0, 0); __builtin_amdgcn_s_setprio(0); } while (0)
#define PG8_WAIT_V(n) asm volatile("s_waitcnt vmcnt(" #n ")" ::: "memory")
#define PG8_WAIT_L(n) asm volatile("s_waitcnt lgkmcnt(" #n ")" ::: "memory")
#define PG8_BAR __builtin_amdgcn_s_barrier()
#define PG8_SCHED __builtin_amdgcn_sched_barrier(0)
    Unit cur, nxt; int ui = 0;
    if (!S.next(0, cur)) return;
    f32x4 acc[2][2][4][2];
#pragma unroll
    for (int a = 0; a < 2; ++a)
#pragma unroll
        for (int b = 0; b < 2; ++b)
#pragma unroll
            for (int m = 0; m < 4; ++m)
#pragma unroll
                for (int n = 0; n < 2; ++n) acc[a][b][m][n] = (f32x4){0.f, 0.f, 0.f, 0.f};
    bf16x8 At[4][2], B0[2][2], B1[2][2];
    unsigned vAc[2][2], vAn[2][2];
    S.a_voff(cur, sR, sC, vAc);
    const char* cA = S.a_base(cur); const char* cB = S.b_base(cur);
    PG8_STAGE(PG8_SB(0, 0), cB, voffB); PG8_STAGE(PG8_SB(0, 1), cB + hstepB, voffB); PG8_STAGE(PG8_SA(0, 0), cA, vAc[0]); PG8_STAGE(PG8_SA(0, 1), cA, vAc[1]);
    if (wr == 1) PG8_BAR;
    PG8_WAIT_V(2); PG8_BAR;
    PG8_STAGE(PG8_SB(1, 0), cB + kstep, voffB); PG8_STAGE(PG8_SA(1, 0), cA + kstep, vAc[0]); PG8_STAGE(PG8_SB(1, 1), cB + hstepB + kstep, voffB);
    PG8_WAIT_V(6); PG8_BAR;
    for (;;) {
        const bool has_next = S.next(ui + 1, nxt);
        const char* nA = has_next ? S.a_base(nxt) : cA; const char* nB = has_next ? S.b_base(nxt) : cB;
        if (has_next) S.a_voff(nxt, sR, sC, vAn); else { vAn[0][0] = vAc[0][0]; vAn[0][1] = vAc[0][1]; vAn[1][0] = vAc[1][0]; vAn[1][1] = vAc[1][1]; }
        for (int t = 0; t < nt; t += 2) {
            const bool last = (t == nt - 2);
            const char* a1 = cA + (size_t)(t + 1) * kstep;
            const char* a2 = last ? nA : cA + (size_t)(t + 2) * kstep; const char* b2 = last ? nB : cB + (size_t)(t + 2) * kstep;
            const char* a3 = a2 + kstep; const char* b3 = b2 + kstep;
            unsigned v2[2][2];
            v2[0][0] = last ? vAn[0][0] : vAc[0][0]; v2[0][1] = last ? vAn[0][1] : vAc[0][1]; v2[1][0] = last ? vAn[1][0] : vAc[1][0]; v2[1][1] = last ? vAn[1][1] : vAc[1][1];
            PG8_LDB(B0, 0, 0); PG8_LDB(B1, 0, 1); PG8_SCHED; PG8_LDA(At, 0, 0); PG8_STAGE(PG8_SA(1, 1), a1, vAc[1]);
            PG8_WAIT_V(8); PG8_WAIT_L(0); PG8_BAR; PG8_MMA(0, 0, At, B0); PG8_MMA(0, 1, At, B1); PG8_BAR; PG8_SCHED;
            PG8_LDA(At, 0, 1); PG8_STAGE(PG8_SB(0, 0), b2, voffB); PG8_STAGE(PG8_SB(0, 1), b2 + hstepB, voffB); PG8_STAGE(PG8_SA(0, 0), a2, v2[0]);
            PG8_WAIT_V(8); PG8_WAIT_L(0); PG8_BAR; PG8_MMA(1, 0, At, B0); PG8_MMA(1, 1, At, B1); PG8_BAR; PG8_SCHED;
            PG8_LDB(B0, 1, 0); PG8_LDB(B1, 1, 1); PG8_SCHED; PG8_LDA(At, 1, 0); PG8_STAGE(PG8_SA(0, 1), a2, v2[1]);
            PG8_WAIT_V(8); PG8_WAIT_L(0); PG8_BAR; PG8_MMA(0, 0, At, B0); PG8_MMA(0, 1, At, B1); PG8_BAR; PG8_SCHED;
            PG8_LDA(At, 1, 1); PG8_STAGE(PG8_SB(1, 0), b3, voffB); PG8_STAGE(PG8_SB(1, 1), b3 + hstepB, voffB); PG8_STAGE(PG8_SA(1, 0), a3, v2[0]);
            PG8_WAIT_V(8); PG8_WAIT_L(0); PG8_BAR; PG8_MMA(1, 0, At, B0); PG8_MMA(1, 1, At, B1); PG8_BAR; PG8_SCHED;
        }
        if (wr == 0) PG8_BAR;
        S.epi(acc, cur, wr, wc, fr, fq);
        if (!has_next) break;
#pragma unroll
        for (int a = 0; a < 2; ++a)
#pragma unroll
            for (int b = 0; b < 2; ++b)
#pragma unroll
                for (int m = 0; m < 4; ++m)
#pragma unroll
                    for (int n = 0; n < 2; ++n) acc[a][b][m][n] = (f32x4){0.f, 0.f, 0.f, 0.f};
        cur = nxt; cA = nA; cB = nB; ++ui;
        vAc[0][0] = vAn[0][0]; vAc[0][1] = vAn[0][1]; vAc[1][0] = vAn[1][0]; vAc[1][1] = vAn[1][1];
        if (wr == 1) PG8_BAR;
    }
    PG8_WAIT_V(0);
    PG8_BAR;
#undef PG8_SA
#undef PG8_SB
#undef PG8_STAGE
#undef PG8_LDA
#undef PG8_LDB
#undef PG8_MMA
#undef PG8_WAIT_V
#undef PG8_WAIT_L
#undef PG8_BAR
#undef PG8_SCHED
}
}

struct Frame {
    LAS unsigned char* lds;
    volatile LAS unsigned* MISC;
    gu32* ctl;
    int tid, lane, wave, vcu, G;
    const float* in[26]; float* out; unsigned char* ws;
};
struct Args { const float* in[26]; float* out; unsigned char* ws; int ph_lo, ph_hi; };

__device__ __forceinline__ void sub_stamp(Frame& F, int k) { if (DIAG && blockIdx.x == 0 && F.tid == 0) ((volatile LAS unsigned*)(F.lds + LDSCTL_OFF + 2048))[k] = (unsigned)__builtin_amdgcn_s_memrealtime(); }
template <int CTRL> __device__ __forceinline__ float dpp_mov(float src) { return __builtin_bit_cast(float, __builtin_amdgcn_update_dpp(0, __builtin_bit_cast(int, src), CTRL, 0xF, 0xF, true)); }
__device__ __forceinline__ float group8_sum(float v) {
    v += dpp_mov<0xB1>(v); v += dpp_mov<0x4E>(v); v += dpp_mov<0x141>(v); return v;
}
__device__ __forceinline__ float wave_sum(float v) {
    v = group8_sum(v); v += dpp_mov<0x140>(v);
    return __builtin_bit_cast(float, __builtin_amdgcn_readlane(__builtin_bit_cast(int, v), 0)) + __builtin_bit_cast(float, __builtin_amdgcn_readlane(__builtin_bit_cast(int, v), 16))
         + __builtin_bit_cast(float, __builtin_amdgcn_readlane(__builtin_bit_cast(int, v), 32)) + __builtin_bit_cast(float, __builtin_amdgcn_readlane(__builtin_bit_cast(int, v), 48));
}

struct P0Item { const float* W; bf16_t* WT; int Ksrc, N, dst_row0, k0, n0; };
__device__ __forceinline__ void p0_item_load(const P0Item& I, f32x4 (&v)[8], int lane) {
    const int r = lane >> 3, c4 = (lane & 7) * 4;
#pragma unroll
    for (int i = 0; i < 8; ++i) v[i] = *(const f32x4*)(I.W + (size_t)(I.k0 + 8 * i + r) * I.N + I.n0 + c4);
}
__device__ __forceinline__ void p0_item_store(const P0Item& I, const f32x4 (&v)[8], LAS float* scr, int lane) {
    { const int r = lane >> 3, c4 = (lane & 7) * 4;
#pragma unroll
      for (int i = 0; i < 8; ++i) { LAS float* d = scr + (8 * i + r) * 33 + c4; d[0] = v[i][0]; d[1] = v[i][1]; d[2] = v[i][2]; d[3] = v[i][3]; } }
    LDS_WAIT(); asm volatile("" ::: "memory");
    const int c = lane & 7;
#pragma unroll
    for (int j = 0; j < 4; ++j) { const int n = (lane >> 3) + 8 * j; const LAS float* s = scr + (8 * c) * 33 + n;
        u32x4 o; o.x = pk2(s[0 * 33], s[1 * 33]); o.y = pk2(s[2 * 33], s[3 * 33]); o.z = pk2(s[4 * 33], s[5 * 33]); o.w = pk2(s[6 * 33], s[7 * 33]);
        *(GAS u32x4*)(I.WT + (size_t)(I.dst_row0 + n) * I.Ksrc + I.k0 + 8 * c) = o; }
    LDS_WAIT(); asm volatile("" ::: "memory");
}
__host__ __device__ __forceinline__ int map_in(int n) { return n < 512 ? 256 * (n >> 7) + (n & 127) : (n < 1024 ? 256 * ((n - 512) >> 7) + 128 + ((n - 512) & 127) : n); }

__device__ __forceinline__ void p0_convert(Frame& F, int gw, int NGW, int which) {
    LAS float* scr = (LAS float*)(F.lds + RING_OFF + F.wave * 16384);
    constexpr int I_IN = 16 * 56, I_OUT = 16 * 32, I_G = 16 * 8, I_D = 4 * 32, I_E = 2 * I_G + I_D;
    const int NITEMS = which == 0 ? I_IN + I_OUT : NE * I_E;
    bf16_t* WI = (bf16_t*)(F.ws + WS_WI); bf16_t* WO = (bf16_t*)(F.ws + WS_WO); bf16_t* WGU = (bf16_t*)(F.ws + WS_WGU); bf16_t* WD = (bf16_t*)(F.ws + WS_WD);
    auto decode = [&](int it, P0Item& I) {
        int r = it;
        if (which == 0) {
            if (r < I_IN) { const int kb = r / 56, nb = r % 56; I.W = F.in[4]; I.Ksrc = DM; I.N = DIN; I.WT = WI; I.dst_row0 = map_in(32 * nb); I.k0 = 64 * kb; I.n0 = 32 * nb; return; } r -= I_IN;
            { const int kb = r / 32, nb = r % 32; I.W = F.in[13]; I.Ksrc = DM; I.N = DM; I.WT = WO; I.dst_row0 = 32 * nb; I.k0 = 64 * kb; I.n0 = 32 * nb; return; }
        }
        const int e = r / I_E; r -= e * I_E;
        if (r < I_G) { const int kb = r / 8, nb = r % 8, n0 = 32 * nb; I.W = F.in[21] + (size_t)e * DM * DE; I.Ksrc = DM; I.N = DE; I.WT = WGU + (size_t)e * 512 * DM; I.dst_row0 = 256 * (n0 >> 7) + (n0 & 127); I.k0 = 64 * kb; I.n0 = n0; return; } r -= I_G;
        if (r < I_G) { const int kb = r / 8, nb = r % 8, n0 = 32 * nb; I.W = F.in[22] + (size_t)e * DM * DE; I.Ksrc = DM; I.N = DE; I.WT = WGU + (size_t)e * 512 * DM; I.dst_row0 = 256 * (n0 >> 7) + 128 + (n0 & 127); I.k0 = 64 * kb; I.n0 = n0; return; } r -= I_G;
        { const int kb = r / 32, nb = r % 32; I.W = F.in[23] + (size_t)e * DE * DM; I.Ksrc = DE; I.N = DM; I.WT = WD + (size_t)e * DM * DE; I.dst_row0 = 32 * nb; I.k0 = 64 * kb; I.n0 = 32 * nb; }
    };
    int it = gw;
    if (it < NITEMS) {
        P0Item cur; f32x4 vc[8]; decode(it, cur); p0_item_load(cur, vc, F.lane);
        for (;;) {
            const int itn = it + NGW; const bool has = itn < NITEMS;
            P0Item nx = cur; f32x4 vn[8];
            if (has) { decode(itn, nx); p0_item_load(nx, vn, F.lane); }
            p0_item_store(cur, vc, scr, F.lane);
            if (!has) break;
            cur = nx; it = itn;
#pragma unroll
            for (int i = 0; i < 8; ++i) vc[i] = vn[i];
        }
    }
}
__device__ __forceinline__ void p0_prologue(Frame& F) {
    const float* c = F.in[1]; const float* w_ada = F.in[2]; const float* b_ada = F.in[3];
    {
        LAS float* cact = (LAS float*)(F.lds + RING_OFF);
        LAS float* red = (LAS float*)(F.lds + RING_OFF + 32768);
        for (int i = F.tid; i < NBATCH * DM; i += 512) { const float v = c[i]; cact[i] = v / (1.f + __expf(-v)); }
        __syncthreads();
        float* mod = (float*)(F.ws + WS_MOD);
        for (int cg = blockIdx.x; cg < 256; cg += F.G) {
            const int j0 = cg * 24, ks = F.tid >> 5, jj = F.tid & 31;
            float a[8] = {0.f, 0.f, 0.f, 0.f, 0.f, 0.f, 0.f, 0.f};
            if (jj < 24) {
#pragma unroll 32
                for (int k = ks * 64; k < ks * 64 + 64; ++k) { const float w = w_ada[(size_t)k * 6 * DM + j0 + jj];
#pragma unroll
                    for (int b = 0; b < 8; ++b) a[b] += cact[b * DM + k] * w; }
            }
#pragma unroll
            for (int b = 0; b < 8; ++b) red[(ks * 8 + b) * 32 + jj] = a[b];
            __syncthreads();
            if (F.tid < 8 * 24) { const int b = F.tid / 24, j = F.tid % 24; float s = 0.f;
                for (int q = 0; q < 16; ++q) s += red[(q * 8 + b) * 32 + j];
                mod[b * 6 * DM + j0 + j] = s + b_ada[j0 + j]; }
            __syncthreads();
        }
    }
    sub_stamp(F, 10);
    {
        const int gt = blockIdx.x * 512 + F.tid, NT = F.G * 512;
        float* bperm = (float*)(F.ws + WS_BPERM); const float* b_in = F.in[5];
        for (int n = gt; n < DIN; n += NT) bperm[map_in(n)] = b_in[n];
        bf16_t* wr_hi = (bf16_t*)(F.ws + WS_WR); bf16_t* wr_lo = wr_hi + 48 * DM;
        const float* wrg = F.in[17]; const float* wre = F.in[19];
        for (int i = gt; i < 48 * DM; i += NT) { const int j = i / DM, k = i % DM; float v = 0.f;
            if (j < 4) v = wrg[k * NG + j]; else if (j < 36) v = wre[k * NE + (j - 4)];
            const unsigned h = f2bf(v); const float r = v - bf2f((unsigned short)h); wr_hi[i] = (bf16_t)h; wr_lo[i] = (bf16_t)f2bf(r); }
    }
    sub_stamp(F, 11);
    p0_convert(F, F.vcu * NWAVES + F.wave, F.G * NWAVES, 0);
}

__device__ __forceinline__ void p1_modulate(Frame& F) {
    const float* x = F.in[0]; const float* mod = (const float*)(F.ws + WS_MOD); bf16_t* H = (bf16_t*)(F.ws + WS_H);
    const int cv = F.tid & 127, rsub = F.tid >> 7, col = cv * 8;
    for (int r0 = blockIdx.x * 16; r0 < T; r0 += F.G * 16) {
        const int b = r0 / SEQ; const float* mb = mod + b * 6 * DM;
        const f32x4 s0 = *(const f32x4*)(mb + DM + col) + 1.f, s1 = *(const f32x4*)(mb + DM + col + 4) + 1.f, h0 = *(const f32x4*)(mb + col), h1 = *(const f32x4*)(mb + col + 4);
        f32x4 xa[4], xb[4];
#pragma unroll
        for (int i = 0; i < 4; ++i) { const size_t e0 = (size_t)(r0 + rsub + 4 * i) * DM + col; xa[i] = *(const f32x4*)(x + e0); xb[i] = *(const f32x4*)(x + e0 + 4); }
#pragma unroll
        for (int i = 0; i < 4; ++i) { const size_t e0 = (size_t)(r0 + rsub + 4 * i) * DM + col; const f32x4 y0 = xa[i] * s0 + h0, y1 = xb[i] * s1 + h1;
            u32x4 o; o.x = pk2(y0[0], y0[1]); o.y = pk2(y0[2], y0[3]); o.z = pk2(y1[0], y1[1]); o.w = pk2(y1[2], y1[3]);
            *(u32x4*)(H + e0) = o; }
    }
}

struct InProj {
    static constexpr bool PERM = true;
    int K, G, c; const bf16_t* A; const bf16_t* Bt; const float* bias; bf16_t* VG; bf16_t* Q; bf16_t* KV;
    __device__ __forceinline__ bool next(int i, pg8::Unit& u) const { u.e = 0; return pg8::static_next(i, G, c, T / 256, DIN / 256, u.pm, u.pn); }
    __device__ __forceinline__ const char* a_base(const pg8::Unit& u) const { return (const char*)A + (size_t)u.pm * 256 * K * 2; }
    __device__ __forceinline__ const char* b_base(const pg8::Unit& u) const { return (const char*)Bt + (size_t)u.pn * 256 * K * 2; }
    __device__ __forceinline__ void a_voff(const pg8::Unit&, const int (&R)[2], const int (&C)[2], unsigned (&v)[2][2]) const {
#pragma unroll
        for (int i = 0; i < 2; ++i) { v[0][i] = (unsigned)(R[i] * K + C[i]) * 2u; v[1][i] = v[0][i] + (unsigned)(128 * K * 2); } }
    __device__ __forceinline__ void epi(const f32x4 (&acc)[2][2][4][2], const pg8::Unit& u, int wr, int wc, int fr, int fq) const {
        const int row0 = u.pm * 256 + wr * 64 + fr; const int bcol0 = u.pn * 256 + wc * 32 + 8 * fq;
        f32x4 bv[2][2];
#pragma unroll
        for (int bj = 0; bj < 2; ++bj)
#pragma unroll
            for (int n = 0; n < 2; ++n) bv[bj][n] = *(const f32x4*)(bias + bcol0 + bj * 128 + 4 * n);
        if (u.pn < 4) {
            bf16_t* base = VG + u.pn * 128 + wc * 32 + 8 * fq;
#pragma unroll
            for (int ai = 0; ai < 2; ++ai)
#pragma unroll
                for (int m = 0; m < 4; ++m) { bf16_t* rowp = base + (size_t)(row0 + ai * 128 + m * 16) * DCONV;
                    f32x4 a0 = acc[ai][0][m][0] + bv[0][0], a1 = acc[ai][0][m][1] + bv[0][1], g0 = acc[ai][1][m][0] + bv[1][0], g1 = acc[ai][1][m][1] + bv[1][1];
#pragma unroll
                    for (int j = 0; j < 4; ++j) { a0[j] *= fast_sigmoid(g0[j]); a1[j] *= fast_sigmoid(g1[j]); }
                    u32x4 w; w.x = cvt_pk_bf16(a0[0], a0[1]); w.y = cvt_pk_bf16(a0[2], a0[3]); w.z = cvt_pk_bf16(a1[0], a1[1]); w.w = cvt_pk_bf16(a1[2], a1[3]);
                    *(u32x4*)rowp = w; }
        } else {
            const bool isq = u.pn < 6; const float sc = isq ? QSCALE : 1.f; const int ldc = isq ? DATTN : 2 * DKV;
            bf16_t* base = (isq ? Q + (u.pn - 4) * 256 : KV) + wc * 32 + 8 * fq;
#pragma unroll
            for (int ai = 0; ai < 2; ++ai)
#pragma unroll
                for (int m = 0; m < 4; ++m) { bf16_t* rowp = base + (size_t)(row0 + ai * 128 + m * 16) * ldc;
#pragma unroll
                    for (int bj = 0; bj < 2; ++bj) { const f32x4 v0 = (acc[ai][bj][m][0] + bv[bj][0]) * sc, v1 = (acc[ai][bj][m][1] + bv[bj][1]) * sc;
                        u32x4 w; w.x = cvt_pk_bf16(v0[0], v0[1]); w.y = cvt_pk_bf16(v0[2], v0[3]); w.z = cvt_pk_bf16(v1[0], v1[1]); w.w = cvt_pk_bf16(v1[2], v1[3]);
                        *(u32x4*)(rowp + bj * 128) = w; } }
        }
    }
};


template <int R> __device__ __forceinline__ void conv_rows(float (&acc)[32], const float (&w)[31], const float (&vin)[62]) {
    if constexpr (R < 62) {
#pragma unroll
        for (int j = 0; j < 31; ++j) { const int o = R - j; if (o >= 0 && o < 32) acc[o] += w[j] * vin[R]; }
        conv_rows<R + 1>(acc, w, vin);
    }
}
__device__ __forceinline__ void conv_load(const bf16_t* VG, int t0, int c, float (&vin)[62]) {
    const int s0 = t0 % SEQ, tb = t0 - s0;
#pragma unroll
    for (int r = 0; r < 62; ++r) { const int ss = s0 - 30 + r; const int tr = tb + (ss < 0 ? 0 : ss); const float v = bf2f(VG[(size_t)tr * DCONV + c]); vin[r] = ss < 0 ? 0.f : v; }
}
__device__ __forceinline__ void p3_conv_all(Frame& F) {
    const bf16_t* VG = (const bf16_t*)(F.ws + WS_VG);
    const float* conv_w = F.in[6]; const float* conv_b = F.in[7]; const float* lng = F.in[8]; const float* lnb = F.in[9]; const float* outg = F.in[10];
    bf16_t* Y = (bf16_t*)(F.ws + WS_H);
    LAS float* tile = (LAS float*)(F.lds + RING_OFF);
    const int c = F.tid; const int NU = T / 32;
    int u = blockIdx.x; if (u >= NU) return;
    float w[31];
#pragma unroll
    for (int j = 0; j < 31; ++j) w[j] = conv_w[j * DCONV + c];
    const float cb = conv_b[c];
    float vin[62]; conv_load(VG, 32 * u, c, vin);
    for (;;) {
        const int t0 = 32 * u; const int un = u + F.G; const bool has = un < NU;
        float vnx[62];
        if (has) conv_load(VG, 32 * un, c, vnx);
        float acc[32];
#pragma unroll
        for (int o = 0; o < 32; ++o) acc[o] = cb;
        conv_rows<0>(acc, w, vin);
#pragma unroll
        for (int o = 0; o < 32; ++o) tile[o * 516 + c] = acc[o];
        __syncthreads();
        {
            const int c8 = F.lane * 8;
            const f32x4 g0 = *(const f32x4*)(lng + c8), g1 = *(const f32x4*)(lng + c8 + 4), b0 = *(const f32x4*)(lnb + c8), b1 = *(const f32x4*)(lnb + c8 + 4), og0 = *(const f32x4*)(outg + c8), og1 = *(const f32x4*)(outg + c8 + 4);
#pragma unroll
            for (int i = 0; i < 4; ++i) { const int o = F.wave * 4 + i;
                f32x4 v0 = *(const LAS f32x4*)(tile + o * 516 + c8), v1 = *(const LAS f32x4*)(tile + o * 516 + c8 + 4);
                const float mean = wave_sum((v0[0] + v0[1]) + (v0[2] + v0[3]) + (v1[0] + v1[1]) + (v1[2] + v1[3])) * (1.f / DCONV);
                v0 = v0 - mean; v1 = v1 - mean;
                const float var = wave_sum((v0[0] * v0[0] + v0[1] * v0[1]) + (v0[2] * v0[2] + v0[3] * v0[3]) + (v1[0] * v1[0] + v1[1] * v1[1]) + (v1[2] * v1[2] + v1[3] * v1[3])) * (1.f / DCONV);
                const float rstd = rsqrtf(var + EPS);
                v0 = v0 * rstd * g0 + b0; v1 = v1 * rstd * g1 + b1;
                float q = 0.f;
#pragma unroll
                for (int j = 0; j < 4; ++j) { v0[j] = fast_silu(v0[j]); v1[j] = fast_silu(v1[j]); q += v0[j] * v0[j] + v1[j] * v1[j]; }
                q = group8_sum(q);
                const float r2 = rsqrtf(q * (1.f / 64.f) + EPS);
                v0 = v0 * r2 * og0; v1 = v1 * r2 * og1;
                u32x4 ow; ow.x = pk2(v0[0], v0[1]); ow.y = pk2(v0[2], v0[3]); ow.z = pk2(v1[0], v1[1]); ow.w = pk2(v1[2], v1[3]);
                *(u32x4*)(Y + (size_t)(t0 + o) * DM + c8) = ow; }
        }
        __syncthreads();
        if (!has) break;
        u = un;
#pragma unroll
        for (int r = 0; r < 62; ++r) vin[r] = vnx[r];
    }
}

namespace att {
constexpr int KCH = 4112;
constexpr int L_K = 0, L_V = 8 * KCH, L_O = L_V + 32768, OST = 8704, L_WS = L_O + 8 * OST, L_END = L_WS + 8 * 128;
static_assert(L_END <= RING_BYTES, "attention LDS");
typedef short s16x4 __attribute__((ext_vector_type(4)));
typedef float f32x16 __attribute__((ext_vector_type(16)));
typedef short v4i16_t __attribute__((ext_vector_type(4)));
__device__ __forceinline__ int crow(int r, int hi) { return (r & 3) + 8 * (r >> 2) + 4 * hi; }
__device__ __forceinline__ s16x4 vtr(const LAS unsigned char* p) { return __builtin_bit_cast(s16x4, __builtin_amdgcn_ds_read_tr16_b64_v4i16((LAS v4i16_t*)p)); }

__device__ __forceinline__ void attn_unit(Frame& F, int b, int kvh, int blk) {
    const bf16_t* Q = (const bf16_t*)(F.ws + WS_Q); const bf16_t* KV = (const bf16_t*)(F.ws + WS_KV); bf16_t* Y = (bf16_t*)(F.ws + WS_H);
    const float* sinks = F.in[11]; const float* outg = F.in[12];
    LAS unsigned char* lds = F.lds + RING_OFF;
    const int lane = F.lane, r32 = lane & 31, hi = lane >> 5, wave = F.wave;
    const int t0 = b * SEQ + blk * 128;
    bf16x8 qrr[2][4];
#pragma unroll
    for (int wi = 0; wi < 2; ++wi) { const int wu = wave + 8 * wi, hq = wu >> 2, sub = wu & 3;
        const bf16_t* qrow = Q + (size_t)(t0 + 32 * sub + r32) * DATTN + (kvh * 4 + hq) * 64 + hi * 8;
#pragma unroll
        for (int s = 0; s < 4; ++s) qrr[wi][s] = *(const bf16x8*)(qrow + 16 * s); }
    {
        u32x4 kq[4], vq[4];
#pragma unroll
        for (int i = 0; i < 4; ++i) { const int p = F.tid + 512 * i, key = p >> 3, ch = p & 7; const bool valid = (blk > 0) || key >= 128;
            const int tk = valid ? t0 - 128 + key : t0;
            const bf16_t* gk = KV + (size_t)tk * 256 + kvh * 64 + ch * 8;
            kq[i] = *(const u32x4*)gk; vq[i] = *(const u32x4*)(gk + 128);
            if (!valid) { kq[i] = (u32x4){0u, 0u, 0u, 0u}; vq[i] = kq[i]; } }
#pragma unroll
        for (int i = 0; i < 4; ++i) { const int p = F.tid + 512 * i, key = p >> 3, ch = p & 7;
            *(LAS u32x4*)(lds + L_K + ch * KCH + key * 16) = kq[i];
            *(LAS u32x4*)(lds + L_V + (key >> 6) * 8192 + ((ch >> 2) * 4 + ((key & 63) >> 4)) * 1024 + (key & 15) * 64 + (ch & 3) * 16) = vq[i]; }
    }
    __syncthreads();
    const int vlane = (4 * hi + ((lane & 15) >> 2)) * 64 + ((lane >> 4) & 1) * 32 + (lane & 3) * 8;
#pragma unroll
    for (int wi = 0; wi < 2; ++wi) {
        const int wu = wave + 8 * wi, hq = wu >> 2, sub = wu & 3, i0 = 32 * sub, h = kvh * 4 + hq;
        bf16x8 qr[4];
#pragma unroll
        for (int s = 0; s < 4; ++s) qr[s] = qrr[wi][s];
        f32x16 st[5];
#pragma unroll
        for (int t = 0; t < 5; ++t) {
#pragma unroll
            for (int r = 0; r < 16; ++r) st[t][r] = 0.f;
#pragma unroll
            for (int s = 0; s < 4; ++s) { const bf16x8 kf = *(const LAS bf16x8*)(lds + L_K + (2 * s + hi) * KCH + (i0 + 32 * t + r32) * 16);
                st[t] = __builtin_amdgcn_mfma_f32_32x32x16_bf16(kf, qr[s], st[t], 0, 0, 0); } }
        const float sinkl = sinks[h] * LOG2E;
        float m = sinkl;
#pragma unroll
        for (int t = 0; t < 5; ++t)
#pragma unroll
            for (int r = 0; r < 16; ++r) { const int cj = crow(r, hi); bool ok = true;
                if (t == 0) ok = cj >= r32 + 1; if (t == 4) ok = cj <= r32;
                if (blk == 0) ok = ok && (i0 + 32 * t + cj >= 128);
                const float v = ok ? st[t][r] : -1e30f; st[t][r] = v; m = fmaxf(m, v); }
        m = fmaxf(m, __shfl_xor(m, 32));
        float l = 0.f;
#pragma unroll
        for (int t = 0; t < 5; ++t)
#pragma unroll
            for (int r = 0; r < 16; ++r) { const float pv = __builtin_amdgcn_exp2f(st[t][r] - m); st[t][r] = pv; l += pv; }
        l += __shfl_xor(l, 32); l += __builtin_amdgcn_exp2f(sinkl - m);
        f32x16 o[2];
#pragma unroll
        for (int r = 0; r < 16; ++r) { o[0][r] = 0.f; o[1][r] = 0.f; }
#pragma unroll
        for (int t = 0; t < 5; ++t)
#pragma unroll
            for (int s2 = 0; s2 < 2; ++s2) {
                u32x4 pw; pw.x = cvt_pk_bf16(st[t][8 * s2 + 0], st[t][8 * s2 + 1]); pw.y = cvt_pk_bf16(st[t][8 * s2 + 2], st[t][8 * s2 + 3]); pw.z = cvt_pk_bf16(st[t][8 * s2 + 4], st[t][8 * s2 + 5]); pw.w = cvt_pk_bf16(st[t][8 * s2 + 6], st[t][8 * s2 + 7]);
                const bf16x8 pa = __builtin_bit_cast(bf16x8, pw);
                const int kk0 = i0 + 32 * t + 16 * s2, g = kk0 >> 6, pc = (kk0 & 63) >> 4;
#pragma unroll
                for (int d0 = 0; d0 < 2; ++d0) { const LAS unsigned char* vb = lds + L_V + g * 8192 + (d0 * 4 + pc) * 1024 + vlane;
                    const s16x4 lo = vtr(vb), hh = vtr(vb + 512);
                    const bf16x8 vf = (bf16x8){lo[0], lo[1], lo[2], lo[3], hh[0], hh[1], hh[2], hh[3]};
                    o[d0] = __builtin_amdgcn_mfma_f32_32x32x16_bf16(pa, vf, o[d0], 0, 0, 0); } }
        LAS float* wsf = (LAS float*)(lds + L_WS + wave * 128);
        LAS float* ost = (LAS float*)(lds + L_O + wave * OST);
        if (hi == 0) wsf[r32] = l;
#pragma unroll
        for (int r = 0; r < 16; ++r) { const int q = crow(r, hi); ost[q * 68 + r32] = o[0][r]; ost[q * 68 + 32 + r32] = o[1][r]; }
        LDS_WAIT(); asm volatile("" ::: "memory");
        { const int q = lane >> 1, half = lane & 1; const float rl = 1.f / wsf[q];
          f32x4 v[8]; float ss = 0.f;
#pragma unroll
          for (int j = 0; j < 8; ++j) { v[j] = *(const LAS f32x4*)(ost + q * 68 + half * 32 + 4 * j) * rl; ss += (v[j][0] * v[j][0] + v[j][1] * v[j][1]) + (v[j][2] * v[j][2] + v[j][3] * v[j][3]); }
          ss += __shfl_xor(ss, 1);
          const float rr = rsqrtf(ss * (1.f / 64.f) + EPS);
          const float* gp = outg + h * 64 + half * 32; bf16_t* yp = Y + (size_t)(t0 + i0 + q) * DM + DCONV + h * 64 + half * 32;
#pragma unroll
          for (int j = 0; j < 4; ++j) { const f32x4 a = v[2 * j] * rr * *(const f32x4*)(gp + 8 * j), c2 = v[2 * j + 1] * rr * *(const f32x4*)(gp + 8 * j + 4);
              u32x4 ow; ow.x = pk2(a[0], a[1]); ow.y = pk2(a[2], a[3]); ow.z = pk2(c2[0], c2[1]); ow.w = pk2(c2[2], c2[3]);
              *(u32x4*)(yp + 8 * j) = ow; } }
        LDS_WAIT(); asm volatile("" ::: "memory");
    }
    __syncthreads();
}
}

__device__ __forceinline__ void p3_attn_only(Frame& F) {
    for (int u = blockIdx.x; u < NBATCH * NKV * (SEQ / 128); u += F.G) { const int blk = u & 31, kvh = (u >> 5) & 1, b = u >> 6; att::attn_unit(F, b, kvh, blk); }
}
__device__ __forceinline__ void p3_conv_only(Frame& F) {
    p3_conv_all(F);
}
__device__ __forceinline__ void p3_mixers(Frame& F) {
#ifndef SKIP_ATTN
    for (int u = blockIdx.x; u < NBATCH * NKV * (SEQ / 128); u += F.G) { const int blk = u & 31, kvh = (u >> 5) & 1, b = u >> 6; att::attn_unit(F, b, kvh, blk); }
#endif
    sub_stamp(F, 13);
#ifndef SKIP_CONV
    p3_conv_all(F);
#endif
    sub_stamp(F, 14);
}

struct OutProj {
    static constexpr bool PERM = true;
    int K, G, c; const bf16_t* A; const bf16_t* Bt; const float* bo; bf16_t* MIX;
    __device__ __forceinline__ bool next(int i, pg8::Unit& u) const { u.e = 0; return pg8::static_next(i, G, c, T / 256, DM / 256, u.pm, u.pn); }
    __device__ __forceinline__ const char* a_base(const pg8::Unit& u) const { return (const char*)A + (size_t)u.pm * 256 * K * 2; }
    __device__ __forceinline__ const char* b_base(const pg8::Unit& u) const { return (const char*)Bt + (size_t)u.pn * 256 * K * 2; }
    __device__ __forceinline__ void a_voff(const pg8::Unit&, const int (&R)[2], const int (&C)[2], unsigned (&v)[2][2]) const {
#pragma unroll
        for (int i = 0; i < 2; ++i) { v[0][i] = (unsigned)(R[i] * K + C[i]) * 2u; v[1][i] = v[0][i] + (unsigned)(128 * K * 2); } }
    __device__ __forceinline__ void epi(const f32x4 (&acc)[2][2][4][2], const pg8::Unit& u, int wr, int wc, int fr, int fq) const {
        const int row0 = u.pm * 256 + wr * 64 + fr; const int col0 = u.pn * 256 + wc * 32 + 8 * fq;
        f32x4 bv[2][2];
#pragma unroll
        for (int bj = 0; bj < 2; ++bj)
#pragma unroll
            for (int n = 0; n < 2; ++n) bv[bj][n] = *(const f32x4*)(bo + col0 + bj * 128 + 4 * n);
#pragma unroll
        for (int ai = 0; ai < 2; ++ai)
#pragma unroll
            for (int m = 0; m < 4; ++m) { bf16_t* rowp = MIX + (size_t)(row0 + ai * 128 + m * 16) * DM + col0;
#pragma unroll
                for (int bj = 0; bj < 2; ++bj) { const f32x4 v0 = acc[ai][bj][m][0] + bv[bj][0], v1 = acc[ai][bj][m][1] + bv[bj][1];
                    u32x4 w; w.x = cvt_pk_bf16(v0[0], v0[1]); w.y = cvt_pk_bf16(v0[2], v0[3]); w.z = cvt_pk_bf16(v1[0], v1[1]); w.w = cvt_pk_bf16(v1[2], v1[3]);
                    *(u32x4*)(rowp + bj * 128) = w; } }
    }
};

constexpr int TAB_OFF = LDSCTL_OFF + 1024;
__device__ __forceinline__ void build_route_table(Frame& F) {
    volatile LAS int* tab = (volatile LAS int*)(F.lds + TAB_OFF);
    if (F.tid == 0) { int tp = 0;
        for (int e = 0; e < NE; ++e) { const int cn = (int)__hip_atomic_load(F.ctl + CW_ECNT + 64 * e, RLX_AGENT); tab[e] = cn; tab[32 + e] = tp; tp += (cn + 255) >> 8; }
        tab[64] = tp; }
    __syncthreads();
}

__device__ __forceinline__ void p5_rows(Frame& F) {
    float* X = F.out; const float* xin = F.in[0]; const bf16_t* MIX = (const bf16_t*)(F.ws + WS_MIX); bf16_t* H2 = (bf16_t*)(F.ws + WS_H2);
    const float* ln_g = F.in[15]; const float* ln_b = F.in[16]; const float* mod = (const float*)(F.ws + WS_MOD);
    const bf16_t* wr_hi = (const bf16_t*)(F.ws + WS_WR); const bf16_t* wr_lo = wr_hi + 48 * DM;
    const float* brg = F.in[18]; const float* bre = F.in[20];
    int* list = (int*)(F.ws + WS_LIST); unsigned* tokrec = (unsigned*)(F.ws + WS_TOK);
    LAS float* lg = (LAS float*)(F.lds + RING_OFF + F.wave * 3072);
    volatile LAS int* lcnt = (volatile LAS int*)(F.lds + RING_OFF + 24576);
    const int lane = F.lane, i16 = lane & 15, kq = lane >> 4;
    for (int tile = blockIdx.x; tile < T / 128; tile += F.G) {
        if (F.tid < 64) lcnt[F.tid] = 0;
        __syncthreads();
        const int rbase = tile * 128 + F.wave * 16; const int b = (tile * 128) / SEQ;
        const float* sc2 = mod + b * 6 * DM + 4 * DM; const float* sh2 = mod + b * 6 * DM + 3 * DM;
        {
            const float* g1 = mod + b * 6 * DM + 2 * DM;
            f32x4 gg[4], lgv[4], lbv[4], scv[4], shv[4];
#pragma unroll
            for (int j = 0; j < 4; ++j) { const int col = 4 * lane + 256 * j; gg[j] = *(const f32x4*)(g1 + col); lgv[j] = *(const f32x4*)(ln_g + col); lbv[j] = *(const f32x4*)(ln_b + col);
                scv[j] = *(const f32x4*)(sc2 + col) + 1.f; shv[j] = *(const f32x4*)(sh2 + col); }
#pragma unroll 1
            for (int rb = 0; rb < 16; rb += 2) {
                f32x4 z[2][4]; u32x2 mv[2][4];
#pragma unroll
                for (int r = 0; r < 2; ++r)
#pragma unroll
                    for (int j = 0; j < 4; ++j) { const size_t o = (size_t)(rbase + rb + r) * DM + 4 * lane + 256 * j; z[r][j] = *(const f32x4*)(xin + o); mv[r][j] = *(const u32x2*)(MIX + o); }
                float sm[2];
#pragma unroll
                for (int r = 0; r < 2; ++r) { sm[r] = 0.f;
#pragma unroll
                    for (int j = 0; j < 4; ++j) { f32x4 m4; m4[0] = __builtin_bit_cast(float, mv[r][j].x << 16); m4[1] = __builtin_bit_cast(float, mv[r][j].x & 0xffff0000u); m4[2] = __builtin_bit_cast(float, mv[r][j].y << 16); m4[3] = __builtin_bit_cast(float, mv[r][j].y & 0xffff0000u);
                        z[r][j] = z[r][j] * ALPHA + gg[j] * m4; sm[r] += (z[r][j][0] + z[r][j][1]) + (z[r][j][2] + z[r][j][3]); } }
#pragma unroll
                for (int r = 0; r < 2; ++r) sm[r] = wave_sum(sm[r]);
                float sq[2];
#pragma unroll
                for (int r = 0; r < 2; ++r) { const float mean = sm[r] * (1.f / DM); sq[r] = 0.f;
#pragma unroll
                    for (int j = 0; j < 4; ++j) { z[r][j] = z[r][j] - mean; sq[r] += (z[r][j][0] * z[r][j][0] + z[r][j][1] * z[r][j][1]) + (z[r][j][2] * z[r][j][2] + z[r][j][3] * z[r][j][3]); } }
#pragma unroll
                for (int r = 0; r < 2; ++r) sq[r] = wave_sum(sq[r]);
#pragma unroll
                for (int r = 0; r < 2; ++r) { const float rstd = rsqrtf(sq[r] * (1.f / DM) + EPS);
#pragma unroll
                    for (int j = 0; j < 4; ++j) { const size_t o = (size_t)(rbase + rb + r) * DM + 4 * lane + 256 * j; const f32x4 x1 = z[r][j] * rstd * lgv[j] + lbv[j];
                        *(f32x4*)(X + o) = x1; const f32x4 t = x1 * scv[j] + shv[j];
                        u32x2 hw; hw.x = pk2(t[0], t[1]); hw.y = pk2(t[2], t[3]); *(u32x2*)(H2 + o) = hw; } }
            }
            asm volatile("s_waitcnt vmcnt(0)" ::: "memory");
        }
        const int row = rbase + i16;
        f32x4 acc[3];
#pragma unroll
        for (int ct = 0; ct < 3; ++ct) acc[ct] = (f32x4){0.f, 0.f, 0.f, 0.f};
        { const bf16_t* hr = H2 + (size_t)row * DM + 8 * kq; const bf16_t* wp = wr_hi + (size_t)i16 * DM + 8 * kq;
#pragma unroll 1
          for (int kc = 0; kc < DM; kc += 128) {
              bf16x8 ah[4], bh[4][3];
#pragma unroll
              for (int u = 0; u < 4; ++u) { ah[u] = *(const bf16x8*)(hr + kc + 32 * u);
#pragma unroll
                  for (int ct = 0; ct < 3; ++ct) bh[u][ct] = *(const bf16x8*)(wp + (size_t)(16 * ct) * DM + kc + 32 * u); }
#pragma unroll
              for (int u = 0; u < 4; ++u)
#pragma unroll
                  for (int ct = 0; ct < 3; ++ct) acc[ct] = __builtin_amdgcn_mfma_f32_16x16x32_bf16(ah[u], bh[u][ct], acc[ct], 0, 0, 0);
          } }
#pragma unroll
        for (int ct = 0; ct < 3; ++ct)
#pragma unroll
            for (int r = 0; r < 4; ++r) lg[(4 * kq + r) * 48 + 16 * ct + i16] = acc[ct][r];
        LDS_WAIT(); asm volatile("" ::: "memory");
        int e1 = 0, e2 = 0, rk1 = 0, rk2 = 0; float w1 = 0.f, w2 = 0.f;
        if (lane < 16) {
            const LAS float* L = lg + lane * 48;
            float gl[4];
#pragma unroll
            for (int j = 0; j < 4; ++j) gl[j] = L[j] + brg[j];
            int gi = 0; float gm = gl[0];
#pragma unroll
            for (int j = 1; j < 4; ++j) if (gl[j] > gm) { gm = gl[j]; gi = j; }
            float gs = 0.f;
#pragma unroll
            for (int j = 0; j < 4; ++j) gs += __expf(gl[j] - gm);
            const float ptop = 1.f / gs;
            float el[8];
#pragma unroll
            for (int j = 0; j < 8; ++j) el[j] = L[4 + gi * 8 + j] + bre[gi * 8 + j];
            int i1 = 0; float m1 = el[0];
#pragma unroll
            for (int j = 1; j < 8; ++j) if (el[j] > m1) { m1 = el[j]; i1 = j; }
            int i2 = -1; float m2 = -3e38f;
#pragma unroll
            for (int j = 0; j < 8; ++j) if (j != i1 && el[j] > m2) { m2 = el[j]; i2 = j; }
            const float pb = __expf(m2 - m1), inv = ptop / (1.f + pb);
            e1 = gi * 8 + i1; e2 = gi * 8 + i2; w1 = inv; w2 = pb * inv;
            rk1 = __hip_atomic_fetch_add((LAS int*)lcnt + e1, 1, __ATOMIC_RELAXED, __HIP_MEMORY_SCOPE_WORKGROUP);
            rk2 = __hip_atomic_fetch_add((LAS int*)lcnt + e2, 1, __ATOMIC_RELAXED, __HIP_MEMORY_SCOPE_WORKGROUP);
        }
        __syncthreads();
        if (F.tid < 32) { const int n = lcnt[F.tid]; int base = 0; if (n > 0) base = (int)__hip_atomic_fetch_add(F.ctl + CW_ECNT + 64 * F.tid, (unsigned)n, RLX_AGENT); lcnt[32 + F.tid] = base; }
        __syncthreads();
        if (lane < 16) { const int tok = tile * 128 + F.wave * 16 + lane; const int s1 = lcnt[32 + e1] + rk1, s2 = lcnt[32 + e2] + rk2;
            list[(size_t)e1 * T + s1] = tok; list[(size_t)e2 * T + s2] = tok;
            u32x4 r0; r0.x = (unsigned)e1; r0.y = (unsigned)s1; r0.z = (unsigned)e2; r0.w = (unsigned)s2;
            u32x4 r1; r1.x = __builtin_bit_cast(unsigned, w1); r1.y = __builtin_bit_cast(unsigned, w2); r1.z = 0u; r1.w = 0u;
            *(u32x4*)(tokrec + (size_t)tok * 8) = r0; *(u32x4*)(tokrec + (size_t)tok * 8 + 4) = r1; }
        __syncthreads();
    }
}

__device__ __forceinline__ bool moe_next(const volatile LAS int* tab, int i, int G, int c, int NT, pg8::Unit& u) {
    const int nwg = tab[64] * NT; const long L = (long)i * G + c; if (L >= nwg) return false;
    int wgid = (int)L; { const int q = nwg / 8, r = nwg % 8, xcd = wgid % 8, off = wgid / 8; wgid = (xcd < r ? xcd * (q + 1) : r * (q + 1) + (xcd - r) * q) + off; }
    const int mtg = wgid / NT; int e = 0;
    for (int k = 1; k < NE; ++k) e += (tab[32 + k] <= mtg) ? 1 : 0;
    u.e = __builtin_amdgcn_readfirstlane(e); u.pm = __builtin_amdgcn_readfirstlane(mtg - tab[32 + e]); u.pn = __builtin_amdgcn_readfirstlane(wgid % NT); return true;
}
struct MoeUp {
    static constexpr bool PERM = true;
    int K, G, c; const volatile LAS int* tab; const bf16_t* H2; const bf16_t* WGU; const int* list; bf16_t* ACT;
    __device__ __forceinline__ bool next(int i, pg8::Unit& u) const { return moe_next(tab, i, G, c, 2, u); }
    __device__ __forceinline__ const char* a_base(const pg8::Unit&) const { return (const char*)H2; }
    __device__ __forceinline__ const char* b_base(const pg8::Unit& u) const { return (const char*)WGU + ((size_t)u.e * 512 + u.pn * 256) * K * 2; }
    __device__ __forceinline__ void a_voff(const pg8::Unit& u, const int (&R)[2], const int (&C)[2], unsigned (&v)[2][2]) const {
        const int cn = tab[u.e]; const int* lp = list + (size_t)u.e * T;
#pragma unroll
        for (int h = 0; h < 2; ++h)
#pragma unroll
            for (int i = 0; i < 2; ++i) { const int idx = u.pm * 256 + h * 128 + R[i]; const int tok = lp[idx < cn ? idx : 0]; v[h][i] = (unsigned)(tok * K + C[i]) * 2u; } }
    __device__ __forceinline__ void epi(const f32x4 (&acc)[2][2][4][2], const pg8::Unit& u, int wr, int wc, int fr, int fq) const {
        const int row0 = tab[32 + u.e] * 256 + u.pm * 256 + wr * 64 + fr;
        bf16_t* base = ACT + u.pn * 128 + wc * 32 + 8 * fq;
#pragma unroll
        for (int ai = 0; ai < 2; ++ai)
#pragma unroll
            for (int m = 0; m < 4; ++m) { bf16_t* rowp = base + (size_t)(row0 + ai * 128 + m * 16) * DE;
                f32x4 g0 = acc[ai][0][m][0], g1 = acc[ai][0][m][1]; const f32x4 u0 = acc[ai][1][m][0], u1 = acc[ai][1][m][1];
#pragma unroll
                for (int j = 0; j < 4; ++j) { g0[j] = fast_silu(g0[j]) * u0[j]; g1[j] = fast_silu(g1[j]) * u1[j]; }
                u32x4 w; w.x = cvt_pk_bf16(g0[0], g0[1]); w.y = cvt_pk_bf16(g0[2], g0[3]); w.z = cvt_pk_bf16(g1[0], g1[1]); w.w = cvt_pk_bf16(g1[2], g1[3]);
                *(u32x4*)rowp = w; }
    }
};
struct MoeDown {
    static constexpr bool PERM = true;
    int K, G, c; const volatile LAS int* tab; const bf16_t* ACT; const bf16_t* WD; bf16_t* YS;
    __device__ __forceinline__ bool next(int i, pg8::Unit& u) const { return moe_next(tab, i, G, c, 4, u); }
    __device__ __forceinline__ const char* a_base(const pg8::Unit& u) const { return (const char*)ACT + ((size_t)tab[32 + u.e] * 256 + u.pm * 256) * K * 2; }
    __device__ __forceinline__ const char* b_base(const pg8::Unit& u) const { return (const char*)WD + ((size_t)u.e * DM + u.pn * 256) * K * 2; }
    __device__ __forceinline__ void a_voff(const pg8::Unit&, const int (&R)[2], const int (&C)[2], unsigned (&v)[2][2]) const {
#pragma unroll
        for (int i = 0; i < 2; ++i) { v[0][i] = (unsigned)(R[i] * K + C[i]) * 2u; v[1][i] = v[0][i] + (unsigned)(128 * K * 2); } }
    __device__ __forceinline__ void epi(const f32x4 (&acc)[2][2][4][2], const pg8::Unit& u, int wr, int wc, int fr, int fq) const {
        const int row0 = tab[32 + u.e] * 256 + u.pm * 256 + wr * 64 + fr;
        bf16_t* base = YS + u.pn * 256 + wc * 32 + 8 * fq;
#pragma unroll
        for (int ai = 0; ai < 2; ++ai)
#pragma unroll
            for (int m = 0; m < 4; ++m) { bf16_t* rowp = base + (size_t)(row0 + ai * 128 + m * 16) * DM;
#pragma unroll
                for (int bj = 0; bj < 2; ++bj) { const f32x4 v0 = acc[ai][bj][m][0], v1 = acc[ai][bj][m][1];
                    u32x4 w; w.x = cvt_pk_bf16(v0[0], v0[1]); w.y = cvt_pk_bf16(v0[2], v0[3]); w.z = cvt_pk_bf16(v1[0], v1[1]); w.w = cvt_pk_bf16(v1[2], v1[3]);
                    *(u32x4*)(rowp + bj * 128) = w; } }
    }
};

__device__ __forceinline__ void p8_final(Frame& F) {
    float* X = F.out; const bf16_t* YS = (const bf16_t*)(F.ws + WS_YS); const unsigned* tokrec = (const unsigned*)(F.ws + WS_TOK);
    const float* mod = (const float*)(F.ws + WS_MOD); const float* lg = F.in[24]; const float* lb = F.in[25];
    volatile LAS int* tab = (volatile LAS int*)(F.lds + TAB_OFF);
    const int lane = F.lane; const int gw = blockIdx.x * NWAVES + F.wave, NGW = F.G * NWAVES;
    f32x4 lgv[4], lbv[4];
#pragma unroll
    for (int j = 0; j < 4; ++j) { const int col = 4 * lane + 256 * j; lgv[j] = *(const f32x4*)(lg + col); lbv[j] = *(const f32x4*)(lb + col); }
#pragma unroll 1
    for (int base = gw; base < T; base += 2 * NGW) {
        int tr[2]; bool ok[2]; u32x4 r0[2]; u32x2 r1[2];
#pragma unroll
        for (int r = 0; r < 2; ++r) { const int t = base + r * NGW; ok[r] = t < T; tr[r] = ok[r] ? t : base; r0[r] = *(const u32x4*)(tokrec + (size_t)tr[r] * 8); r1[r] = *(const u32x2*)(tokrec + (size_t)tr[r] * 8 + 4); }
        f32x4 z[2][4]; u32x2 ya[2][4], yb[2][4]; float w1[2], w2[2]; f32x4 gv[2][4];
#pragma unroll
        for (int r = 0; r < 2; ++r) {
            const int e1 = __builtin_amdgcn_readfirstlane((int)r0[r].x), s1 = __builtin_amdgcn_readfirstlane((int)r0[r].y), e2 = __builtin_amdgcn_readfirstlane((int)r0[r].z), s2 = __builtin_amdgcn_readfirstlane((int)r0[r].w);
            w1[r] = __builtin_bit_cast(float, __builtin_amdgcn_readfirstlane(r1[r].x)); w2[r] = __builtin_bit_cast(float, __builtin_amdgcn_readfirstlane(r1[r].y));
            const size_t ra = (size_t)(tab[32 + e1] * 256 + s1), rb = (size_t)(tab[32 + e2] * 256 + s2);
            const float* g2 = mod + (tr[r] / SEQ) * 6 * DM + 5 * DM;
#pragma unroll
            for (int j = 0; j < 4; ++j) { const int col = 4 * lane + 256 * j;
                z[r][j] = *(const f32x4*)(X + (size_t)tr[r] * DM + col); gv[r][j] = *(const f32x4*)(g2 + col);
                ya[r][j] = *(const u32x2*)(YS + ra * DM + col); yb[r][j] = *(const u32x2*)(YS + rb * DM + col); } }
        float sm[2];
#pragma unroll
        for (int r = 0; r < 2; ++r) { sm[r] = 0.f;
#pragma unroll
            for (int j = 0; j < 4; ++j) { f32x4 f;
                f[0] = w1[r] * __builtin_bit_cast(float, ya[r][j].x << 16) + w2[r] * __builtin_bit_cast(float, yb[r][j].x << 16);
                f[1] = w1[r] * __builtin_bit_cast(float, ya[r][j].x & 0xffff0000u) + w2[r] * __builtin_bit_cast(float, yb[r][j].x & 0xffff0000u);
                f[2] = w1[r] * __builtin_bit_cast(float, ya[r][j].y << 16) + w2[r] * __builtin_bit_cast(float, yb[r][j].y << 16);
                f[3] = w1[r] * __builtin_bit_cast(float, ya[r][j].y & 0xffff0000u) + w2[r] * __builtin_bit_cast(float, yb[r][j].y & 0xffff0000u);
                z[r][j] = z[r][j] * ALPHA + gv[r][j] * f; sm[r] += (z[r][j][0] + z[r][j][1]) + (z[r][j][2] + z[r][j][3]); } }
#pragma unroll
        for (int r = 0; r < 2; ++r) sm[r] = wave_sum(sm[r]);
        float sq[2];
#pragma unroll
        for (int r = 0; r < 2; ++r) { const float mean = sm[r] * (1.f / DM); sq[r] = 0.f;
#pragma unroll
            for (int j = 0; j < 4; ++j) { z[r][j] = z[r][j] - mean; sq[r] += (z[r][j][0] * z[r][j][0] + z[r][j][1] * z[r][j][1]) + (z[r][j][2] * z[r][j][2] + z[r][j][3] * z[r][j][3]); } }
#pragma unroll
        for (int r = 0; r < 2; ++r) sq[r] = wave_sum(sq[r]);
#pragma unroll
        for (int r = 0; r < 2; ++r) { const float rstd = rsqrtf(sq[r] * (1.f / DM) + EPS);
            if (ok[r]) {
#pragma unroll
                for (int j = 0; j < 4; ++j) { const int col = 4 * lane + 256 * j; *(f32x4*)(X + (size_t)tr[r] * DM + col) = z[r][j] * rstd * lgv[j] + lbv[j]; } } }
    }
}

__global__ void __launch_bounds__(NWAVES * 64, 2) mega_fwd(Args args) {
    extern __shared__ __attribute__((aligned(16))) unsigned char lds[];
    Frame F;
    F.lds = (LAS unsigned char*)lds;
    F.MISC = (volatile LAS unsigned*)(F.lds + MISC_OFF);
    F.tid = threadIdx.x; F.lane = F.tid & 63; F.wave = __builtin_amdgcn_readfirstlane(F.tid >> 6);
    F.G = gridDim.x; { const int bx = blockIdx.x; F.vcu = (F.G % 8 == 0) ? (bx % 8) * (F.G / 8) + bx / 8 : bx; }
    F.ws = args.ws; F.out = args.out; F.ctl = (gu32*)(args.ws + WS_CTL);
#pragma unroll
    for (int i = 0; i < 26; ++i) F.in[i] = args.in[i];
    for (int u = F.tid; u < (LDS_BYTES - LDSCTL_OFF) / 4; u += NWAVES * 64) ((LAS unsigned*)(F.lds + LDSCTL_OFF))[u] = 0u;
    __syncthreads();
    XcdBarrier bar = xcd_barrier_post((unsigned*)(F.ctl + CW_BAR), F.MISC + 8);
    volatile LAS unsigned* TS = (volatile LAS unsigned*)(F.lds + LDSCTL_OFF + 2048);
#define STAMP(k) do { if (DIAG && blockIdx.x == 0 && F.tid == 0) TS[k] = (unsigned)__builtin_amdgcn_s_memrealtime(); } while (0)
    STAMP(0);
    const int lo = args.ph_lo, hi = args.ph_hi;
#define IN(k) (lo <= (k) && (k) < hi)
#define BOTH(k) (IN(k) && IN((k) + 1))
    if (IN(0)) { p0_prologue(F); sub_stamp(F, 12); if (DUP_PHASE == 0) { xcd_barrier(bar); p0_prologue(F); } if (BOTH(0)) xcd_barrier(bar); STAMP(1); }
    if (IN(1)) { p1_modulate(F); if (DUP_PHASE == 1) { xcd_barrier(bar); p1_modulate(F); } if (BOTH(1)) xcd_barrier(bar); STAMP(2); }
    if (IN(2)) {
        InProj S; S.K = DM; S.G = F.G; S.c = (int)blockIdx.x; S.A = (const bf16_t*)(F.ws + WS_H); S.Bt = (const bf16_t*)(F.ws + WS_WI); S.bias = (const float*)(F.ws + WS_BPERM);
        S.VG = (bf16_t*)(F.ws + WS_VG); S.Q = (bf16_t*)(F.ws + WS_Q); S.KV = (bf16_t*)(F.ws + WS_KV);
        pg8::gemm_phase<InProj>(F.lds + RING_OFF, S);
        if (DUP_PHASE == 2) { xcd_barrier(bar); pg8::gemm_phase<InProj>(F.lds + RING_OFF, S); }
        {
            const int nwg = (T / 256) * (DIN / 256), G = F.G, c = (int)blockIdx.x; const int maxu = (nwg + G - 1) / G; const int full = nwg - (maxu - 1) * G;
            const int nlight = (full == G) ? 0 : G - full;
            if (nlight == 0) p0_convert(F, c * NWAVES + F.wave, G * NWAVES, 1);
            else if (c >= full) p0_convert(F, (c - full) * NWAVES + F.wave, nlight * NWAVES, 1);
        }
        if (BOTH(2)) xcd_barrier(bar); STAMP(3);
    }
    if (IN(3)) { p3_mixers(F); if (DUP_PHASE == 3) { xcd_barrier(bar); p3_mixers(F); } if (DUP_PHASE == 30) { xcd_barrier(bar); p3_attn_only(F); } if (DUP_PHASE == 31) { xcd_barrier(bar); p3_conv_only(F); } if (BOTH(3)) xcd_barrier(bar); STAMP(4); }
    if (IN(4)) {
        OutProj S; S.K = DM; S.G = F.G; S.c = (int)blockIdx.x; S.A = (const bf16_t*)(F.ws + WS_H); S.Bt = (const bf16_t*)(F.ws + WS_WO); S.bo = F.in[14]; S.MIX = (bf16_t*)(F.ws + WS_MIX);
        pg8::gemm_phase<OutProj>(F.lds + RING_OFF, S);
        if (DUP_PHASE == 4) { xcd_barrier(bar); pg8::gemm_phase<OutProj>(F.lds + RING_OFF, S); }
        if (BOTH(4)) xcd_barrier(bar); STAMP(5);
    }
    if (IN(5)) { p5_rows(F); if (BOTH(5)) xcd_barrier(bar); STAMP(6); }
    if (IN(6) || IN(7) || IN(8)) build_route_table(F);
    if (IN(6)) {
        MoeUp S; S.K = DM; S.G = F.G; S.c = (int)blockIdx.x; S.tab = (const volatile LAS int*)(F.lds + TAB_OFF); S.H2 = (const bf16_t*)(F.ws + WS_H2); S.WGU = (const bf16_t*)(F.ws + WS_WGU);
        S.list = (const int*)(F.ws + WS_LIST); S.ACT = (bf16_t*)(F.ws + WS_ACT);
        pg8::gemm_phase<MoeUp>(F.lds + RING_OFF, S);
        if (DUP_PHASE == 6) { xcd_barrier(bar); pg8::gemm_phase<MoeUp>(F.lds + RING_OFF, S); }
        if (BOTH(6)) xcd_barrier(bar); STAMP(7);
    }
    if (IN(7)) {
        MoeDown S; S.K = DE; S.G = F.G; S.c = (int)blockIdx.x; S.tab = (const volatile LAS int*)(F.lds + TAB_OFF); S.ACT = (const bf16_t*)(F.ws + WS_ACT); S.WD = (const bf16_t*)(F.ws + WS_WD); S.YS = (bf16_t*)(F.ws + WS_YS);
        pg8::gemm_phase<MoeDown>(F.lds + RING_OFF, S);
        if (DUP_PHASE == 7) { xcd_barrier(bar); pg8::gemm_phase<MoeDown>(F.lds + RING_OFF, S); }
        if (BOTH(7)) xcd_barrier(bar); STAMP(8);
    }
    if (IN(8)) { p8_final(F); }
#if DIAG
    {
        xcd_barrier(bar); STAMP(9);
        __syncthreads();
#define DSEL(k) ((k) == 9 ? TS[9] - TS[0] : (k) == 10 ? TS[10] - TS[0] : (k) == 11 ? TS[11] - TS[10] : (k) == 12 ? TS[12] - TS[11] : (k) == 13 ? TS[13] - TS[3] : (k) == 14 ? TS[14] - TS[13] : TS[(k) + 1] - TS[(k)])
        const unsigned ta = DSEL(DIAG_A);
        const unsigned tb = DSEL(DIAG_B);
        if (blockIdx.x == 0) {
            const float da = (float)ta * 0.01f, db = (float)tb * 0.01f;
            int n = (int)(db * 500.f); if (n > 126000) n = 126000;
            const int NGW = F.G * NWAVES;
            for (int e = F.tid; e < n; e += 512) { const int ee = e + 1024; const int ri = ee >> 10, col = ee & 1023; const int row = (ri & 7) + (ri >> 3) * NGW; F.out[(size_t)row * DM + col] += 0.05f; }
            if (F.tid == 0) F.out[0] += 1.f + da * 0.02f;
        }
    }
#endif
#undef IN
#undef BOTH
}

namespace nv {
__device__ __forceinline__ float sigmoidf_(float v) { return 1.f / (1.f + __expf(-v)); }
__device__ __forceinline__ float siluf_(float v) { return v / (1.f + __expf(-v)); }
__global__ void __launch_bounds__(256) k_gemm(const float* A, const float* B, const float* bias, float* C, int M, int N, int K) {
    __shared__ float As[16][65]; __shared__ float Bs[16][64];
    int tx = threadIdx.x % 16, ty = threadIdx.x / 16; int m0 = blockIdx.y * 64, n0 = blockIdx.x * 64;
    float acc[4][4] = {};
    for (int k0 = 0; k0 < K; k0 += 16) {
        for (int i = threadIdx.x; i < 64 * 16; i += 256) { int r = i / 16, kk = i % 16; As[kk][r] = A[(size_t)(m0 + r) * K + k0 + kk]; }
        for (int i = threadIdx.x; i < 16 * 64; i += 256) { int kk = i / 64, cc = i % 64; Bs[kk][cc] = B[(size_t)(k0 + kk) * N + n0 + cc]; }
        __syncthreads();
#pragma unroll
        for (int kk = 0; kk < 16; ++kk) { float a[4], b[4];
#pragma unroll
            for (int i = 0; i < 4; ++i) { a[i] = As[kk][ty * 4 + i]; b[i] = Bs[kk][tx * 4 + i]; }
#pragma unroll
            for (int i = 0; i < 4; ++i)
#pragma unroll
                for (int j = 0; j < 4; ++j) acc[i][j] += a[i] * b[j]; }
        __syncthreads();
    }
    for (int i = 0; i < 4; ++i) for (int j = 0; j < 4; ++j) { int r = m0 + ty * 4 + i, cc = n0 + tx * 4 + j; C[(size_t)r * N + cc] = acc[i][j] + (bias ? bias[cc] : 0.f); }
}
__device__ __forceinline__ float block_sum512(float v, float* red) {
    for (int o = 32; o > 0; o >>= 1) v += __shfl_xor(v, o);
    __syncthreads();
    if ((threadIdx.x & 63) == 0) red[threadIdx.x >> 6] = v;
    __syncthreads();
    float s = 0.f; for (int i = 0; i < 8; ++i) s += red[i];
    return s;
}
__global__ void __launch_bounds__(512) k_conv2(const bf16_t* VG, const float* conv_w, const float* conv_b, const float* lng, const float* lnb, const float* outg, float* ycat) {
    __shared__ float red[8];
    int t = blockIdx.x, c = threadIdx.x; int s = t % SEQ;
    float acc = 0.f;
    for (int j = 0; j < CW; ++j) { int ss = s - (CW - 1) + j; if (ss < 0) continue; acc += conv_w[j * DCONV + c] * bf2f(VG[(size_t)(t - (CW - 1) + j) * DCONV + c]); }
    acc += conv_b[c];
    float mean = block_sum512(acc, red) * (1.f / DCONV); float d = acc - mean;
    float var = block_sum512(d * d, red) * (1.f / DCONV);
    float y = d * rsqrtf(var + EPS) * lng[c] + lnb[c];
    y = siluf_(y);
    float q = y * y; for (int o = 32; o > 0; o >>= 1) q += __shfl_xor(q, o);
    y = y * rsqrtf(q * (1.f / 64.f) + EPS) * outg[c];
    ycat[(size_t)t * DM + c] = y;
}
__global__ void __launch_bounds__(512) k_attn2(const bf16_t* Q, const bf16_t* KV, const float* sinks, const float* outg, float* ycat) {
    __shared__ float ps[8][128];
    int t = blockIdx.x, h = threadIdx.x >> 6, lane = threadIdx.x & 63; int s = t % SEQ; int kvh = h / 4;
    const bf16_t* q = Q + (size_t)t * DATTN + h * HD;
    float sc[2];
    for (int i = 0; i < 2; ++i) { int d = lane + 64 * i; int ss = s - d; float v = -1e30f;
        if (ss >= 0) { const bf16_t* k = KV + (size_t)(t - d) * 256 + kvh * HD; float a = 0.f; for (int e = 0; e < HD; ++e) a += bf2f(q[e]) * bf2f(k[e]); v = a; }
        sc[i] = v; }
    float sk = sinks[h] * LOG2E; float m = fmaxf(fmaxf(sc[0], sc[1]), sk);
    for (int o = 32; o > 0; o >>= 1) m = fmaxf(m, __shfl_xor(m, o));
    float p0 = (sc[0] > -1e29f) ? exp2f(sc[0] - m) : 0.f, p1 = (sc[1] > -1e29f) ? exp2f(sc[1] - m) : 0.f;
    float l = p0 + p1; for (int o = 32; o > 0; o >>= 1) l += __shfl_xor(l, o);
    l += exp2f(sk - m);
    ps[h][lane] = p0 / l; ps[h][lane + 64] = p1 / l;
    __syncthreads();
    float o = 0.f; int nd = (s + 1 < WIN) ? s + 1 : WIN;
    for (int d = 0; d < nd; ++d) o += ps[h][d] * bf2f(KV[(size_t)(t - d) * 256 + DKV + kvh * HD + lane]);
    float qq = o * o; for (int oo = 32; oo > 0; oo >>= 1) qq += __shfl_xor(qq, oo);
    ycat[(size_t)t * DM + DCONV + h * HD + lane] = o * rsqrtf(qq * (1.f / 64.f) + EPS) * outg[h * HD + lane];
}
__device__ __forceinline__ float block_sum256(float v, float* red) {
    for (int o = 32; o > 0; o >>= 1) v += __shfl_xor(v, o);
    __syncthreads();
    if ((threadIdx.x & 63) == 0) red[threadIdx.x >> 6] = v;
    __syncthreads();
    return red[0] + red[1] + red[2] + red[3];
}
__global__ void __launch_bounds__(256) k_ln1(const float* x, const float* mix, const float* mod, const float* g, const float* bta, float* x1) {
    __shared__ float red[4];
    int t = blockIdx.x, b = t / SEQ; float z[4]; float s = 0.f;
    for (int i = 0; i < 4; ++i) { int c = threadIdx.x + 256 * i; z[i] = ALPHA * x[(size_t)t * DM + c] + mod[b * 6 * DM + 2 * DM + c] * mix[(size_t)t * DM + c]; s += z[i]; }
    float mean = block_sum256(s, red) * (1.f / DM); float q = 0.f;
    for (int i = 0; i < 4; ++i) { z[i] -= mean; q += z[i] * z[i]; }
    float rstd = rsqrtf(block_sum256(q, red) * (1.f / DM) + EPS);
    for (int i = 0; i < 4; ++i) { int c = threadIdx.x + 256 * i; x1[(size_t)t * DM + c] = z[i] * rstd * g[c] + bta[c]; }
}
__global__ void k_bf2f(const bf16_t* in, float* out, size_t n) { size_t i = (size_t)blockIdx.x * blockDim.x + threadIdx.x; if (i < n) out[i] = bf2f(in[i]); }
__global__ void __launch_bounds__(256) k_moe(float* io, const float* mod, const float* wrg, const float* brg, const float* wre, const float* bre,
                                            const float* wg, const float* wu, const float* wd, const float* g2ln, const float* b2ln) {
    __shared__ float h2[DM]; __shared__ float part[4][64]; __shared__ float logit[64]; __shared__ float act[DE]; __shared__ int se[2]; __shared__ float sw[2]; __shared__ float red[4];
    int t = blockIdx.x, b = t / SEQ, tid = threadIdx.x;
    float x1v[4];
    for (int i = 0; i < 4; ++i) { int c = tid + 256 * i; x1v[i] = io[(size_t)t * DM + c]; h2[c] = x1v[i] * (1.f + mod[b * 6 * DM + 4 * DM + c]) + mod[b * 6 * DM + 3 * DM + c]; }
    __syncthreads();
    { int j = tid & 63, kp = tid >> 6; float a = 0.f;
      if (j < 36) { for (int k = kp * 256; k < kp * 256 + 256; ++k) a += h2[k] * (j < 4 ? wrg[k * NG + j] : wre[k * NE + (j - 4)]); }
      part[kp][j] = a; }
    __syncthreads();
    if (tid < 36) logit[tid] = part[0][tid] + part[1][tid] + part[2][tid] + part[3][tid] + (tid < 4 ? brg[tid] : bre[tid - 4]);
    __syncthreads();
    if (tid == 0) {
        float m = logit[0]; int gi = 0; for (int i = 1; i < 4; ++i) if (logit[i] > m) { m = logit[i]; gi = i; }
        float ssum = 0.f; for (int i = 0; i < 4; ++i) ssum += __expf(logit[i] - m); float ptop = 1.f / ssum;
        const float* el = logit + 4 + gi * 8; float em = el[0]; int i1 = 0; for (int i = 1; i < 8; ++i) if (el[i] > em) { em = el[i]; i1 = i; }
        float e2m = -3e38f; int i2 = -1; for (int i = 0; i < 8; ++i) if (i != i1 && el[i] > e2m) { e2m = el[i]; i2 = i; }
        float pa = 1.f, pb = __expf(e2m - em); float inv = ptop / (pa + pb);
        se[0] = gi * 8 + i1; se[1] = gi * 8 + i2; sw[0] = pa * inv; sw[1] = pb * inv;
    }
    __syncthreads();
    float y[4] = {0.f, 0.f, 0.f, 0.f};
    for (int s = 0; s < 2; ++s) {
        int e = se[s]; float w = sw[s];
        const float* G = wg + (size_t)e * DM * DE; const float* U = wu + (size_t)e * DM * DE; const float* Dn = wd + (size_t)e * DE * DM;
        float ga = 0.f, ua = 0.f;
        for (int k = 0; k < DM; ++k) { float hv = h2[k]; ga += hv * G[(size_t)k * DE + tid]; ua += hv * U[(size_t)k * DE + tid]; }
        __syncthreads();
        act[tid] = siluf_(ga) * ua;
        __syncthreads();
        for (int j = 0; j < DE; ++j) { float av = act[j] * w; for (int i = 0; i < 4; ++i) y[i] += av * Dn[(size_t)j * DM + tid + 256 * i]; }
    }
    float z[4]; float sm = 0.f;
    for (int i = 0; i < 4; ++i) { int c = tid + 256 * i; z[i] = ALPHA * x1v[i] + mod[b * 6 * DM + 5 * DM + c] * y[i]; sm += z[i]; }
    float mean = block_sum256(sm, red) * (1.f / DM); float q = 0.f;
    for (int i = 0; i < 4; ++i) { z[i] -= mean; q += z[i] * z[i]; }
    float rstd = rsqrtf(block_sum256(q, red) * (1.f / DM) + EPS);
    for (int i = 0; i < 4; ++i) { int c = tid + 256 * i; io[(size_t)t * DM + c] = z[i] * rstd * g2ln[c] + b2ln[c]; }
}
}

extern "C" void kernel_launch(void* const* d_in, const int* in_sizes, int n_in, void* d_out, int out_size, void* d_ws, size_t ws_size, hipStream_t stream) {
    static int grid = 0;
    if (grid == 0) {
        int dev = 0, cus = 0;
        if (hipGetDevice(&dev) != hipSuccess || hipDeviceGetAttribute(&cus, hipDeviceAttributeMultiprocessorCount, dev) != hipSuccess) { fprintf(stderr, "kernel_launch: device query failed\n"); grid = -1; return; }
        if (hipFuncSetAttribute((const void*)mega_fwd, hipFuncAttributeMaxDynamicSharedMemorySize, LDS_BYTES) != hipSuccess) { fprintf(stderr, "kernel_launch: hipFuncSetAttribute failed\n"); grid = -1; return; }
        int per_cu = 0;
        if (hipOccupancyMaxActiveBlocksPerMultiprocessor(&per_cu, (const void*)mega_fwd, NWAVES * 64, LDS_BYTES) != hipSuccess || per_cu < 1) fprintf(stderr, "kernel_launch: occupancy query reports %d\n", per_cu);
        (void)hipGetLastError();
        grid = cus;
    }
    if (grid < 0) return;
    (void)hipMemsetAsync((char*)d_ws + WS_CTL, 0, CTL_ZERO_BYTES, stream);
    Args a{};
    for (int i = 0; i < 26; ++i) a.in[i] = (const float*)d_in[i];
    a.out = (float*)d_out; a.ws = (unsigned char*)d_ws; a.ph_lo = 0; a.ph_hi = DEV_STAGE + 1;
    hipLaunchKernelGGL(mega_fwd, dim3(grid), dim3(NWAVES * 64), LDS_BYTES, stream, a);
    {
        using namespace nv;
        char* ws = (char*)d_ws; float* out = (float*)d_out;
        const float* x = (const float*)d_in[0];
        const float* mod = (const float*)(ws + WS_MOD);
        float* ycat = (float*)(ws + WS_DEV1);
        float* mix = (float*)(ws + 56 * MiB);
#if DEV_STAGE == 3
        k_bf2f<<<(unsigned)((size_t)T * DM / 256), 256, 0, stream>>>((const bf16_t*)(ws + WS_H), ycat, (size_t)T * DM);
        mix = (float*)(ws + 120 * MiB);
        k_gemm<<<dim3(DM / 64, T / 64), 256, 0, stream>>>(ycat, (const float*)d_in[13], (const float*)d_in[14], mix, T, DM, DM);
        k_ln1<<<T, 256, 0, stream>>>(x, mix, mod, (const float*)d_in[15], (const float*)d_in[16], out);
        k_moe<<<T, 256, 0, stream>>>(out, mod, (const float*)d_in[17], (const float*)d_in[18], (const float*)d_in[19], (const float*)d_in[20], (const float*)d_in[21], (const float*)d_in[22], (const float*)d_in[23], (const float*)d_in[24], (const float*)d_in[25]);
#endif
#if DEV_STAGE == 2
        k_conv2<<<T, 512, 0, stream>>>((const bf16_t*)(ws + WS_VG), (const float*)d_in[6], (const float*)d_in[7], (const float*)d_in[8], (const float*)d_in[9], (const float*)d_in[10], ycat);
        k_attn2<<<T, 512, 0, stream>>>((const bf16_t*)(ws + WS_Q), (const bf16_t*)(ws + WS_KV), (const float*)d_in[11], (const float*)d_in[12], ycat);
        k_gemm<<<dim3(DM / 64, T / 64), 256, 0, stream>>>(ycat, (const float*)d_in[13], (const float*)d_in[14], mix, T, DM, DM);
        k_ln1<<<T, 256, 0, stream>>>(x, mix, mod, (const float*)d_in[15], (const float*)d_in[16], out);
        k_moe<<<T, 256, 0, stream>>>(out, mod, (const float*)d_in[17], (const float*)d_in[18], (const float*)d_in[19], (const float*)d_in[20], (const float*)d_in[21], (const float*)d_in[22], (const float*)d_in[23], (const float*)d_in[24], (const float*)d_in[25]);
#endif
    }
}
```

```cpp
#include <hip/hip_runtime.h>
#include <cstdio>
#include <cstdint>

#ifndef DIAG
#define DIAG 0
#endif
#ifndef DIAG_A
#define DIAG_A 9
#endif
#ifndef DIAG_B
#define DIAG_B 9
#endif
#ifndef DUP_PHASE
#define DUP_PHASE -1
#endif
#ifndef DEV_STAGE
#define DEV_STAGE 8
#endif

#define LAS __attribute__((address_space(3)))
#define GAS __attribute__((address_space(1)))
typedef unsigned short bf16_t;
typedef short bf16x8 __attribute__((ext_vector_type(8)));
typedef float f32x4 __attribute__((ext_vector_type(4)));
typedef float f32x2 __attribute__((ext_vector_type(2)));
typedef unsigned u32x4 __attribute__((ext_vector_type(4)));
typedef unsigned u32x2 __attribute__((ext_vector_type(2)));
typedef GAS unsigned gu32;

constexpr int DM = 1024, NBATCH = 8, SEQ = 4096, T = NBATCH * SEQ;
constexpr int DCONV = 512, CW = 31, NH = 8, NKV = 2, HD = 64, DATTN = 512, DKV = 128, WIN = 128;
constexpr int DIN = 1792, NG = 4, EPG = 8, NE = 32, DE = 256;
constexpr float ALPHA = 1.189207115002721f, EPS = 1e-5f;
constexpr float LOG2E = 1.4426950408889634f;
constexpr float QSCALE = 0.125f * LOG2E;

constexpr size_t MiB = 1u << 20;
constexpr size_t WS_CTL = 0, CTL_ZERO_BYTES = 1 * MiB;
constexpr size_t WS_MOD = 1 * MiB;
constexpr size_t WS_BPERM = 1 * MiB + 256 * 1024;
constexpr size_t WS_WR = 1 * MiB + 512 * 1024;
constexpr size_t WS_WI = 2 * MiB;
constexpr size_t WS_WO = 6 * MiB;
constexpr size_t WS_WGU = 8 * MiB;
constexpr size_t WS_WD = 40 * MiB;
constexpr size_t WS_H = 56 * MiB;
constexpr size_t WS_VG = 120 * MiB;
constexpr size_t WS_Q = 152 * MiB;
constexpr size_t WS_KV = 184 * MiB;
constexpr size_t WS_H2 = 200 * MiB;
constexpr size_t WS_ACT = 264 * MiB;
constexpr size_t WS_LIST = 300 * MiB;
constexpr size_t WS_TOK = 304 * MiB;
constexpr size_t WS_MIX = 120 * MiB;
constexpr size_t WS_YS = 56 * MiB;
constexpr size_t WS_DEV1 = 320 * MiB;
constexpr int CW_BAR = 4096;
constexpr int CW_ECNT = 16384;

constexpr int RING_OFF = 0, RING_BYTES = 139264;
constexpr int LDSCTL_OFF = RING_BYTES, MISC_OFF = LDSCTL_OFF + 320;
constexpr int LDS_BYTES = 147456;
constexpr int NWAVES = 8;

#define RLX_AGENT __ATOMIC_RELAXED, __HIP_MEMORY_SCOPE_AGENT
#define LDS_WAIT() asm volatile("s_waitcnt lgkmcnt(0)" ::: "memory")
#define VM_WAIT() asm volatile("s_waitcnt vmcnt(0)" ::: "memory")

__device__ __forceinline__ unsigned f2bf(float f) { unsigned u = __builtin_bit_cast(unsigned, f); return (u + 0x7fffu + ((u >> 16) & 1u)) >> 16; }
__device__ __forceinline__ unsigned pk2(float lo, float hi) { return f2bf(lo) | (f2bf(hi) << 16); }
__device__ __forceinline__ float bf2f(unsigned short b) { return __builtin_bit_cast(float, (unsigned)b << 16); }
__device__ __forceinline__ unsigned cvt_pk_bf16(float lo, float hi) { unsigned r; asm volatile("v_cvt_pk_bf16_f32 %0, %1, %2" : "=v"(r) : "v"(lo), "v"(hi)); return r; }
__device__ __forceinline__ float fast_sigmoid(float v) { return __builtin_amdgcn_rcpf(1.f + __builtin_amdgcn_exp2f(-v * LOG2E)); }
__device__ __forceinline__ float fast_silu(float v) { return v * fast_sigmoid(v); }

#define XB_TMO      128
#define XB_XCNT(j)  (256  + 64 * (j))
#define XB_XSUB(j)  (1280 + 64 * (j))
#define XB_XGEN(j)  (2304 + 64 * (j))
#define XB_TOP      3328
#define XB_TOPGEN   3392
#define XCD_BAR_WORDS 3456
#define XB_SPIN_CAP (1u << 18)
__device__ __forceinline__ unsigned xb_ld(unsigned* p)              { return __hip_atomic_load(p, __ATOMIC_RELAXED, __HIP_MEMORY_SCOPE_AGENT); }
__device__ __forceinline__ unsigned xb_add(unsigned* p, unsigned v) { return __hip_atomic_fetch_add(p, v, __ATOMIC_RELAXED, __HIP_MEMORY_SCOPE_AGENT); }
__device__ __forceinline__ unsigned xb_xcc_id() { return (unsigned)__builtin_amdgcn_s_getreg((3 << 11) | 20) & 0xFu; }
#define XB_SPIN(cond, bar) do { unsigned _sp = 0; while (cond) { __builtin_amdgcn_s_sleep(1); \
    if ((++_sp & 255u) == 0u) { if (xb_ld(&(bar)[XB_TMO])) break; if (_sp > XB_SPIN_CAP) { atomicAdd(&(bar)[XB_TMO], 1u); break; } } } } while (0)
struct XcdBarrier { unsigned* bar; unsigned x; volatile LAS unsigned* st; };
__device__ __forceinline__ XcdBarrier xcd_barrier_post(unsigned* bar, volatile LAS unsigned* st) {
    XcdBarrier b; b.bar = bar; b.x = xb_xcc_id(); b.st = st;
    if (threadIdx.x == 0) (void)xb_add(&bar[XB_XCNT(b.x)], 1u);
    return b;
}
__device__ __forceinline__ void xcd_barrier_complete(unsigned* bar, unsigned x, unsigned& nloc, unsigned& nx) {
    const unsigned G = gridDim.x * gridDim.y * gridDim.z;
    unsigned sum, cnt, mine, sp = 0u;
    for (;;) {
        sum = 0u; cnt = 0u; mine = 0u;
#pragma unroll
        for (unsigned j = 0; j < 16; ++j) { const unsigned c = xb_ld(&bar[XB_XCNT(j)]); sum += c; cnt += (c > 0u) ? 1u : 0u; mine = (j == x) ? c : mine; }
        if (sum == G) break;
        __builtin_amdgcn_s_sleep(1);
        if ((++sp & 255u) == 0u) { if (xb_ld(&bar[XB_TMO])) break; if (sp > XB_SPIN_CAP) { atomicAdd(&bar[XB_TMO], 1u); break; } }
    }
    nloc = mine > 0u ? mine : 1u; nx = cnt > 0u ? cnt : 1u;
}
__device__ __forceinline__ void xcd_barrier(const XcdBarrier& b) {
    asm volatile("s_waitcnt vmcnt(0)" ::: "memory");
    __syncthreads();
    if (threadIdx.x == 0) {
        unsigned* bar = b.bar;
        __builtin_amdgcn_s_waitcnt(0);
        unsigned nloc = b.st[0], nx = b.st[1];
        if (nloc == 0u) { xcd_barrier_complete(bar, b.x, nloc, nx); b.st[0] = nloc; b.st[1] = nx; }
        const unsigned old = xb_add(&bar[XB_XSUB(b.x)], 1u);
        const unsigned gen = old / nloc;
        if (old + 1u == (gen + 1u) * nloc) {
            __builtin_amdgcn_fence(__ATOMIC_RELEASE, "agent");
            asm volatile("s_waitcnt vmcnt(0)" ::: "memory");
            const unsigned og = xb_add(&bar[XB_TOP], 1u);
            const unsigned tg = og / nx;
            if (og + 1u == (tg + 1u) * nx) xb_add(&bar[XB_TOPGEN], 1u);
            else XB_SPIN(xb_ld(&bar[XB_TOPGEN]) == tg, bar);
            __builtin_amdgcn_fence(__ATOMIC_ACQUIRE, "agent");
            xb_add(&bar[XB_XGEN(b.x)], 1u);
            asm volatile("s_waitcnt vmcnt(0)" ::: "memory");
        } else {
            XB_SPIN(xb_ld(&bar[XB_XGEN(b.x)]) == gen, bar);
            __builtin_amdgcn_fence(__ATOMIC_ACQUIRE, "agent");
            asm volatile("s_waitcnt vmcnt(0)" ::: "memory");
        }
    }
    __syncthreads();
}

namespace pg8 {
constexpr int BM = 256, BK = 64, HALF = 128, HTB = HALF * BK * 2, STAGE_BYTES = 8 * HTB, NXCD = 8, WGM = 8;
__host__ __device__ __forceinline__ int lds_byte(int r, int c) { const int st = (r >> 4) * 2 + (c >> 5), rr = r & 15, cc = c & 31, ob = rr * 64 + cc * 2; return st * 1024 + (ob ^ (((ob >> 9) & 1) << 5)); }
__host__ __device__ __forceinline__ void stage_rc(int b, int& R, int& C) { const int st = b / 1024, sb = b % 1024, swz = sb ^ (((sb >> 9) & 1) << 5); R = (st >> 1) * 16 + swz / 64; C = (st & 1) * 32 + (swz % 64) / 2; }
__host__ __device__ __forceinline__ int perm32(int rho) { const int n = rho >> 4, i = rho & 15; return 8 * (i >> 2) + 4 * n + (i & 3); }

struct Unit { int pm, pn, e; };
__device__ __forceinline__ bool static_next(int i, int G, int c, int nM, int nN, int& pm, int& pn) {
    const int nwg = nM * nN; const long L = (long)i * G + c; if (L >= nwg) return false;
    int wgid = (int)L; { const int q = nwg / NXCD, r = nwg % NXCD, xcd = wgid % NXCD, off = wgid / NXCD; wgid = (xcd < r ? xcd * (q + 1) : r * (q + 1) + (xcd - r) * q) + off; }
    const int nig = WGM * nN, gid = wgid / nig, fm = gid * WGM, gsz = (nM - fm) < WGM ? (nM - fm) : WGM;
    pm = fm + ((wgid % nig) % gsz); pn = (wgid % nig) / gsz; return true;
}

template <class P>
__device__ __forceinline__ void gemm_phase(LAS unsigned char* lds, const P& S) {
    const int tid = threadIdx.x, wid = __builtin_amdgcn_readfirstlane(tid >> 6), lane = tid & 63, wr = wid >> 2, wc = wid & 3, fr = lane & 15, fq = lane >> 4;
    const int K = S.K, nt = K / BK;
    int sR[2], sC[2]; unsigned voffB[2];
#pragma unroll
    for (int i = 0; i < 2; ++i) { int R, C; stage_rc(tid * 16 + i * 8192, R, C); sR[i] = R; sC[i] = C; const int Rb = P::PERM ? ((R & ~31) + perm32(R & 31)) : R; voffB[i] = (unsigned)(Rb * K + C) * 2u; }
    const size_t kstep = (size_t)(BK * 2);
    const size_t hstepB = (size_t)HALF * K * 2;
    const unsigned ldsw = (unsigned)wid * 1024u;
    const int aoff = lds_byte(wr * 64 + fr, fq * 8), boff = lds_byte(wc * 32 + fr, fq * 8);
#define PG8_SA(b, h) (((b) * 2 + (h)) * HTB)
#define PG8_SB(b, h) ((4 + (b) * 2 + (h)) * HTB)
#define PG8_STAGE(bufoff, gbase, voff) do { _Pragma("unroll") for (int _i = 0; _i < 2; ++_i) \
        __builtin_amdgcn_global_load_lds((const unsigned*)((const char*)(gbase) + (voff)[_i]), (LAS unsigned*)(lds + (bufoff) + ldsw + _i * 8192), 16, 0, 0); } while (0)
#define PG8_LDA(dst, b, h) do { _Pragma("unroll") for (int m = 0; m < 4; ++m) _Pragma("unroll") for (int k = 0; k < 2; ++k) dst[m][k] = *(const LAS bf16x8*)(lds + PG8_SA(b, h) + aoff + m * 2048 + k * 1024); } while (0)
#define PG8_LDB(dst, b, h) do { _Pragma("unroll") for (int n = 0; n < 2; ++n) _Pragma("unroll") for (int k = 0; k < 2; ++k) dst[n][k] = *(const LAS bf16x8*)(lds + PG8_SB(b, h) + boff + n * 2048 + k * 1024); } while (0)
#define PG8_MMA(ai, bj, At, Bt) do { __builtin_amdgcn_s_setprio(1); _Pragma("unroll") for (int m = 0; m < 4; ++m) _Pragma("unroll") for (int n = 0; n < 2; ++n) _Pragma("unroll") for (int k = 0; k < 2; ++k) \
        acc[ai][bj][m][n] = __builtin_amdgcn_mfma_f32_16x16x32_bf16(Bt[n][k], At[m][k], acc[ai][bj][m][n], 0, 0, 0); __builtin_amdgcn_s_setprio(0); } while (0)
#define PG8_WAIT_V(n) asm volatile("s_waitcnt vmcnt(" #n ")" ::: "memory")
#define PG8_WAIT_L(n) asm volatile("s_waitcnt lgkmcnt(" #n ")" ::: "memory")
#define PG8_BAR __builtin_amdgcn_s_barrier()
#define PG8_SCHED __builtin_amdgcn_sched_barrier(0)
    Unit cur, nxt; int ui = 0;
    if (!S.next(0, cur)) return;
    f32x4 acc[2][2][4][2];
#pragma unroll
    for (int a = 0; a < 2; ++a)
#pragma unroll
        for (int b = 0; b < 2; ++b)
#pragma unroll
            for (int m = 0; m < 4; ++m)
#pragma unroll
                for (int n = 0; n < 2; ++n) acc[a][b][m][n] = (f32x4){0.f, 0.f, 0.f, 0.f};
    bf16x8 At[4][2], B0[2][2], B1[2][2];
    unsigned vAc[2][2], vAn[2][2];
    S.a_voff(cur, sR, sC, vAc);
    const char* cA = S.a_base(cur); const char* cB = S.b_base(cur);
    PG8_STAGE(PG8_SB(0, 0), cB, voffB); PG8_STAGE(PG8_SB(0, 1), cB + hstepB, voffB); PG8_STAGE(PG8_SA(0, 0), cA, vAc[0]); PG8_STAGE(PG8_SA(0, 1), cA, vAc[1]);
    if (wr == 1) PG8_BAR;
    PG8_WAIT_V(2); PG8_BAR;
    PG8_STAGE(PG8_SB(1, 0), cB + kstep, voffB); PG8_STAGE(PG8_SA(1, 0), cA + kstep, vAc[0]); PG8_STAGE(PG8_SB(1, 1), cB + hstepB + kstep, voffB);
    PG8_WAIT_V(6); PG8_BAR;
    for (;;) {
        const bool has_next = S.next(ui + 1, nxt);
        const char* nA = has_next ? S.a_base(nxt) : cA; const char* nB = has_next ? S.b_base(nxt) : cB;
        if (has_next) S.a_voff(nxt, sR, sC, vAn); else { vAn[0][0] = vAc[0][0]; vAn[0][1] = vAc[0][1]; vAn[1][0] = vAc[1][0]; vAn[1][1] = vAc[1][1]; }
        for (int t = 0; t < nt; t += 2) {
            const bool last = (t == nt - 2);
            const char* a1 = cA + (size_t)(t + 1) * kstep;
            const char* a2 = last ? nA : cA + (size_t)(t + 2) * kstep; const char* b2 = last ? nB : cB + (size_t)(t + 2) * kstep;
            const char* a3 = a2 + kstep; const char* b3 = b2 + kstep;
            unsigned v2[2][2];
            v2[0][0] = last ? vAn[0][0] : vAc[0][0]; v2[0][1] = last ? vAn[0][1] : vAc[0][1]; v2[1][0] = last ? vAn[1][0] : vAc[1][0]; v2[1][1] = last ? vAn[1][1] : vAc[1][1];
            PG8_LDB(B0, 0, 0); PG8_LDB(B1, 0, 1); PG8_SCHED; PG8_LDA(At, 0, 0); PG8_STAGE(PG8_SA(1, 1), a1, vAc[1]);
            PG8_WAIT_V(8); PG8_WAIT_L(0); PG8_BAR; PG8_MMA(0, 0, At, B0); PG8_MMA(0, 1, At, B1); PG8_BAR; PG8_SCHED;
            PG8_LDA(At, 0, 1); PG8_STAGE(PG8_SB(0, 0), b2, voffB); PG8_STAGE(PG8_SB(0, 1), b2 + hstepB, voffB); PG8_STAGE(PG8_SA(0, 0), a2, v2[0]);
            PG8_WAIT_V(8); PG8_WAIT_L(0); PG8_BAR; PG8_MMA(1, 0, At, B0); PG8_MMA(1, 1, At, B1); PG8_BAR; PG8_SCHED;
            PG8_LDB(B0, 1, 0); PG8_LDB(B1, 1, 1); PG8_SCHED; PG8_LDA(At, 1, 0); PG8_STAGE(PG8_SA(0, 1), a2, v2[1]);
            PG8_WAIT_V(8); PG8_WAIT_L(0); PG8_BAR; PG8_MMA(0, 0, At, B0); PG8_MMA(0, 1, At, B1); PG8_BAR; PG8_SCHED;
            PG8_LDA(At, 1, 1); PG8_STAGE(PG8_SB(1, 0), b3, voffB); PG8_STAGE(PG8_SB(1, 1), b3 + hstepB, voffB); PG8_STAGE(PG8_SA(1, 0), a3, v2[0]);
            PG8_WAIT_V(8); PG8_WAIT_L(0); PG8_BAR; PG8_MMA(1, 0, At, B0); PG8_MMA(1, 1, At, B1); PG8_BAR; PG8_SCHED;
        }
        if (wr == 0) PG8_BAR;
        S.epi(acc, cur, wr, wc, fr, fq);
        if (!has_next) break;
#pragma unroll
        for (int a = 0; a < 2; ++a)
#pragma unroll
            for (int b = 0; b < 2; ++b)
#pragma unroll
                for (int m = 0; m < 4; ++m)
#pragma unroll
                    for (int n = 0; n < 2; ++n) acc[a][b][m][n] = (f32x4){0.f, 0.f, 0.f, 0.f};
        cur = nxt; cA = nA; cB = nB; ++ui;
        vAc[0][0] = vAn[0][0]; vAc[0][1] = vAn[0][1]; vAc[1][0] = vAn[1][0]; vAc[1][1] = vAn[1][1];
        if (wr == 1) PG8_BAR;
    }
    PG8_WAIT_V(0);
    PG8_BAR;
#undef PG8_SA
#undef PG8_SB
#undef PG8_STAGE
#undef PG8_LDA
#undef PG8_LDB
#undef PG8_MMA
#undef PG8_WAIT_V
#undef PG8_WAIT_L
#undef PG8_BAR
#undef PG8_SCHED
}
}

struct Frame {
    LAS unsigned char* lds;
    volatile LAS unsigned* MISC;
    gu32* ctl;
    int tid, lane, wave, vcu, G;
    const float* in[26]; float* out; unsigned char* ws;
};
struct Args { const float* in[26]; float* out; unsigned char* ws; int ph_lo, ph_hi; };

__device__ __forceinline__ void sub_stamp(Frame& F, int k) { if (DIAG && blockIdx.x == 0 && F.tid == 0) ((volatile LAS unsigned*)(F.lds + LDSCTL_OFF + 2048))[k] = (unsigned)__builtin_amdgcn_s_memrealtime(); }
template <int CTRL> __device__ __forceinline__ float dpp_mov(float src) { return __builtin_bit_cast(float, __builtin_amdgcn_update_dpp(0, __builtin_bit_cast(int, src), CTRL, 0xF, 0xF, true)); }
__device__ __forceinline__ float group8_sum(float v) {
    v += dpp_mov<0xB1>(v); v += dpp_mov<0x4E>(v); v += dpp_mov<0x141>(v); return v;
}
__device__ __forceinline__ float wave_sum(float v) {
    v = group8_sum(v); v += dpp_mov<0x140>(v);
    return __builtin_bit_cast(float, __builtin_amdgcn_readlane(__builtin_bit_cast(int, v), 0)) + __builtin_bit_cast(float, __builtin_amdgcn_readlane(__builtin_bit_cast(int, v), 16))
         + __builtin_bit_cast(float, __builtin_amdgcn_readlane(__builtin_bit_cast(int, v), 32)) + __builtin_bit_cast(float, __builtin_amdgcn_readlane(__builtin_bit_cast(int, v), 48));
}

struct P0Item { const float* W; bf16_t* WT; int Ksrc, N, dst_row0, k0, n0; };
__device__ __forceinline__ void p0_item_load(const P0Item& I, f32x4 (&v)[8], int lane) {
    const int r = lane >> 3, c4 = (lane & 7) * 4;
#pragma unroll
    for (int i = 0; i < 8; ++i) v[i] = __builtin_nontemporal_load((const f32x4*)(I.W + (size_t)(I.k0 + 8 * i + r) * I.N + I.n0 + c4));
}
__device__ __forceinline__ void p0_item_store(const P0Item& I, const f32x4 (&v)[8], LAS float* scr, int lane) {
    { const int r = lane >> 3, c4 = (lane & 7) * 4;
#pragma unroll
      for (int i = 0; i < 8; ++i) { LAS float* d = scr + (8 * i + r) * 33 + c4; d[0] = v[i][0]; d[1] = v[i][1]; d[2] = v[i][2]; d[3] = v[i][3]; } }
    LDS_WAIT(); asm volatile("" ::: "memory");
    const int c = lane & 7;
#pragma unroll
    for (int j = 0; j < 4; ++j) { const int n = (lane >> 3) + 8 * j; const LAS float* s = scr + (8 * c) * 33 + n;
        u32x4 o; o.x = pk2(s[0 * 33], s[1 * 33]); o.y = pk2(s[2 * 33], s[3 * 33]); o.z = pk2(s[4 * 33], s[5 * 33]); o.w = pk2(s[6 * 33], s[7 * 33]);
        __builtin_nontemporal_store(o, (GAS u32x4*)(I.WT + (size_t)(I.dst_row0 + n) * I.Ksrc + I.k0 + 8 * c)); }
    LDS_WAIT(); asm volatile("" ::: "memory");
}
__host__ __device__ __forceinline__ int map_in(int n) { return n < 512 ? 256 * (n >> 7) + (n & 127) : (n < 1024 ? 256 * ((n - 512) >> 7) + 128 + ((n - 512) & 127) : n); }

__device__ __forceinline__ void p0_convert(Frame& F, int gw, int NGW, int which) {
    LAS float* scr = (LAS float*)(F.lds + RING_OFF + F.wave * 16384);
    constexpr int I_IN = 16 * 56, I_OUT = 16 * 32, I_G = 16 * 8, I_D = 4 * 32, I_E = 2 * I_G + I_D;
    const int NITEMS = which == 0 ? I_IN + I_OUT : NE * I_E;
    bf16_t* WI = (bf16_t*)(F.ws + WS_WI); bf16_t* WO = (bf16_t*)(F.ws + WS_WO); bf16_t* WGU = (bf16_t*)(F.ws + WS_WGU); bf16_t* WD = (bf16_t*)(F.ws + WS_WD);
    auto decode = [&](int it, P0Item& I) {
        int r = it;
        if (which == 0) {
            if (r < I_IN) { const int kb = r / 56, nb = r % 56; I.W = F.in[4]; I.Ksrc = DM; I.N = DIN; I.WT = WI; I.dst_row0 = map_in(32 * nb); I.k0 = 64 * kb; I.n0 = 32 * nb; return; } r -= I_IN;
            { const int kb = r / 32, nb = r % 32; I.W = F.in[13]; I.Ksrc = DM; I.N = DM; I.WT = WO; I.dst_row0 = 32 * nb; I.k0 = 64 * kb; I.n0 = 32 * nb; return; }
        }
        const int e = r / I_E; r -= e * I_E;
        if (r < I_G) { const int kb = r / 8, nb = r % 8, n0 = 32 * nb; I.W = F.in[21] + (size_t)e * DM * DE; I.Ksrc = DM; I.N = DE; I.WT = WGU + (size_t)e * 512 * DM; I.dst_row0 = 256 * (n0 >> 7) + (n0 & 127); I.k0 = 64 * kb; I.n0 = n0; return; } r -= I_G;
        if (r < I_G) { const int kb = r / 8, nb = r % 8, n0 = 32 * nb; I.W = F.in[22] + (size_t)e * DM * DE; I.Ksrc = DM; I.N = DE; I.WT = WGU + (size_t)e * 512 * DM; I.dst_row0 = 256 * (n0 >> 7) + 128 + (n0 & 127); I.k0 = 64 * kb; I.n0 = n0; return; } r -= I_G;
        { const int kb = r / 32, nb = r % 32; I.W = F.in[23] + (size_t)e * DE * DM; I.Ksrc = DE; I.N = DM; I.WT = WD + (size_t)e * DM * DE; I.dst_row0 = 32 * nb; I.k0 = 64 * kb; I.n0 = 32 * nb; }
    };
    int it = gw;
    if (it < NITEMS) {
        P0Item cur; f32x4 vc[8]; decode(it, cur); p0_item_load(cur, vc, F.lane);
#pragma unroll
        for (int i = 0; i < 8; ++i) asm volatile("" : "+v"(vc[i]));
        for (;;) {
            const int itn = it + NGW; const bool has = itn < NITEMS;
            P0Item nx = cur; f32x4 vn[8];
            if (has) { decode(itn, nx); p0_item_load(nx, vn, F.lane); }
            p0_item_store(cur, vc, scr, F.lane);
            if (!has) break;
            cur = nx; it = itn;
#pragma unroll
            for (int i = 0; i < 8; ++i) vc[i] = vn[i];
        }
    }
}
__device__ __forceinline__ void p0_prologue(Frame& F) {
    const float* c = F.in[1]; const float* w_ada = F.in[2]; const float* b_ada = F.in[3];
    {
        LAS float* cact = (LAS float*)(F.lds + RING_OFF);
        LAS float* red = (LAS float*)(F.lds + RING_OFF + 32768);
        for (int i = F.tid; i < NBATCH * DM; i += 512) { const float v = c[i]; cact[i] = v / (1.f + __expf(-v)); }
        __syncthreads();
        float* mod = (float*)(F.ws + WS_MOD);
        for (int cg = blockIdx.x; cg < 256; cg += F.G) {
            const int j0 = cg * 24, ks = F.tid >> 5, jj = F.tid & 31;
            float a[8] = {0.f, 0.f, 0.f, 0.f, 0.f, 0.f, 0.f, 0.f};
            if (jj < 24) {
#pragma unroll 32
                for (int k = ks * 64; k < ks * 64 + 64; ++k) { const float w = w_ada[(size_t)k * 6 * DM + j0 + jj];
#pragma unroll
                    for (int b = 0; b < 8; ++b) a[b] += cact[b * DM + k] * w; }
            }
#pragma unroll
            for (int b = 0; b < 8; ++b) red[(ks * 8 + b) * 32 + jj] = a[b];
            __syncthreads();
            if (F.tid < 8 * 24) { const int b = F.tid / 24, j = F.tid % 24; float s = 0.f;
                for (int q = 0; q < 16; ++q) s += red[(q * 8 + b) * 32 + j];
                mod[b * 6 * DM + j0 + j] = s + b_ada[j0 + j]; }
            __syncthreads();
        }
    }
    sub_stamp(F, 10);
    {
        const int gt = blockIdx.x * 512 + F.tid, NT = F.G * 512;
        float* bperm = (float*)(F.ws + WS_BPERM); const float* b_in = F.in[5];
        for (int n = gt; n < DIN; n += NT) bperm[map_in(n)] = b_in[n];
        bf16_t* wr_hi = (bf16_t*)(F.ws + WS_WR); bf16_t* wr_lo = wr_hi + 48 * DM;
        const float* wrg = F.in[17]; const float* wre = F.in[19];
        for (int i = gt; i < 48 * DM; i += NT) { const int j = i / DM, k = i % DM; float v = 0.f;
            if (j < 4) v = wrg[k * NG + j]; else if (j < 36) v = wre[k * NE + (j - 4)];
            const unsigned h = f2bf(v); const float r = v - bf2f((unsigned short)h); wr_hi[i] = (bf16_t)h; wr_lo[i] = (bf16_t)f2bf(r); }
    }
    sub_stamp(F, 11);
    p0_convert(F, F.vcu * NWAVES + F.wave, F.G * NWAVES, 0);
}

__device__ __forceinline__ void p1_modulate(Frame& F) {
    const float* x = F.in[0]; const float* mod = (const float*)(F.ws + WS_MOD); bf16_t* H = (bf16_t*)(F.ws + WS_H);
    const int cv = F.tid & 127, rsub = F.tid >> 7, col = cv * 8;
    for (int r0 = blockIdx.x * 16; r0 < T; r0 += F.G * 16) {
        const int b = r0 / SEQ; const float* mb = mod + b * 6 * DM;
        const f32x4 s0 = *(const f32x4*)(mb + DM + col) + 1.f, s1 = *(const f32x4*)(mb + DM + col + 4) + 1.f, h0 = *(const f32x4*)(mb + col), h1 = *(const f32x4*)(mb + col + 4);
        f32x4 xa[4], xb[4];
#pragma unroll
        for (int i = 0; i < 4; ++i) { const size_t e0 = (size_t)(r0 + rsub + 4 * i) * DM + col; xa[i] = *(const f32x4*)(x + e0); xb[i] = *(const f32x4*)(x + e0 + 4); }
#pragma unroll
        for (int i = 0; i < 4; ++i) { const size_t e0 = (size_t)(r0 + rsub + 4 * i) * DM + col; const f32x4 y0 = xa[i] * s0 + h0, y1 = xb[i] * s1 + h1;
            u32x4 o; o.x = pk2(y0[0], y0[1]); o.y = pk2(y0[2], y0[3]); o.z = pk2(y1[0], y1[1]); o.w = pk2(y1[2], y1[3]);
            *(u32x4*)(H + e0) = o; }
    }
}

struct InProj {
    static constexpr bool PERM = true;
    int K, G, c; const bf16_t* A; const bf16_t* Bt; const float* bias; bf16_t* VG; bf16_t* Q; bf16_t* KV;
    __device__ __forceinline__ bool next(int i, pg8::Unit& u) const { u.e = 0; return pg8::static_next(i, G, c, T / 256, DIN / 256, u.pm, u.pn); }
    __device__ __forceinline__ const char* a_base(const pg8::Unit& u) const { return (const char*)A + (size_t)u.pm * 256 * K * 2; }
    __device__ __forceinline__ const char* b_base(const pg8::Unit& u) const { return (const char*)Bt + (size_t)u.pn * 256 * K * 2; }
    __device__ __forceinline__ void a_voff(const pg8::Unit&, const int (&R)[2], const int (&C)[2], unsigned (&v)[2][2]) const {
#pragma unroll
        for (int i = 0; i < 2; ++i) { v[0][i] = (unsigned)(R[i] * K + C[i]) * 2u; v[1][i] = v[0][i] + (unsigned)(128 * K * 2); } }
    __device__ __forceinline__ void epi(const f32x4 (&acc)[2][2][4][2], const pg8::Unit& u, int wr, int wc, int fr, int fq) const {
        const int row0 = u.pm * 256 + wr * 64 + fr; const int bcol0 = u.pn * 256 + wc * 32 + 8 * fq;
        f32x4 bv[2][2];
#pragma unroll
        for (int bj = 0; bj < 2; ++bj)
#pragma unroll
            for (int n = 0; n < 2; ++n) bv[bj][n] = *(const f32x4*)(bias + bcol0 + bj * 128 + 4 * n);
        if (u.pn < 4) {
            bf16_t* base = VG + u.pn * 128 + wc * 32 + 8 * fq;
#pragma unroll
            for (int ai = 0; ai < 2; ++ai)
#pragma unroll
                for (int m = 0; m < 4; ++m) { bf16_t* rowp = base + (size_t)(row0 + ai * 128 + m * 16) * DCONV;
                    f32x4 a0 = acc[ai][0][m][0] + bv[0][0], a1 = acc[ai][0][m][1] + bv[0][1], g0 = acc[ai][1][m][0] + bv[1][0], g1 = acc[ai][1][m][1] + bv[1][1];
#pragma unroll
                    for (int j = 0; j < 4; ++j) { a0[j] *= fast_sigmoid(g0[j]); a1[j] *= fast_sigmoid(g1[j]); }
                    u32x4 w; w.x = cvt_pk_bf16(a0[0], a0[1]); w.y = cvt_pk_bf16(a0[2], a0[3]); w.z = cvt_pk_bf16(a1[0], a1[1]); w.w = cvt_pk_bf16(a1[2], a1[3]);
                    *(u32x4*)rowp = w; }
        } else {
            const bool isq = u.pn < 6; const float sc = isq ? QSCALE : 1.f; const int ldc = isq ? DATTN : 2 * DKV;
            bf16_t* base = (isq ? Q + (u.pn - 4) * 256 : KV) + wc * 32 + 8 * fq;
#pragma unroll
            for (int ai = 0; ai < 2; ++ai)
#pragma unroll
                for (int m = 0; m < 4; ++m) { bf16_t* rowp = base + (size_t)(row0 + ai * 128 + m * 16) * ldc;
#pragma unroll
                    for (int bj = 0; bj < 2; ++bj) { const f32x4 v0 = (acc[ai][bj][m][0] + bv[bj][0]) * sc, v1 = (acc[ai][bj][m][1] + bv[bj][1]) * sc;
                        u32x4 w; w.x = cvt_pk_bf16(v0[0], v0[1]); w.y = cvt_pk_bf16(v0[2], v0[3]); w.z = cvt_pk_bf16(v1[0], v1[1]); w.w = cvt_pk_bf16(v1[2], v1[3]);
                        *(u32x4*)(rowp + bj * 128) = w; } }
        }
    }
};


template <int R> __device__ __forceinline__ void conv_rows(float (&acc)[32], const float (&w)[31], const unsigned (&vr)[62]) {
    if constexpr (R < 62) {
        const float v = __builtin_bit_cast(float, vr[R] << 16);
#pragma unroll
        for (int j = 0; j < 31; ++j) { const int o = R - j; if (o >= 0 && o < 32) acc[o] += w[j] * v; }
        conv_rows<R + 1>(acc, w, vr);
    }
}
__device__ __forceinline__ void conv_load(const bf16_t* VG, const bf16_t* zeros, int t0, int c, unsigned (&vr)[62]) {
    const int s0 = t0 % SEQ, tb = t0 - s0;
#pragma unroll
    for (int r = 0; r < 62; ++r) { const int ss = s0 - 30 + r; const bf16_t* p = ss < 0 ? zeros + c : VG + (size_t)(tb + ss) * DCONV + c; vr[r] = *p; }
}
__device__ __forceinline__ void p3_conv_all(Frame& F) {
    const bf16_t* VG = (const bf16_t*)(F.ws + WS_VG);
    const float* conv_w = F.in[6]; const float* conv_b = F.in[7]; const float* lng = F.in[8]; const float* lnb = F.in[9]; const float* outg = F.in[10];
    bf16_t* Y = (bf16_t*)(F.ws + WS_H);
    LAS float* tile = (LAS float*)(F.lds + RING_OFF);
    const int c = F.tid; const int NU = T / 32;
    int u = blockIdx.x; if (u >= NU) return;
    float w[31];
#pragma unroll
    for (int j = 0; j < 31; ++j) w[j] = conv_w[j * DCONV + c];
    const float cb = conv_b[c];
    const bf16_t* zeros = (const bf16_t*)(F.ws + WS_CTL + 512 * 1024);
    unsigned vin[62]; conv_load(VG, zeros, 32 * u, c, vin);
#pragma unroll
    for (int r = 0; r < 62; ++r) asm volatile("" : "+v"(vin[r]));
    for (;;) {
        const int t0 = 32 * u; const int un = u + F.G; const bool has = un < NU;
        unsigned vnx[62];
        if (has) conv_load(VG, zeros, 32 * un, c, vnx);
        float acc[32];
#pragma unroll
        for (int o = 0; o < 32; ++o) acc[o] = cb;
        conv_rows<0>(acc, w, vin);
#pragma unroll
        for (int o = 0; o < 32; ++o) tile[o * 516 + c] = acc[o];
        __syncthreads();
        {
            const int c8 = F.lane * 8;
            const f32x4 g0 = *(const f32x4*)(lng + c8), g1 = *(const f32x4*)(lng + c8 + 4), b0 = *(const f32x4*)(lnb + c8), b1 = *(const f32x4*)(lnb + c8 + 4), og0 = *(const f32x4*)(outg + c8), og1 = *(const f32x4*)(outg + c8 + 4);
#pragma unroll
            for (int i = 0; i < 4; ++i) { const int o = F.wave * 4 + i;
                f32x4 v0 = *(const LAS f32x4*)(tile + o * 516 + c8), v1 = *(const LAS f32x4*)(tile + o * 516 + c8 + 4);
                const float mean = wave_sum((v0[0] + v0[1]) + (v0[2] + v0[3]) + (v1[0] + v1[1]) + (v1[2] + v1[3])) * (1.f / DCONV);
                v0 = v0 - mean; v1 = v1 - mean;
                const float var = wave_sum((v0[0] * v0[0] + v0[1] * v0[1]) + (v0[2] * v0[2] + v0[3] * v0[3]) + (v1[0] * v1[0] + v1[1] * v1[1]) + (v1[2] * v1[2] + v1[3] * v1[3])) * (1.f / DCONV);
                const float rstd = rsqrtf(var + EPS);
                v0 = v0 * rstd * g0 + b0; v1 = v1 * rstd * g1 + b1;
                float q = 0.f;
#pragma unroll
                for (int j = 0; j < 4; ++j) { v0[j] = fast_silu(v0[j]); v1[j] = fast_silu(v1[j]); q += v0[j] * v0[j] + v1[j] * v1[j]; }
                q = group8_sum(q);
                const float r2 = rsqrtf(q * (1.f / 64.f) + EPS);
                v0 = v0 * r2 * og0; v1 = v1 * r2 * og1;
                u32x4 ow; ow.x = pk2(v0[0], v0[1]); ow.y = pk2(v0[2], v0[3]); ow.z = pk2(v1[0], v1[1]); ow.w = pk2(v1[2], v1[3]);
                *(u32x4*)(Y + (size_t)(t0 + o) * DM + c8) = ow; }
        }
        __syncthreads();
        if (!has) break;
        u = un;
#pragma unroll
        for (int r = 0; r < 62; ++r) vin[r] = vnx[r];
    }
}

namespace att {
constexpr int KCH = 4112;
constexpr int L_K = 0, L_V = 8 * KCH, L_O = L_V + 32768, OST = 8704, L_WS = L_O + 8 * OST, L_END = L_WS + 8 * 128;
static_assert(L_END <= RING_BYTES, "attention LDS");
typedef short s16x4 __attribute__((ext_vector_type(4)));
typedef float f32x16 __attribute__((ext_vector_type(16)));
typedef short v4i16_t __attribute__((ext_vector_type(4)));
__device__ __forceinline__ int crow(int r, int hi) { return (r & 3) + 8 * (r >> 2) + 4 * hi; }
__device__ __forceinline__ s16x4 vtr(const LAS unsigned char* p) { return __builtin_bit_cast(s16x4, __builtin_amdgcn_ds_read_tr16_b64_v4i16((LAS v4i16_t*)p)); }

__device__ __forceinline__ void attn_unit(Frame& F, int b, int kvh, int blk) {
    const bf16_t* Q = (const bf16_t*)(F.ws + WS_Q); const bf16_t* KV = (const bf16_t*)(F.ws + WS_KV); bf16_t* Y = (bf16_t*)(F.ws + WS_H);
    const float* sinks = F.in[11]; const float* outg = F.in[12];
    LAS unsigned char* lds = F.lds + RING_OFF;
    const int lane = F.lane, r32 = lane & 31, hi = lane >> 5, wave = F.wave;
    const int t0 = b * SEQ + blk * 128;
    bf16x8 qrr[2][4];
#pragma unroll
    for (int wi = 0; wi < 2; ++wi) { const int wu = wave + 8 * wi, hq = wu >> 2, sub = wu & 3;
        const bf16_t* qrow = Q + (size_t)(t0 + 32 * sub + r32) * DATTN + (kvh * 4 + hq) * 64 + hi * 8;
#pragma unroll
        for (int s = 0; s < 4; ++s) qrr[wi][s] = *(const bf16x8*)(qrow + 16 * s); }
    {
        u32x4 kq[4], vq[4];
#pragma unroll
        for (int i = 0; i < 4; ++i) { const int p = F.tid + 512 * i, key = p >> 3, ch = p & 7; const bool valid = (blk > 0) || key >= 128;
            const int tk = valid ? t0 - 128 + key : t0;
            const bf16_t* gk = KV + (size_t)tk * 256 + kvh * 64 + ch * 8;
            kq[i] = *(const u32x4*)gk; vq[i] = *(const u32x4*)(gk + 128);
            if (!valid) { kq[i] = (u32x4){0u, 0u, 0u, 0u}; vq[i] = kq[i]; } }
#pragma unroll
        for (int i = 0; i < 4; ++i) { const int p = F.tid + 512 * i, key = p >> 3, ch = p & 7;
            *(LAS u32x4*)(lds + L_K + ch * KCH + key * 16) = kq[i];
            *(LAS u32x4*)(lds + L_V + (key >> 6) * 8192 + ((ch >> 2) * 4 + ((key & 63) >> 4)) * 1024 + (key & 15) * 64 + (ch & 3) * 16) = vq[i]; }
    }
    __syncthreads();
    const int vlane = (4 * hi + ((lane & 15) >> 2)) * 64 + ((lane >> 4) & 1) * 32 + (lane & 3) * 8;
#pragma unroll
    for (int wi = 0; wi < 2; ++wi) {
        const int wu = wave + 8 * wi, hq = wu >> 2, sub = wu & 3, i0 = 32 * sub, h = kvh * 4 + hq;
        bf16x8 qr[4];
#pragma unroll
        for (int s = 0; s < 4; ++s) qr[s] = qrr[wi][s];
        f32x16 st[5];
#pragma unroll
        for (int t = 0; t < 5; ++t) {
#pragma unroll
            for (int r = 0; r < 16; ++r) st[t][r] = 0.f;
#pragma unroll
            for (int s = 0; s < 4; ++s) { const bf16x8 kf = *(const LAS bf16x8*)(lds + L_K + (2 * s + hi) * KCH + (i0 + 32 * t + r32) * 16);
                st[t] = __builtin_amdgcn_mfma_f32_32x32x16_bf16(kf, qr[s], st[t], 0, 0, 0); } }
        const float sinkl = sinks[h] * LOG2E;
        float m = sinkl;
#pragma unroll
        for (int t = 0; t < 5; ++t)
#pragma unroll
            for (int r = 0; r < 16; ++r) { const int cj = crow(r, hi); bool ok = true;
                if (t == 0) ok = cj >= r32 + 1; if (t == 4) ok = cj <= r32;
                if (blk == 0) ok = ok && (i0 + 32 * t + cj >= 128);
                const float v = ok ? st[t][r] : -1e30f; st[t][r] = v; m = fmaxf(m, v); }
        m = fmaxf(m, __shfl_xor(m, 32));
        float l = 0.f;
#pragma unroll
        for (int t = 0; t < 5; ++t)
#pragma unroll
            for (int r = 0; r < 16; ++r) { const float pv = __builtin_amdgcn_exp2f(st[t][r] - m); st[t][r] = pv; l += pv; }
        l += __shfl_xor(l, 32); l += __builtin_amdgcn_exp2f(sinkl - m);
        f32x16 o[2];
#pragma unroll
        for (int r = 0; r < 16; ++r) { o[0][r] = 0.f; o[1][r] = 0.f; }
#pragma unroll
        for (int t = 0; t < 5; ++t)
#pragma unroll
            for (int s2 = 0; s2 < 2; ++s2) {
                u32x4 pw; pw.x = cvt_pk_bf16(st[t][8 * s2 + 0], st[t][8 * s2 + 1]); pw.y = cvt_pk_bf16(st[t][8 * s2 + 2], st[t][8 * s2 + 3]); pw.z = cvt_pk_bf16(st[t][8 * s2 + 4], st[t][8 * s2 + 5]); pw.w = cvt_pk_bf16(st[t][8 * s2 + 6], st[t][8 * s2 + 7]);
                const bf16x8 pa = __builtin_bit_cast(bf16x8, pw);
                const int kk0 = i0 + 32 * t + 16 * s2, g = kk0 >> 6, pc = (kk0 & 63) >> 4;
#pragma unroll
                for (int d0 = 0; d0 < 2; ++d0) { const LAS unsigned char* vb = lds + L_V + g * 8192 + (d0 * 4 + pc) * 1024 + vlane;
                    const s16x4 lo = vtr(vb), hh = vtr(vb + 512);
                    const bf16x8 vf = (bf16x8){lo[0], lo[1], lo[2], lo[3], hh[0], hh[1], hh[2], hh[3]};
                    o[d0] = __builtin_amdgcn_mfma_f32_32x32x16_bf16(pa, vf, o[d0], 0, 0, 0); } }
        LAS float* wsf = (LAS float*)(lds + L_WS + wave * 128);
        LAS float* ost = (LAS float*)(lds + L_O + wave * OST);
        if (hi == 0) wsf[r32] = l;
#pragma unroll
        for (int r = 0; r < 16; ++r) { const int q = crow(r, hi); ost[q * 68 + r32] = o[0][r]; ost[q * 68 + 32 + r32] = o[1][r]; }
        LDS_WAIT(); asm volatile("" ::: "memory");
        { const int q = lane >> 1, half = lane & 1; const float rl = 1.f / wsf[q];
          f32x4 v[8]; float ss = 0.f;
#pragma unroll
          for (int j = 0; j < 8; ++j) { v[j] = *(const LAS f32x4*)(ost + q * 68 + half * 32 + 4 * j) * rl; ss += (v[j][0] * v[j][0] + v[j][1] * v[j][1]) + (v[j][2] * v[j][2] + v[j][3] * v[j][3]); }
          ss += __shfl_xor(ss, 1);
          const float rr = rsqrtf(ss * (1.f / 64.f) + EPS);
          const float* gp = outg + h * 64 + half * 32; bf16_t* yp = Y + (size_t)(t0 + i0 + q) * DM + DCONV + h * 64 + half * 32;
#pragma unroll
          for (int j = 0; j < 4; ++j) { const f32x4 a = v[2 * j] * rr * *(const f32x4*)(gp + 8 * j), c2 = v[2 * j + 1] * rr * *(const f32x4*)(gp + 8 * j + 4);
              u32x4 ow; ow.x = pk2(a[0], a[1]); ow.y = pk2(a[2], a[3]); ow.z = pk2(c2[0], c2[1]); ow.w = pk2(c2[2], c2[3]);
              *(u32x4*)(yp + 8 * j) = ow; } }
        LDS_WAIT(); asm volatile("" ::: "memory");
    }
    __syncthreads();
}
}

__device__ __forceinline__ void p3_attn_only(Frame& F) {
    for (int u = blockIdx.x; u < NBATCH * NKV * (SEQ / 128); u += F.G) { const int blk = u & 31, kvh = (u >> 5) & 1, b = u >> 6; att::attn_unit(F, b, kvh, blk); }
}
__device__ __forceinline__ void p3_conv_only(Frame& F) {
    p3_conv_all(F);
}
__device__ __forceinline__ void p3_mixers(Frame& F) {
#ifndef SKIP_ATTN
    for (int u = blockIdx.x; u < NBATCH * NKV * (SEQ / 128); u += F.G) { const int blk = u & 31, kvh = (u >> 5) & 1, b = u >> 6; att::attn_unit(F, b, kvh, blk); }
#endif
    sub_stamp(F, 13);
#ifndef SKIP_CONV
    p3_conv_all(F);
#endif
    sub_stamp(F, 14);
}

struct OutProj {
    static constexpr bool PERM = true;
    int K, G, c; const bf16_t* A; const bf16_t* Bt; const float* bo; bf16_t* MIX;
    __device__ __forceinline__ bool next(int i, pg8::Unit& u) const { u.e = 0; return pg8::static_next(i, G, c, T / 256, DM / 256, u.pm, u.pn); }
    __device__ __forceinline__ const char* a_base(const pg8::Unit& u) const { return (const char*)A + (size_t)u.pm * 256 * K * 2; }
    __device__ __forceinline__ const char* b_base(const pg8::Unit& u) const { return (const char*)Bt + (size_t)u.pn * 256 * K * 2; }
    __device__ __forceinline__ void a_voff(const pg8::Unit&, const int (&R)[2], const int (&C)[2], unsigned (&v)[2][2]) const {
#pragma unroll
        for (int i = 0; i < 2; ++i) { v[0][i] = (unsigned)(R[i] * K + C[i]) * 2u; v[1][i] = v[0][i] + (unsigned)(128 * K * 2); } }
    __device__ __forceinline__ void epi(const f32x4 (&acc)[2][2][4][2], const pg8::Unit& u, int wr, int wc, int fr, int fq) const {
        const int row0 = u.pm * 256 + wr * 64 + fr; const int col0 = u.pn * 256 + wc * 32 + 8 * fq;
        f32x4 bv[2][2];
#pragma unroll
        for (int bj = 0; bj < 2; ++bj)
#pragma unroll
            for (int n = 0; n < 2; ++n) bv[bj][n] = *(const f32x4*)(bo + col0 + bj * 128 + 4 * n);
#pragma unroll
        for (int ai = 0; ai < 2; ++ai)
#pragma unroll
            for (int m = 0; m < 4; ++m) { bf16_t* rowp = MIX + (size_t)(row0 + ai * 128 + m * 16) * DM + col0;
#pragma unroll
                for (int bj = 0; bj < 2; ++bj) { const f32x4 v0 = acc[ai][bj][m][0] + bv[bj][0], v1 = acc[ai][bj][m][1] + bv[bj][1];
                    u32x4 w; w.x = cvt_pk_bf16(v0[0], v0[1]); w.y = cvt_pk_bf16(v0[2], v0[3]); w.z = cvt_pk_bf16(v1[0], v1[1]); w.w = cvt_pk_bf16(v1[2], v1[3]);
                    *(u32x4*)(rowp + bj * 128) = w; } }
    }
};

constexpr int TAB_OFF = LDSCTL_OFF + 1024;
__device__ __forceinline__ void build_route_table(Frame& F) {
    volatile LAS int* tab = (volatile LAS int*)(F.lds + TAB_OFF);
    if (F.tid == 0) { int tp = 0;
        for (int e = 0; e < NE; ++e) { const int cn = (int)__hip_atomic_load(F.ctl + CW_ECNT + 64 * e, RLX_AGENT); tab[e] = cn; tab[32 + e] = tp; tp += (cn + 255) >> 8; }
        tab[64] = tp; }
    __syncthreads();
}

__device__ __forceinline__ void p5_rows(Frame& F) {
    float* X = F.out; const float* xin = F.in[0]; const bf16_t* MIX = (const bf16_t*)(F.ws + WS_MIX); bf16_t* H2 = (bf16_t*)(F.ws + WS_H2);
    const float* ln_g = F.in[15]; const float* ln_b = F.in[16]; const float* mod = (const float*)(F.ws + WS_MOD);
    const bf16_t* wr_hi = (const bf16_t*)(F.ws + WS_WR); const bf16_t* wr_lo = wr_hi + 48 * DM;
    const float* brg = F.in[18]; const float* bre = F.in[20];
    int* list = (int*)(F.ws + WS_LIST); unsigned* tokrec = (unsigned*)(F.ws + WS_TOK);
    LAS float* lg = (LAS float*)(F.lds + RING_OFF + F.wave * 3072);
    volatile LAS int* lcnt = (volatile LAS int*)(F.lds + RING_OFF + 24576);
    const int lane = F.lane, i16 = lane & 15, kq = lane >> 4;
    for (int tile = blockIdx.x; tile < T / 128; tile += F.G) {
        if (F.tid < 64) lcnt[F.tid] = 0;
        __syncthreads();
        const int rbase = tile * 128 + F.wave * 16; const int b = (tile * 128) / SEQ;
        const float* sc2 = mod + b * 6 * DM + 4 * DM; const float* sh2 = mod + b * 6 * DM + 3 * DM;
        {
            const float* g1 = mod + b * 6 * DM + 2 * DM;
            f32x4 gg[4], lgv[4], lbv[4], scv[4], shv[4];
#pragma unroll
            for (int j = 0; j < 4; ++j) { const int col = 4 * lane + 256 * j; gg[j] = *(const f32x4*)(g1 + col); lgv[j] = *(const f32x4*)(ln_g + col); lbv[j] = *(const f32x4*)(ln_b + col);
                scv[j] = *(const f32x4*)(sc2 + col) + 1.f; shv[j] = *(const f32x4*)(sh2 + col); }
#pragma unroll 1
            for (int rb = 0; rb < 16; rb += 2) {
                f32x4 z[2][4]; u32x2 mv[2][4];
#pragma unroll
                for (int r = 0; r < 2; ++r)
#pragma unroll
                    for (int j = 0; j < 4; ++j) { const size_t o = (size_t)(rbase + rb + r) * DM + 4 * lane + 256 * j; z[r][j] = *(const f32x4*)(xin + o); mv[r][j] = *(const u32x2*)(MIX + o); }
                float sm[2];
#pragma unroll
                for (int r = 0; r < 2; ++r) { sm[r] = 0.f;
#pragma unroll
                    for (int j = 0; j < 4; ++j) { f32x4 m4; m4[0] = __builtin_bit_cast(float, mv[r][j].x << 16); m4[1] = __builtin_bit_cast(float, mv[r][j].x & 0xffff0000u); m4[2] = __builtin_bit_cast(float, mv[r][j].y << 16); m4[3] = __builtin_bit_cast(float, mv[r][j].y & 0xffff0000u);
                        z[r][j] = z[r][j] * ALPHA + gg[j] * m4; sm[r] += (z[r][j][0] + z[r][j][1]) + (z[r][j][2] + z[r][j][3]); } }
#pragma unroll
                for (int r = 0; r < 2; ++r) sm[r] = wave_sum(sm[r]);
                float sq[2];
#pragma unroll
                for (int r = 0; r < 2; ++r) { const float mean = sm[r] * (1.f / DM); sq[r] = 0.f;
#pragma unroll
                    for (int j = 0; j < 4; ++j) { z[r][j] = z[r][j] - mean; sq[r] += (z[r][j][0] * z[r][j][0] + z[r][j][1] * z[r][j][1]) + (z[r][j][2] * z[r][j][2] + z[r][j][3] * z[r][j][3]); } }
#pragma unroll
                for (int r = 0; r < 2; ++r) sq[r] = wave_sum(sq[r]);
#pragma unroll
                for (int r = 0; r < 2; ++r) { const float rstd = rsqrtf(sq[r] * (1.f / DM) + EPS);
#pragma unroll
                    for (int j = 0; j < 4; ++j) { const size_t o = (size_t)(rbase + rb + r) * DM + 4 * lane + 256 * j; const f32x4 x1 = z[r][j] * rstd * lgv[j] + lbv[j];
                        *(f32x4*)(X + o) = x1; const f32x4 t = x1 * scv[j] + shv[j];
                        u32x2 hw; hw.x = pk2(t[0], t[1]); hw.y = pk2(t[2], t[3]); *(u32x2*)(H2 + o) = hw; } }
            }
            asm volatile("s_waitcnt vmcnt(0)" ::: "memory");
        }
        const int row = rbase + i16;
        f32x4 acc[3];
#pragma unroll
        for (int ct = 0; ct < 3; ++ct) acc[ct] = (f32x4){0.f, 0.f, 0.f, 0.f};
        { const bf16_t* hr = H2 + (size_t)row * DM + 8 * kq; const bf16_t* wp = wr_hi + (size_t)i16 * DM + 8 * kq;
#pragma unroll 1
          for (int kc = 0; kc < DM; kc += 128) {
              bf16x8 ah[4], bh[4][3];
#pragma unroll
              for (int u = 0; u < 4; ++u) { ah[u] = *(const bf16x8*)(hr + kc + 32 * u);
#pragma unroll
                  for (int ct = 0; ct < 3; ++ct) bh[u][ct] = *(const bf16x8*)(wp + (size_t)(16 * ct) * DM + kc + 32 * u); }
#pragma unroll
              for (int u = 0; u < 4; ++u)
#pragma unroll
                  for (int ct = 0; ct < 3; ++ct) acc[ct] = __builtin_amdgcn_mfma_f32_16x16x32_bf16(ah[u], bh[u][ct], acc[ct], 0, 0, 0);
          } }
#pragma unroll
        for (int ct = 0; ct < 3; ++ct)
#pragma unroll
            for (int r = 0; r < 4; ++r) lg[(4 * kq + r) * 48 + 16 * ct + i16] = acc[ct][r];
        LDS_WAIT(); asm volatile("" ::: "memory");
        int e1 = 0, e2 = 0, rk1 = 0, rk2 = 0; float w1 = 0.f, w2 = 0.f;
        if (lane < 16) {
            const LAS float* L = lg + lane * 48;
            float gl[4];
#pragma unroll
            for (int j = 0; j < 4; ++j) gl[j] = L[j] + brg[j];
            int gi = 0; float gm = gl[0];
#pragma unroll
            for (int j = 1; j < 4; ++j) if (gl[j] > gm) { gm = gl[j]; gi = j; }
            float gs = 0.f;
#pragma unroll
            for (int j = 0; j < 4; ++j) gs += __expf(gl[j] - gm);
            const float ptop = 1.f / gs;
            float el[8];
#pragma unroll
            for (int j = 0; j < 8; ++j) el[j] = L[4 + gi * 8 + j] + bre[gi * 8 + j];
            int i1 = 0; float m1 = el[0];
#pragma unroll
            for (int j = 1; j < 8; ++j) if (el[j] > m1) { m1 = el[j]; i1 = j; }
            int i2 = -1; float m2 = -3e38f;
#pragma unroll
            for (int j = 0; j < 8; ++j) if (j != i1 && el[j] > m2) { m2 = el[j]; i2 = j; }
            const float pb = __expf(m2 - m1), inv = ptop / (1.f + pb);
            e1 = gi * 8 + i1; e2 = gi * 8 + i2; w1 = inv; w2 = pb * inv;
            rk1 = __hip_atomic_fetch_add((LAS int*)lcnt + e1, 1, __ATOMIC_RELAXED, __HIP_MEMORY_SCOPE_WORKGROUP);
            rk2 = __hip_atomic_fetch_add((LAS int*)lcnt + e2, 1, __ATOMIC_RELAXED, __HIP_MEMORY_SCOPE_WORKGROUP);
        }
        __syncthreads();
        if (F.tid < 32) { const int n = lcnt[F.tid]; int base = 0; if (n > 0) base = (int)__hip_atomic_fetch_add(F.ctl + CW_ECNT + 64 * F.tid, (unsigned)n, RLX_AGENT); lcnt[32 + F.tid] = base; }
        __syncthreads();
        if (lane < 16) { const int tok = tile * 128 + F.wave * 16 + lane; const int s1 = lcnt[32 + e1] + rk1, s2 = lcnt[32 + e2] + rk2;
            list[(size_t)e1 * T + s1] = tok; list[(size_t)e2 * T + s2] = tok;
            u32x4 r0; r0.x = (unsigned)e1; r0.y = (unsigned)s1; r0.z = (unsigned)e2; r0.w = (unsigned)s2;
            u32x4 r1; r1.x = __builtin_bit_cast(unsigned, w1); r1.y = __builtin_bit_cast(unsigned, w2); r1.z = 0u; r1.w = 0u;
            *(u32x4*)(tokrec + (size_t)tok * 8) = r0; *(u32x4*)(tokrec + (size_t)tok * 8 + 4) = r1; }
        __syncthreads();
    }
}

__device__ __forceinline__ bool moe_next(const volatile LAS int* tab, int i, int G, int c, int NT, pg8::Unit& u) {
    const int nwg = tab[64] * NT; const long L = (long)i * G + c; if (L >= nwg) return false;
    int wgid = (int)L; { const int q = nwg / 8, r = nwg % 8, xcd = wgid % 8, off = wgid / 8; wgid = (xcd < r ? xcd * (q + 1) : r * (q + 1) + (xcd - r) * q) + off; }
    const int mtg = wgid / NT; int e = 0;
    for (int k = 1; k < NE; ++k) e += (tab[32 + k] <= mtg) ? 1 : 0;
    u.e = __builtin_amdgcn_readfirstlane(e); u.pm = __builtin_amdgcn_readfirstlane(mtg - tab[32 + e]); u.pn = __builtin_amdgcn_readfirstlane(wgid % NT); return true;
}
struct MoeUp {
    static constexpr bool PERM = true;
    int K, G, c; const volatile LAS int* tab; const bf16_t* H2; const bf16_t* WGU; const int* list; bf16_t* ACT;
    __device__ __forceinline__ bool next(int i, pg8::Unit& u) const { return moe_next(tab, i, G, c, 2, u); }
    __device__ __forceinline__ const char* a_base(const pg8::Unit&) const { return (const char*)H2; }
    __device__ __forceinline__ const char* b_base(const pg8::Unit& u) const { return (const char*)WGU + ((size_t)u.e * 512 + u.pn * 256) * K * 2; }
    __device__ __forceinline__ void a_voff(const pg8::Unit& u, const int (&R)[2], const int (&C)[2], unsigned (&v)[2][2]) const {
        const int cn = tab[u.e]; const int* lp = list + (size_t)u.e * T;
#pragma unroll
        for (int h = 0; h < 2; ++h)
#pragma unroll
            for (int i = 0; i < 2; ++i) { const int idx = u.pm * 256 + h * 128 + R[i]; const int tok = lp[idx < cn ? idx : 0]; v[h][i] = (unsigned)(tok * K + C[i]) * 2u; } }
    __device__ __forceinline__ void epi(const f32x4 (&acc)[2][2][4][2], const pg8::Unit& u, int wr, int wc, int fr, int fq) const {
        const int row0 = tab[32 + u.e] * 256 + u.pm * 256 + wr * 64 + fr;
        bf16_t* base = ACT + u.pn * 128 + wc * 32 + 8 * fq;
#pragma unroll
        for (int ai = 0; ai < 2; ++ai)
#pragma unroll
            for (int m = 0; m < 4; ++m) { bf16_t* rowp = base + (size_t)(row0 + ai * 128 + m * 16) * DE;
                f32x4 g0 = acc[ai][0][m][0], g1 = acc[ai][0][m][1]; const f32x4 u0 = acc[ai][1][m][0], u1 = acc[ai][1][m][1];
#pragma unroll
                for (int j = 0; j < 4; ++j) { g0[j] = fast_silu(g0[j]) * u0[j]; g1[j] = fast_silu(g1[j]) * u1[j]; }
                u32x4 w; w.x = cvt_pk_bf16(g0[0], g0[1]); w.y = cvt_pk_bf16(g0[2], g0[3]); w.z = cvt_pk_bf16(g1[0], g1[1]); w.w = cvt_pk_bf16(g1[2], g1[3]);
                *(u32x4*)rowp = w; }
    }
};
struct MoeDown {
    static constexpr bool PERM = true;
    int K, G, c; const volatile LAS int* tab; const bf16_t* ACT; const bf16_t* WD; bf16_t* YS;
    __device__ __forceinline__ bool next(int i, pg8::Unit& u) const { return moe_next(tab, i, G, c, 4, u); }
    __device__ __forceinline__ const char* a_base(const pg8::Unit& u) const { return (const char*)ACT + ((size_t)tab[32 + u.e] * 256 + u.pm * 256) * K * 2; }
    __device__ __forceinline__ const char* b_base(const pg8::Unit& u) const { return (const char*)WD + ((size_t)u.e * DM + u.pn * 256) * K * 2; }
    __device__ __forceinline__ void a_voff(const pg8::Unit&, const int (&R)[2], const int (&C)[2], unsigned (&v)[2][2]) const {
#pragma unroll
        for (int i = 0; i < 2; ++i) { v[0][i] = (unsigned)(R[i] * K + C[i]) * 2u; v[1][i] = v[0][i] + (unsigned)(128 * K * 2); } }
    __device__ __forceinline__ void epi(const f32x4 (&acc)[2][2][4][2], const pg8::Unit& u, int wr, int wc, int fr, int fq) const {
        const int row0 = tab[32 + u.e] * 256 + u.pm * 256 + wr * 64 + fr;
        bf16_t* base = YS + u.pn * 256 + wc * 32 + 8 * fq;
#pragma unroll
        for (int ai = 0; ai < 2; ++ai)
#pragma unroll
            for (int m = 0; m < 4; ++m) { bf16_t* rowp = base + (size_t)(row0 + ai * 128 + m * 16) * DM;
#pragma unroll
                for (int bj = 0; bj < 2; ++bj) { const f32x4 v0 = acc[ai][bj][m][0], v1 = acc[ai][bj][m][1];
                    u32x4 w; w.x = cvt_pk_bf16(v0[0], v0[1]); w.y = cvt_pk_bf16(v0[2], v0[3]); w.z = cvt_pk_bf16(v1[0], v1[1]); w.w = cvt_pk_bf16(v1[2], v1[3]);
                    *(u32x4*)(rowp + bj * 128) = w; } }
    }
};

__device__ __forceinline__ void p8_final(Frame& F) {
    float* X = F.out; const bf16_t* YS = (const bf16_t*)(F.ws + WS_YS); const unsigned* tokrec = (const unsigned*)(F.ws + WS_TOK);
    const float* mod = (const float*)(F.ws + WS_MOD); const float* lg = F.in[24]; const float* lb = F.in[25];
    volatile LAS int* tab = (volatile LAS int*)(F.lds + TAB_OFF);
    const int lane = F.lane; const int gw = blockIdx.x * NWAVES + F.wave, NGW = F.G * NWAVES;
    f32x4 lgv[4], lbv[4];
#pragma unroll
    for (int j = 0; j < 4; ++j) { const int col = 4 * lane + 256 * j; lgv[j] = *(const f32x4*)(lg + col); lbv[j] = *(const f32x4*)(lb + col); }
#pragma unroll 1
    for (int base = gw; base < T; base += 2 * NGW) {
        int tr[2]; bool ok[2]; u32x4 r0[2]; u32x2 r1[2];
#pragma unroll
        for (int r = 0; r < 2; ++r) { const int t = base + r * NGW; ok[r] = t < T; tr[r] = ok[r] ? t : base; r0[r] = *(const u32x4*)(tokrec + (size_t)tr[r] * 8); r1[r] = *(const u32x2*)(tokrec + (size_t)tr[r] * 8 + 4); }
        f32x4 z[2][4]; u32x2 ya[2][4], yb[2][4]; float w1[2], w2[2]; f32x4 gv[2][4];
#pragma unroll
        for (int r = 0; r < 2; ++r) {
            const int e1 = __builtin_amdgcn_readfirstlane((int)r0[r].x), s1 = __builtin_amdgcn_readfirstlane((int)r0[r].y), e2 = __builtin_amdgcn_readfirstlane((int)r0[r].z), s2 = __builtin_amdgcn_readfirstlane((int)r0[r].w);
            w1[r] = __builtin_bit_cast(float, __builtin_amdgcn_readfirstlane(r1[r].x)); w2[r] = __builtin_bit_cast(float, __builtin_amdgcn_readfirstlane(r1[r].y));
            const size_t ra = (size_t)(tab[32 + e1] * 256 + s1), rb = (size_t)(tab[32 + e2] * 256 + s2);
            const float* g2 = mod + (tr[r] / SEQ) * 6 * DM + 5 * DM;
#pragma unroll
            for (int j = 0; j < 4; ++j) { const int col = 4 * lane + 256 * j;
                z[r][j] = *(const f32x4*)(X + (size_t)tr[r] * DM + col); gv[r][j] = *(const f32x4*)(g2 + col);
                ya[r][j] = *(const u32x2*)(YS + ra * DM + col); yb[r][j] = *(const u32x2*)(YS + rb * DM + col); } }
        float sm[2];
#pragma unroll
        for (int r = 0; r < 2; ++r) { sm[r] = 0.f;
#pragma unroll
            for (int j = 0; j < 4; ++j) { f32x4 f;
                f[0] = w1[r] * __builtin_bit_cast(float, ya[r][j].x << 16) + w2[r] * __builtin_bit_cast(float, yb[r][j].x << 16);
                f[1] = w1[r] * __builtin_bit_cast(float, ya[r][j].x & 0xffff0000u) + w2[r] * __builtin_bit_cast(float, yb[r][j].x & 0xffff0000u);
                f[2] = w1[r] * __builtin_bit_cast(float, ya[r][j].y << 16) + w2[r] * __builtin_bit_cast(float, yb[r][j].y << 16);
                f[3] = w1[r] * __builtin_bit_cast(float, ya[r][j].y & 0xffff0000u) + w2[r] * __builtin_bit_cast(float, yb[r][j].y & 0xffff0000u);
                z[r][j] = z[r][j] * ALPHA + gv[r][j] * f; sm[r] += (z[r][j][0] + z[r][j][1]) + (z[r][j][2] + z[r][j][3]); } }
#pragma unroll
        for (int r = 0; r < 2; ++r) sm[r] = wave_sum(sm[r]);
        float sq[2];
#pragma unroll
        for (int r = 0; r < 2; ++r) { const float mean = sm[r] * (1.f / DM); sq[r] = 0.f;
#pragma unroll
            for (int j = 0; j < 4; ++j) { z[r][j] = z[r][j] - mean; sq[r] += (z[r][j][0] * z[r][j][0] + z[r][j][1] * z[r][j][1]) + (z[r][j][2] * z[r][j][2] + z[r][j][3] * z[r][j][3]); } }
#pragma unroll
        for (int r = 0; r < 2; ++r) sq[r] = wave_sum(sq[r]);
#pragma unroll
        for (int r = 0; r < 2; ++r) { const float rstd = rsqrtf(sq[r] * (1.f / DM) + EPS);
            if (ok[r]) {
#pragma unroll
                for (int j = 0; j < 4; ++j) { const int col = 4 * lane + 256 * j; *(f32x4*)(X + (size_t)tr[r] * DM + col) = z[r][j] * rstd * lgv[j] + lbv[j]; } } }
    }
}

__global__ void __launch_bounds__(NWAVES * 64, 2) mega_fwd(Args args) {
    extern __shared__ __attribute__((aligned(16))) unsigned char lds[];
    Frame F;
    F.lds = (LAS unsigned char*)lds;
    F.MISC = (volatile LAS unsigned*)(F.lds + MISC_OFF);
    F.tid = threadIdx.x; F.lane = F.tid & 63; F.wave = __builtin_amdgcn_readfirstlane(F.tid >> 6);
    F.G = gridDim.x; { const int bx = blockIdx.x; F.vcu = (F.G % 8 == 0) ? (bx % 8) * (F.G / 8) + bx / 8 : bx; }
    F.ws = args.ws; F.out = args.out; F.ctl = (gu32*)(args.ws + WS_CTL);
#pragma unroll
    for (int i = 0; i < 26; ++i) F.in[i] = args.in[i];
    for (int u = F.tid; u < (LDS_BYTES - LDSCTL_OFF) / 4; u += NWAVES * 64) ((LAS unsigned*)(F.lds + LDSCTL_OFF))[u] = 0u;
    __syncthreads();
    XcdBarrier bar = xcd_barrier_post((unsigned*)(F.ctl + CW_BAR), F.MISC + 8);
    volatile LAS unsigned* TS = (volatile LAS unsigned*)(F.lds + LDSCTL_OFF + 2048);
#define STAMP(k) do { if (DIAG && blockIdx.x == 0 && F.tid == 0) TS[k] = (unsigned)__builtin_amdgcn_s_memrealtime(); } while (0)
    STAMP(0);
    const int lo = args.ph_lo, hi = args.ph_hi;
#define IN(k) (lo <= (k) && (k) < hi)
#define BOTH(k) (IN(k) && IN((k) + 1))
    if (IN(0)) { p0_prologue(F); sub_stamp(F, 12); if (DUP_PHASE == 0) { xcd_barrier(bar); p0_prologue(F); } if (BOTH(0)) xcd_barrier(bar); STAMP(1); }
    if (IN(1)) { p1_modulate(F); if (DUP_PHASE == 1) { xcd_barrier(bar); p1_modulate(F); } if (BOTH(1)) xcd_barrier(bar); STAMP(2); }
    if (IN(2)) {
        InProj S; S.K = DM; S.G = F.G; S.c = (int)blockIdx.x; S.A = (const bf16_t*)(F.ws + WS_H); S.Bt = (const bf16_t*)(F.ws + WS_WI); S.bias = (const float*)(F.ws + WS_BPERM);
        S.VG = (bf16_t*)(F.ws + WS_VG); S.Q = (bf16_t*)(F.ws + WS_Q); S.KV = (bf16_t*)(F.ws + WS_KV);
        pg8::gemm_phase<InProj>(F.lds + RING_OFF, S);
        if (DUP_PHASE == 2) { xcd_barrier(bar); pg8::gemm_phase<InProj>(F.lds + RING_OFF, S); }
        {
            const int nwg = (T / 256) * (DIN / 256), G = F.G, c = (int)blockIdx.x; const int maxu = (nwg + G - 1) / G; const int full = nwg - (maxu - 1) * G;
            const int nlight = (full == G) ? 0 : G - full;
            if (nlight == 0) p0_convert(F, c * NWAVES + F.wave, G * NWAVES, 1);
            else if (c >= full) p0_convert(F, (c - full) * NWAVES + F.wave, nlight * NWAVES, 1);
        }
        if (BOTH(2)) xcd_barrier(bar); STAMP(3);
    }
    if (IN(3)) { p3_mixers(F); if (DUP_PHASE == 3) { xcd_barrier(bar); p3_mixers(F); } if (DUP_PHASE == 30) { xcd_barrier(bar); p3_attn_only(F); } if (DUP_PHASE == 31) { xcd_barrier(bar); p3_conv_only(F); } if (BOTH(3)) xcd_barrier(bar); STAMP(4); }
    if (IN(4)) {
        OutProj S; S.K = DM; S.G = F.G; S.c = (int)blockIdx.x; S.A = (const bf16_t*)(F.ws + WS_H); S.Bt = (const bf16_t*)(F.ws + WS_WO); S.bo = F.in[14]; S.MIX = (bf16_t*)(F.ws + WS_MIX);
        pg8::gemm_phase<OutProj>(F.lds + RING_OFF, S);
        if (DUP_PHASE == 4) { xcd_barrier(bar); pg8::gemm_phase<OutProj>(F.lds + RING_OFF, S); }
        if (BOTH(4)) xcd_barrier(bar); STAMP(5);
    }
    if (IN(5)) { p5_rows(F); if (BOTH(5)) xcd_barrier(bar); STAMP(6); }
    if (IN(6) || IN(7) || IN(8)) build_route_table(F);
    if (IN(6)) {
        MoeUp S; S.K = DM; S.G = F.G; S.c = (int)blockIdx.x; S.tab = (const volatile LAS int*)(F.lds + TAB_OFF); S.H2 = (const bf16_t*)(F.ws + WS_H2); S.WGU = (const bf16_t*)(F.ws + WS_WGU);
        S.list = (const int*)(F.ws + WS_LIST); S.ACT = (bf16_t*)(F.ws + WS_ACT);
        pg8::gemm_phase<MoeUp>(F.lds + RING_OFF, S);
        if (DUP_PHASE == 6) { xcd_barrier(bar); pg8::gemm_phase<MoeUp>(F.lds + RING_OFF, S); }
        if (BOTH(6)) xcd_barrier(bar); STAMP(7);
    }
    if (IN(7)) {
        MoeDown S; S.K = DE; S.G = F.G; S.c = (int)blockIdx.x; S.tab = (const volatile LAS int*)(F.lds + TAB_OFF); S.ACT = (const bf16_t*)(F.ws + WS_ACT); S.WD = (const bf16_t*)(F.ws + WS_WD); S.YS = (bf16_t*)(F.ws + WS_YS);
        pg8::gemm_phase<MoeDown>(F.lds + RING_OFF, S);
        if (DUP_PHASE == 7) { xcd_barrier(bar); pg8::gemm_phase<MoeDown>(F.lds + RING_OFF, S); }
        if (BOTH(7)) xcd_barrier(bar); STAMP(8);
    }
    if (IN(8)) { p8_final(F); }
#if DIAG
    {
        xcd_barrier(bar); STAMP(9);
        __syncthreads();
#define DSEL(k) ((k) == 9 ? TS[9] - TS[0] : (k) == 10 ? TS[10] - TS[0] : (k) == 11 ? TS[11] - TS[10] : (k) == 12 ? TS[12] - TS[11] : (k) == 13 ? TS[13] - TS[3] : (k) == 14 ? TS[14] - TS[13] : TS[(k) + 1] - TS[(k)])
        const unsigned ta = DSEL(DIAG_A);
        const unsigned tb = DSEL(DIAG_B);
        if (blockIdx.x == 0) {
            const float da = (float)ta * 0.01f, db = (float)tb * 0.01f;
            int n = (int)(db * 500.f); if (n > 126000) n = 126000;
            const int NGW = F.G * NWAVES;
            for (int e = F.tid; e < n; e += 512) { const int ee = e + 1024; const int ri = ee >> 10, col = ee & 1023; const int row = (ri & 7) + (ri >> 3) * NGW; F.out[(size_t)row * DM + col] += 0.05f; }
            if (F.tid == 0) F.out[0] += 1.f + da * 0.02f;
        }
    }
#endif
#undef IN
#undef BOTH
}

namespace nv {
__device__ __forceinline__ float sigmoidf_(float v) { return 1.f / (1.f + __expf(-v)); }
__device__ __forceinline__ float siluf_(float v) { return v / (1.f + __expf(-v)); }
__global__ void __launch_bounds__(256) k_gemm(const float* A, const float* B, const float* bias, float* C, int M, int N, int K) {
    __shared__ float As[16][65]; __shared__ float Bs[16][64];
    int tx = threadIdx.x % 16, ty = threadIdx.x / 16; int m0 = blockIdx.y * 64, n0 = blockIdx.x * 64;
    float acc[4][4] = {};
    for (int k0 = 0; k0 < K; k0 += 16) {
        for (int i = threadIdx.x; i < 64 * 16; i += 256) { int r = i / 16, kk = i % 16; As[kk][r] = A[(size_t)(m0 + r) * K + k0 + kk]; }
        for (int i = threadIdx.x; i < 16 * 64; i += 256) { int kk = i / 64, cc = i % 64; Bs[kk][cc] = B[(size_t)(k0 + kk) * N + n0 + cc]; }
        __syncthreads();
#pragma unroll
        for (int kk = 0; kk < 16; ++kk) { float a[4], b[4];
#pragma unroll
            for (int i = 0; i < 4; ++i) { a[i] = As[kk][ty * 4 + i]; b[i] = Bs[kk][tx * 4 + i]; }
#pragma unroll
            for (int i = 0; i < 4; ++i)
#pragma unroll
                for (int j = 0; j < 4; ++j) acc[i][j] += a[i] * b[j]; }
        __syncthreads();
    }
    for (int i = 0; i < 4; ++i) for (int j = 0; j < 4; ++j) { int r = m0 + ty * 4 + i, cc = n0 + tx * 4 + j; C[(size_t)r * N + cc] = acc[i][j] + (bias ? bias[cc] : 0.f); }
}
__device__ __forceinline__ float block_sum512(float v, float* red) {
    for (int o = 32; o > 0; o >>= 1) v += __shfl_xor(v, o);
    __syncthreads();
    if ((threadIdx.x & 63) == 0) red[threadIdx.x >> 6] = v;
    __syncthreads();
    float s = 0.f; for (int i = 0; i < 8; ++i) s += red[i];
    return s;
}
__global__ void __launch_bounds__(512) k_conv2(const bf16_t* VG, const float* conv_w, const float* conv_b, const float* lng, const float* lnb, const float* outg, float* ycat) {
    __shared__ float red[8];
    int t = blockIdx.x, c = threadIdx.x; int s = t % SEQ;
    float acc = 0.f;
    for (int j = 0; j < CW; ++j) { int ss = s - (CW - 1) + j; if (ss < 0) continue; acc += conv_w[j * DCONV + c] * bf2f(VG[(size_t)(t - (CW - 1) + j) * DCONV + c]); }
    acc += conv_b[c];
    float mean = block_sum512(acc, red) * (1.f / DCONV); float d = acc - mean;
    float var = block_sum512(d * d, red) * (1.f / DCONV);
    float y = d * rsqrtf(var + EPS) * lng[c] + lnb[c];
    y = siluf_(y);
    float q = y * y; for (int o = 32; o > 0; o >>= 1) q += __shfl_xor(q, o);
    y = y * rsqrtf(q * (1.f / 64.f) + EPS) * outg[c];
    ycat[(size_t)t * DM + c] = y;
}
__global__ void __launch_bounds__(512) k_attn2(const bf16_t* Q, const bf16_t* KV, const float* sinks, const float* outg, float* ycat) {
    __shared__ float ps[8][128];
    int t = blockIdx.x, h = threadIdx.x >> 6, lane = threadIdx.x & 63; int s = t % SEQ; int kvh = h / 4;
    const bf16_t* q = Q + (size_t)t * DATTN + h * HD;
    float sc[2];
    for (int i = 0; i < 2; ++i) { int d = lane + 64 * i; int ss = s - d; float v = -1e30f;
        if (ss >= 0) { const bf16_t* k = KV + (size_t)(t - d) * 256 + kvh * HD; float a = 0.f; for (int e = 0; e < HD; ++e) a += bf2f(q[e]) * bf2f(k[e]); v = a; }
        sc[i] = v; }
    float sk = sinks[h] * LOG2E; float m = fmaxf(fmaxf(sc[0], sc[1]), sk);
    for (int o = 32; o > 0; o >>= 1) m = fmaxf(m, __shfl_xor(m, o));
    float p0 = (sc[0] > -1e29f) ? exp2f(sc[0] - m) : 0.f, p1 = (sc[1] > -1e29f) ? exp2f(sc[1] - m) : 0.f;
    float l = p0 + p1; for (int o = 32; o > 0; o >>= 1) l += __shfl_xor(l, o);
    l += exp2f(sk - m);
    ps[h][lane] = p0 / l; ps[h][lane + 64] = p1 / l;
    __syncthreads();
    float o = 0.f; int nd = (s + 1 < WIN) ? s + 1 : WIN;
    for (int d = 0; d < nd; ++d) o += ps[h][d] * bf2f(KV[(size_t)(t - d) * 256 + DKV + kvh * HD + lane]);
    float qq = o * o; for (int oo = 32; oo > 0; oo >>= 1) qq += __shfl_xor(qq, oo);
    ycat[(size_t)t * DM + DCONV + h * HD + lane] = o * rsqrtf(qq * (1.f / 64.f) + EPS) * outg[h * HD + lane];
}
__device__ __forceinline__ float block_sum256(float v, float* red) {
    for (int o = 32; o > 0; o >>= 1) v += __shfl_xor(v, o);
    __syncthreads();
    if ((threadIdx.x & 63) == 0) red[threadIdx.x >> 6] = v;
    __syncthreads();
    return red[0] + red[1] + red[2] + red[3];
}
__global__ void __launch_bounds__(256) k_ln1(const float* x, const float* mix, const float* mod, const float* g, const float* bta, float* x1) {
    __shared__ float red[4];
    int t = blockIdx.x, b = t / SEQ; float z[4]; float s = 0.f;
    for (int i = 0; i < 4; ++i) { int c = threadIdx.x + 256 * i; z[i] = ALPHA * x[(size_t)t * DM + c] + mod[b * 6 * DM + 2 * DM + c] * mix[(size_t)t * DM + c]; s += z[i]; }
    float mean = block_sum256(s, red) * (1.f / DM); float q = 0.f;
    for (int i = 0; i < 4; ++i) { z[i] -= mean; q += z[i] * z[i]; }
    float rstd = rsqrtf(block_sum256(q, red) * (1.f / DM) + EPS);
    for (int i = 0; i < 4; ++i) { int c = threadIdx.x + 256 * i; x1[(size_t)t * DM + c] = z[i] * rstd * g[c] + bta[c]; }
}
__global__ void k_bf2f(const bf16_t* in, float* out, size_t n) { size_t i = (size_t)blockIdx.x * blockDim.x + threadIdx.x; if (i < n) out[i] = bf2f(in[i]); }
__global__ void __launch_bounds__(256) k_moe(float* io, const float* mod, const float* wrg, const float* brg, const float* wre, const float* bre,
                                            const float* wg, const float* wu, const float* wd, const float* g2ln, const float* b2ln) {
    __shared__ float h2[DM]; __shared__ float part[4][64]; __shared__ float logit[64]; __shared__ float act[DE]; __shared__ int se[2]; __shared__ float sw[2]; __shared__ float red[4];
    int t = blockIdx.x, b = t / SEQ, tid = threadIdx.x;
    float x1v[4];
    for (int i = 0; i < 4; ++i) { int c = tid + 256 * i; x1v[i] = io[(size_t)t * DM + c]; h2[c] = x1v[i] * (1.f + mod[b * 6 * DM + 4 * DM + c]) + mod[b * 6 * DM + 3 * DM + c]; }
    __syncthreads();
    { int j = tid & 63, kp = tid >> 6; float a = 0.f;
      if (j < 36) { for (int k = kp * 256; k < kp * 256 + 256; ++k) a += h2[k] * (j < 4 ? wrg[k * NG + j] : wre[k * NE + (j - 4)]); }
      part[kp][j] = a; }
    __syncthreads();
    if (tid < 36) logit[tid] = part[0][tid] + part[1][tid] + part[2][tid] + part[3][tid] + (tid < 4 ? brg[tid] : bre[tid - 4]);
    __syncthreads();
    if (tid == 0) {
        float m = logit[0]; int gi = 0; for (int i = 1; i < 4; ++i) if (logit[i] > m) { m = logit[i]; gi = i; }
        float ssum = 0.f; for (int i = 0; i < 4; ++i) ssum += __expf(logit[i] - m); float ptop = 1.f / ssum;
        const float* el = logit + 4 + gi * 8; float em = el[0]; int i1 = 0; for (int i = 1; i < 8; ++i) if (el[i] > em) { em = el[i]; i1 = i; }
        float e2m = -3e38f; int i2 = -1; for (int i = 0; i < 8; ++i) if (i != i1 && el[i] > e2m) { e2m = el[i]; i2 = i; }
        float pa = 1.f, pb = __expf(e2m - em); float inv = ptop / (pa + pb);
        se[0] = gi * 8 + i1; se[1] = gi * 8 + i2; sw[0] = pa * inv; sw[1] = pb * inv;
    }
    __syncthreads();
    float y[4] = {0.f, 0.f, 0.f, 0.f};
    for (int s = 0; s < 2; ++s) {
        int e = se[s]; float w = sw[s];
        const float* G = wg + (size_t)e * DM * DE; const float* U = wu + (size_t)e * DM * DE; const float* Dn = wd + (size_t)e * DE * DM;
        float ga = 0.f, ua = 0.f;
        for (int k = 0; k < DM; ++k) { float hv = h2[k]; ga += hv * G[(size_t)k * DE + tid]; ua += hv * U[(size_t)k * DE + tid]; }
        __syncthreads();
        act[tid] = siluf_(ga) * ua;
        __syncthreads();
        for (int j = 0; j < DE; ++j) { float av = act[j] * w; for (int i = 0; i < 4; ++i) y[i] += av * Dn[(size_t)j * DM + tid + 256 * i]; }
    }
    float z[4]; float sm = 0.f;
    for (int i = 0; i < 4; ++i) { int c = tid + 256 * i; z[i] = ALPHA * x1v[i] + mod[b * 6 * DM + 5 * DM + c] * y[i]; sm += z[i]; }
    float mean = block_sum256(sm, red) * (1.f / DM); float q = 0.f;
    for (int i = 0; i < 4; ++i) { z[i] -= mean; q += z[i] * z[i]; }
    float rstd = rsqrtf(block_sum256(q, red) * (1.f / DM) + EPS);
    for (int i = 0; i < 4; ++i) { int c = tid + 256 * i; io[(size_t)t * DM + c] = z[i] * rstd * g2ln[c] + b2ln[c]; }
}
}

extern "C" void kernel_launch(void* const* d_in, const int* in_sizes, int n_in, void* d_out, int out_size, void* d_ws, size_t ws_size, hipStream_t stream) {
    static int grid = 0;
    if (grid == 0) {
        int dev = 0, cus = 0;
        if (hipGetDevice(&dev) != hipSuccess || hipDeviceGetAttribute(&cus, hipDeviceAttributeMultiprocessorCount, dev) != hipSuccess) { fprintf(stderr, "kernel_launch: device query failed\n"); grid = -1; return; }
        if (hipFuncSetAttribute((const void*)mega_fwd, hipFuncAttributeMaxDynamicSharedMemorySize, LDS_BYTES) != hipSuccess) { fprintf(stderr, "kernel_launch: hipFuncSetAttribute failed\n"); grid = -1; return; }
        int per_cu = 0;
        if (hipOccupancyMaxActiveBlocksPerMultiprocessor(&per_cu, (const void*)mega_fwd, NWAVES * 64, LDS_BYTES) != hipSuccess || per_cu < 1) fprintf(stderr, "kernel_launch: occupancy query reports %d\n", per_cu);
        (void)hipGetLastError();
        grid = cus;
    }
    if (grid < 0) return;
    (void)hipMemsetAsync((char*)d_ws + WS_CTL, 0, CTL_ZERO_BYTES, stream);
    Args a{};
    for (int i = 0; i < 26; ++i) a.in[i] = (const float*)d_in[i];
    a.out = (float*)d_out; a.ws = (unsigned char*)d_ws; a.ph_lo = 0; a.ph_hi = DEV_STAGE + 1;
    hipLaunchKernelGGL(mega_fwd, dim3(grid), dim3(NWAVES * 64), LDS_BYTES, stream, a);
    {
        using namespace nv;
        char* ws = (char*)d_ws; float* out = (float*)d_out;
        const float* x = (const float*)d_in[0];
        const float* mod = (const float*)(ws + WS_MOD);
        float* ycat = (float*)(ws + WS_DEV1);
        float* mix = (float*)(ws + 56 * MiB);
#if DEV_STAGE == 3
        k_bf2f<<<(unsigned)((size_t)T * DM / 256), 256, 0, stream>>>((const bf16_t*)(ws + WS_H), ycat, (size_t)T * DM);
        mix = (float*)(ws + 120 * MiB);
        k_gemm<<<dim3(DM / 64, T / 64), 256, 0, stream>>>(ycat, (const float*)d_in[13], (const float*)d_in[14], mix, T, DM, DM);
        k_ln1<<<T, 256, 0, stream>>>(x, mix, mod, (const float*)d_in[15], (const float*)d_in[16], out);
        k_moe<<<T, 256, 0, stream>>>(out, mod, (const float*)d_in[17], (const float*)d_in[18], (const float*)d_in[19], (const float*)d_in[20], (const float*)d_in[21], (const float*)d_in[22], (const float*)d_in[23], (const float*)d_in[24], (const float*)d_in[25]);
#endif
#if DEV_STAGE == 2
        k_conv2<<<T, 512, 0, stream>>>((const bf16_t*)(ws + WS_VG), (const float*)d_in[6], (const float*)d_in[7], (const float*)d_in[8], (const float*)d_in[9], (const float*)d_in[10], ycat);
        k_attn2<<<T, 512, 0, stream>>>((const bf16_t*)(ws + WS_Q), (const bf16_t*)(ws + WS_KV), (const float*)d_in[11], (const float*)d_in[12], ycat);
        k_gemm<<<dim3(DM / 64, T / 64), 256, 0, stream>>>(ycat, (const float*)d_in[13], (const float*)d_in[14], mix, T, DM, DM);
        k_ln1<<<T, 256, 0, stream>>>(x, mix, mod, (const float*)d_in[15], (const float*)d_in[16], out);
        k_moe<<<T, 256, 0, stream>>>(out, mod, (const float*)d_in[17], (const float*)d_in[18], (const float*)d_in[19], (const float*)d_in[20], (const float*)d_in[21], (const float*)d_in[22], (const float*)d_in[23], (const float*)d_in[24], (const float*)d_in[25]);
#endif
    }
}
```

```cpp
#include <hip/hip_runtime.h>
#include <cstdio>
#include <cstdint>

#ifndef DIAG
#define DIAG 0
#endif
#ifndef DIAG_A
#define DIAG_A 9
#endif
#ifndef DIAG_B
#define DIAG_B 9
#endif
#ifndef DUP_PHASE
#define DUP_PHASE -1
#endif
#ifndef DEV_STAGE
#define DEV_STAGE 8
#endif

#define LAS __attribute__((address_space(3)))
#define GAS __attribute__((address_space(1)))
typedef unsigned short bf16_t;
typedef short bf16x8 __attribute__((ext_vector_type(8)));
typedef float f32x4 __attribute__((ext_vector_type(4)));
typedef float f32x2 __attribute__((ext_vector_type(2)));
typedef unsigned u32x4 __attribute__((ext_vector_type(4)));
typedef unsigned u32x2 __attribute__((ext_vector_type(2)));
typedef GAS unsigned gu32;

constexpr int DM = 1024, NBATCH = 8, SEQ = 4096, T = NBATCH * SEQ;
constexpr int DCONV = 512, CW = 31, NH = 8, NKV = 2, HD = 64, DATTN = 512, DKV = 128, WIN = 128;
constexpr int DIN = 1792, NG = 4, EPG = 8, NE = 32, DE = 256;
constexpr float ALPHA = 1.189207115002721f, EPS = 1e-5f;
constexpr float LOG2E = 1.4426950408889634f;
constexpr float QSCALE = 0.125f * LOG2E;

constexpr size_t MiB = 1u << 20;
constexpr size_t WS_CTL = 0, CTL_ZERO_BYTES = 1 * MiB;
constexpr size_t WS_MOD = 1 * MiB;
constexpr size_t WS_BPERM = 1 * MiB + 256 * 1024;
constexpr size_t WS_WR = 1 * MiB + 512 * 1024;
constexpr size_t WS_WI = 2 * MiB;
constexpr size_t WS_WO = 6 * MiB;
constexpr size_t WS_WGU = 8 * MiB;
constexpr size_t WS_WD = 40 * MiB;
constexpr size_t WS_H = 56 * MiB;
constexpr size_t WS_VG = 120 * MiB;
constexpr size_t WS_Q = 152 * MiB;
constexpr size_t WS_KV = 184 * MiB;
constexpr size_t WS_H2 = 200 * MiB;
constexpr size_t WS_ACT = 264 * MiB;
constexpr size_t WS_LIST = 300 * MiB;
constexpr size_t WS_TOK = 304 * MiB;
constexpr size_t WS_MIX = 120 * MiB;
constexpr size_t WS_YS = 56 * MiB;
constexpr size_t WS_DEV1 = 320 * MiB;
constexpr int CW_BAR = 4096;
constexpr int CW_ECNT = 16384;

constexpr int RING_OFF = 0, RING_BYTES = 139264;
constexpr int LDSCTL_OFF = RING_BYTES, MISC_OFF = LDSCTL_OFF + 320;
constexpr int LDS_BYTES = 147456;
constexpr int NWAVES = 8;

#define RLX_AGENT __ATOMIC_RELAXED, __HIP_MEMORY_SCOPE_AGENT
#define LDS_WAIT() asm volatile("s_waitcnt lgkmcnt(0)" ::: "memory")
#define VM_WAIT() asm volatile("s_waitcnt vmcnt(0)" ::: "memory")

__device__ __forceinline__ unsigned f2bf(float f) { unsigned u = __builtin_bit_cast(unsigned, f); return (u + 0x7fffu + ((u >> 16) & 1u)) >> 16; }
__device__ __forceinline__ unsigned pk2(float lo, float hi) { return f2bf(lo) | (f2bf(hi) << 16); }
__device__ __forceinline__ float bf2f(unsigned short b) { return __builtin_bit_cast(float, (unsigned)b << 16); }
__device__ __forceinline__ unsigned cvt_pk_bf16(float lo, float hi) { unsigned r; asm volatile("v_cvt_pk_bf16_f32 %0, %1, %2" : "=v"(r) : "v"(lo), "v"(hi)); return r; }
__device__ __forceinline__ float fast_sigmoid(float v) { return __builtin_amdgcn_rcpf(1.f + __builtin_amdgcn_exp2f(-v * LOG2E)); }
__device__ __forceinline__ float fast_silu(float v) { return v * fast_sigmoid(v); }

#define XB_TMO      128
#define XB_XCNT(j)  (256  + 64 * (j))
#define XB_XSUB(j)  (1280 + 64 * (j))
#define XB_XGEN(j)  (2304 + 64 * (j))
#define XB_TOP      3328
#define XB_TOPGEN   3392
#define XCD_BAR_WORDS 3456
#define XB_SPIN_CAP (1u << 18)
__device__ __forceinline__ unsigned xb_ld(unsigned* p)              { return __hip_atomic_load(p, __ATOMIC_RELAXED, __HIP_MEMORY_SCOPE_AGENT); }
__device__ __forceinline__ unsigned xb_add(unsigned* p, unsigned v) { return __hip_atomic_fetch_add(p, v, __ATOMIC_RELAXED, __HIP_MEMORY_SCOPE_AGENT); }
__device__ __forceinline__ unsigned xb_xcc_id() { return (unsigned)__builtin_amdgcn_s_getreg((3 << 11) | 20) & 0xFu; }
#define XB_SPIN(cond, bar) do { unsigned _sp = 0; while (cond) { __builtin_amdgcn_s_sleep(1); \
    if ((++_sp & 255u) == 0u) { if (xb_ld(&(bar)[XB_TMO])) break; if (_sp > XB_SPIN_CAP) { atomicAdd(&(bar)[XB_TMO], 1u); break; } } } } while (0)
struct XcdBarrier { unsigned* bar; unsigned x; volatile LAS unsigned* st; };
__device__ __forceinline__ XcdBarrier xcd_barrier_post(unsigned* bar, volatile LAS unsigned* st) {
    XcdBarrier b; b.bar = bar; b.x = xb_xcc_id(); b.st = st;
    if (threadIdx.x == 0) (void)xb_add(&bar[XB_XCNT(b.x)], 1u);
    return b;
}
__device__ __forceinline__ void xcd_barrier_complete(unsigned* bar, unsigned x, unsigned& nloc, unsigned& nx) {
    const unsigned G = gridDim.x * gridDim.y * gridDim.z;
    unsigned sum, cnt, mine, sp = 0u;
    for (;;) {
        sum = 0u; cnt = 0u; mine = 0u;
#pragma unroll
        for (unsigned j = 0; j < 16; ++j) { const unsigned c = xb_ld(&bar[XB_XCNT(j)]); sum += c; cnt += (c > 0u) ? 1u : 0u; mine = (j == x) ? c : mine; }
        if (sum == G) break;
        __builtin_amdgcn_s_sleep(1);
        if ((++sp & 255u) == 0u) { if (xb_ld(&bar[XB_TMO])) break; if (sp > XB_SPIN_CAP) { atomicAdd(&bar[XB_TMO], 1u); break; } }
    }
    nloc = mine > 0u ? mine : 1u; nx = cnt > 0u ? cnt : 1u;
}
__device__ __forceinline__ void xcd_barrier(const XcdBarrier& b) {
    asm volatile("s_waitcnt vmcnt(0)" ::: "memory");
    __syncthreads();
    if (threadIdx.x == 0) {
        unsigned* bar = b.bar;
        __builtin_amdgcn_s_waitcnt(0);
        unsigned nloc = b.st[0], nx = b.st[1];
        if (nloc == 0u) { xcd_barrier_complete(bar, b.x, nloc, nx); b.st[0] = nloc; b.st[1] = nx; }
        const unsigned old = xb_add(&bar[XB_XSUB(b.x)], 1u);
        const unsigned gen = old / nloc;
        if (old + 1u == (gen + 1u) * nloc) {
            __builtin_amdgcn_fence(__ATOMIC_RELEASE, "agent");
            asm volatile("s_waitcnt vmcnt(0)" ::: "memory");
            const unsigned og = xb_add(&bar[XB_TOP], 1u);
            const unsigned tg = og / nx;
            if (og + 1u == (tg + 1u) * nx) xb_add(&bar[XB_TOPGEN], 1u);
            else XB_SPIN(xb_ld(&bar[XB_TOPGEN]) == tg, bar);
            __builtin_amdgcn_fence(__ATOMIC_ACQUIRE, "agent");
            xb_add(&bar[XB_XGEN(b.x)], 1u);
            asm volatile("s_waitcnt vmcnt(0)" ::: "memory");
        } else {
            XB_SPIN(xb_ld(&bar[XB_XGEN(b.x)]) == gen, bar);
            __builtin_amdgcn_fence(__ATOMIC_ACQUIRE, "agent");
            asm volatile("s_waitcnt vmcnt(0)" ::: "memory");
        }
    }
    __syncthreads();
}

namespace pg8 {
constexpr int BM = 256, BK = 64, HALF = 128, HTB = HALF * BK * 2, STAGE_BYTES = 8 * HTB, NXCD = 8, WGM = 8;
__host__ __device__ __forceinline__ int lds_byte(int r, int c) { const int st = (r >> 4) * 2 + (c >> 5), rr = r & 15, cc = c & 31, ob = rr * 64 + cc * 2; return st * 1024 + (ob ^ (((ob >> 9) & 1) << 5)); }
__host__ __device__ __forceinline__ void stage_rc(int b, int& R, int& C) { const int st = b / 1024, sb = b % 1024, swz = sb ^ (((sb >> 9) & 1) << 5); R = (st >> 1) * 16 + swz / 64; C = (st & 1) * 32 + (swz % 64) / 2; }
__host__ __device__ __forceinline__ int perm32(int rho) { const int n = rho >> 4, i = rho & 15; return 8 * (i >> 2) + 4 * n + (i & 3); }

struct Unit { int pm, pn, e; };
__device__ __forceinline__ bool static_next(int i, int G, int c, int nM, int nN, int& pm, int& pn) {
    const int nwg = nM * nN; const long L = (long)i * G + c; if (L >= nwg) return false;
    int wgid = (int)L; { const int q = nwg / NXCD, r = nwg % NXCD, xcd = wgid % NXCD, off = wgid / NXCD; wgid = (xcd < r ? xcd * (q + 1) : r * (q + 1) + (xcd - r) * q) + off; }
    const int nig = WGM * nN, gid = wgid / nig, fm = gid * WGM, gsz = (nM - fm) < WGM ? (nM - fm) : WGM;
    pm = fm + ((wgid % nig) % gsz); pn = (wgid % nig) / gsz; return true;
}

template <class P>
__device__ __forceinline__ void gemm_phase(LAS unsigned char* lds, const P& S) {
    const int tid = threadIdx.x, wid = __builtin_amdgcn_readfirstlane(tid >> 6), lane = tid & 63, wr = wid >> 2, wc = wid & 3, fr = lane & 15, fq = lane >> 4;
    const int K = S.K, nt = K / BK;
    int sR[2], sC[2]; unsigned voffB[2];
#pragma unroll
    for (int i = 0; i < 2; ++i) { int R, C; stage_rc(tid * 16 + i * 8192, R, C); sR[i] = R; sC[i] = C; const int Rb = P::PERM ? ((R & ~31) + perm32(R & 31)) : R; voffB[i] = (unsigned)(Rb * K + C) * 2u; }
    const size_t kstep = (size_t)(BK * 2);
    const size_t hstepB = (size_t)HALF * K * 2;
    const unsigned ldsw = (unsigned)wid * 1024u;
    const int aoff = lds_byte(wr * 64 + fr, fq * 8), boff = lds_byte(wc * 32 + fr, fq * 8);
#define PG8_SA(b, h) (((b) * 2 + (h)) * HTB)
#define PG8_SB(b, h) ((4 + (b) * 2 + (h)) * HTB)
#define PG8_STAGE(bufoff, gbase, voff) do { _Pragma("unroll") for (int _i = 0; _i < 2; ++_i) \
        __builtin_amdgcn_global_load_lds((const unsigned*)((const char*)(gbase) + (voff)[_i]), (LAS unsigned*)(lds + (bufoff) + ldsw + _i * 8192), 16, 0, 0); } while (0)
#define PG8_LDA(dst, b, h) do { _Pragma("unroll") for (int m = 0; m < 4; ++m) _Pragma("unroll") for (int k = 0; k < 2; ++k) dst[m][k] = *(const LAS bf16x8*)(lds + PG8_SA(b, h) + aoff + m * 2048 + k * 1024); } while (0)
#define PG8_LDB(dst, b, h) do { _Pragma("unroll") for (int n = 0; n < 2; ++n) _Pragma("unroll") for (int k = 0; k < 2; ++k) dst[n][k] = *(const LAS bf16x8*)(lds + PG8_SB(b, h) + boff + n * 2048 + k * 1024); } while (0)
#define PG8_MMA(ai, bj, At, Bt) do { __builtin_amdgcn_s_setprio(1); _Pragma("unroll") for (int m = 0; m < 4; ++m) _Pragma("unroll") for (int n = 0; n < 2; ++n) _Pragma("unroll") for (int k = 0; k < 2; ++k) \
        acc[ai][bj][m][n] = __builtin_amdgcn_mfma_f32_16x16x32_bf16(Bt[n][k], At[m][k], acc[ai][bj][m][n], 0, 0, 0); __builtin_amdgcn_s_setprio(0); } while (0)
#define PG8_WAIT_V(n) asm volatile("s_waitcnt vmcnt(" #n ")" ::: "memory")
#define PG8_WAIT_L(n) asm volatile("s_waitcnt lgkmcnt(" #n ")" ::: "memory")
#define PG8_BAR __builtin_amdgcn_s_barrier()
#define PG8_SCHED __builtin_amdgcn_sched_barrier(0)
    Unit cur, nxt; int ui = 0;
    if (!S.next(0, cur)) return;
    f32x4 acc[2][2][4][2];
#pragma unroll
    for (int a = 0; a < 2; ++a)
#pragma unroll
        for (int b = 0; b < 2; ++b)
#pragma unroll
            for (int m = 0; m < 4; ++m)
#pragma unroll
                for (int n = 0; n < 2; ++n) acc[a][b][m][n] = (f32x4){0.f, 0.f, 0.f, 0.f};
    bf16x8 At[4][2], B0[2][2], B1[2][2];
    unsigned vAc[2][2], vAn[2][2];
    S.a_voff(cur, sR, sC, vAc);
    const char* cA = S.a_base(cur); const char* cB = S.b_base(cur);
    PG8_STAGE(PG8_SB(0, 0), cB, voffB); PG8_STAGE(PG8_SB(0, 1), cB + hstepB, voffB); PG8_STAGE(PG8_SA(0, 0), cA, vAc[0]); PG8_STAGE(PG8_SA(0, 1), cA, vAc[1]);
    if (wr == 1) PG8_BAR;
    PG8_WAIT_V(2); PG8_BAR;
    PG8_STAGE(PG8_SB(1, 0), cB + kstep, voffB); PG8_STAGE(PG8_SA(1, 0), cA + kstep, vAc[0]); PG8_STAGE(PG8_SB(1, 1), cB + hstepB + kstep, voffB);
    PG8_WAIT_V(6); PG8_BAR;
    for (;;) {
        const bool has_next = S.next(ui + 1, nxt);
        const char* nA = has_next ? S.a_base(nxt) : cA; const char* nB = has_next ? S.b_base(nxt) : cB;
        if (has_next) S.a_voff(nxt, sR, sC, vAn); else { vAn[0][0] = vAc[0][0]; vAn[0][1] = vAc[0][1]; vAn[1][0] = vAc[1][0]; vAn[1][1] = vAc[1][1]; }
        for (int t = 0; t < nt; t += 2) {
            const bool last = (t == nt - 2);
            const char* a1 = cA + (size_t)(t + 1) * kstep;
            const char* a2 = last ? nA : cA + (size_t)(t + 2) * kstep; const char* b2 = last ? nB : cB + (size_t)(t + 2) * kstep;
            const char* a3 = a2 + kstep; const char* b3 = b2 + kstep;
            unsigned v2[2][2];
            v2[0][0] = last ? vAn[0][0] : vAc[0][0]; v2[0][1] = last ? vAn[0][1] : vAc[0][1]; v2[1][0] = last ? vAn[1][0] : vAc[1][0]; v2[1][1] = last ? vAn[1][1] : vAc[1][1];
            PG8_LDB(B0, 0, 0); PG8_LDB(B1, 0, 1); PG8_SCHED; PG8_LDA(At, 0, 0); PG8_STAGE(PG8_SA(1, 1), a1, vAc[1]);
            PG8_WAIT_V(8); PG8_WAIT_L(0); PG8_BAR; PG8_MMA(0, 0, At, B0); PG8_MMA(0, 1, At, B1); PG8_BAR; PG8_SCHED;
            PG8_LDA(At, 0, 1); PG8_STAGE(PG8_SB(0, 0), b2, voffB); PG8_STAGE(PG8_SB(0, 1), b2 + hstepB, voffB); PG8_STAGE(PG8_SA(0, 0), a2, v2[0]);
            PG8_WAIT_V(8); PG8_WAIT_L(0); PG8_BAR; PG8_MMA(1, 0, At, B0); PG8_MMA(1, 1, At, B1); PG8_BAR; PG8_SCHED;
            PG8_LDB(B0, 1, 0); PG8_LDB(B1, 1, 1); PG8_SCHED; PG8_LDA(At, 1, 0); PG8_STAGE(PG8_SA(0, 1), a2, v2[1]);
            PG8_WAIT_V(8); PG8_WAIT_L(0); PG8_BAR; PG8_MMA(0, 0, At, B0); PG8_MMA(0, 1, At, B1); PG8_BAR; PG8_SCHED;
            PG8_LDA(At, 1, 1); PG8_STAGE(PG8_SB(1, 0), b3, voffB); PG8_STAGE(PG8_SB(1, 1), b3 + hstepB, voffB); PG8_STAGE(PG8_SA(1, 0), a3, v2[0]);
            PG8_WAIT_V(8); PG8_WAIT_L(0); PG8_BAR; PG8_MMA(1, 0, At, B0); PG8_MMA(1, 1, At, B1); PG8_BAR; PG8_SCHED;
        }
        if (wr == 0) PG8_BAR;
        S.epi(acc, cur, wr, wc, fr, fq);
        if (!has_next) break;
#pragma unroll
        for (int a = 0; a < 2; ++a)
#pragma unroll
            for (int b = 0; b < 2; ++b)
#pragma unroll
                for (int m = 0; m < 4; ++m)
#pragma unroll
                    for (int n = 0; n < 2; ++n) acc[a][b][m][n] = (f32x4){0.f, 0.f, 0.f, 0.f};
        cur = nxt; cA = nA; cB = nB; ++ui;
        vAc[0][0] = vAn[0][0]; vAc[0][1] = vAn[0][1]; vAc[1][0] = vAn[1][0]; vAc[1][1] = vAn[1][1];
        if (wr == 1) PG8_BAR;
    }
    PG8_WAIT_V(0);
    PG8_BAR;
#undef PG8_SA
#undef PG8_SB
#undef PG8_STAGE
#undef PG8_LDA
#undef PG8_LDB
#undef PG8_MMA
#undef PG8_WAIT_V
#undef PG8_WAIT_L
#undef PG8_BAR
#undef PG8_SCHED
}
}

struct Frame {
    LAS unsigned char* lds;
    volatile LAS unsigned* MISC;
    gu32* ctl;
    int tid, lane, wave, vcu, G;
    const float* in[26]; float* out; unsigned char* ws;
};
struct Args { const float* in[26]; float* out; unsigned char* ws; int ph_lo, ph_hi; };

__device__ __forceinline__ void sub_stamp(Frame& F, int k) { if (DIAG && blockIdx.x == 0 && F.tid == 0) ((volatile LAS unsigned*)(F.lds + LDSCTL_OFF + 2048))[k] = (unsigned)__builtin_amdgcn_s_memrealtime(); }
template <int CTRL> __device__ __forceinline__ float dpp_mov(float src) { return __builtin_bit_cast(float, __builtin_amdgcn_update_dpp(0, __builtin_bit_cast(int, src), CTRL, 0xF, 0xF, true)); }
__device__ __forceinline__ float group8_sum(float v) {
    v += dpp_mov<0xB1>(v); v += dpp_mov<0x4E>(v); v += dpp_mov<0x141>(v); return v;
}
__device__ __forceinline__ float wave_sum(float v) {
    v = group8_sum(v); v += dpp_mov<0x140>(v);
    return __builtin_bit_cast(float, __builtin_amdgcn_readlane(__builtin_bit_cast(int, v), 0)) + __builtin_bit_cast(float, __builtin_amdgcn_readlane(__builtin_bit_cast(int, v), 16))
         + __builtin_bit_cast(float, __builtin_amdgcn_readlane(__builtin_bit_cast(int, v), 32)) + __builtin_bit_cast(float, __builtin_amdgcn_readlane(__builtin_bit_cast(int, v), 48));
}

struct P0Item { const float* W; bf16_t* WT; int Ksrc, N, dst_row0, k0, n0; };
__device__ __forceinline__ void p0_item_load(const P0Item& I, f32x4 (&v)[8], int lane) {
    const int r = lane >> 3, c4 = (lane & 7) * 4;
#pragma unroll
    for (int i = 0; i < 8; ++i) v[i] = __builtin_nontemporal_load((const f32x4*)(I.W + (size_t)(I.k0 + 8 * i + r) * I.N + I.n0 + c4));
}
__device__ __forceinline__ void p0_item_store(const P0Item& I, const f32x4 (&v)[8], LAS float* scr, int lane) {
    { const int r = lane >> 3, c4 = (lane & 7) * 4;
#pragma unroll
      for (int i = 0; i < 8; ++i) { LAS float* d = scr + (8 * i + r) * 33 + c4; d[0] = v[i][0]; d[1] = v[i][1]; d[2] = v[i][2]; d[3] = v[i][3]; } }
    LDS_WAIT(); asm volatile("" ::: "memory");
    const int c = lane & 7;
#pragma unroll
    for (int j = 0; j < 4; ++j) { const int n = (lane >> 3) + 8 * j; const LAS float* s = scr + (8 * c) * 33 + n;
        u32x4 o; o.x = pk2(s[0 * 33], s[1 * 33]); o.y = pk2(s[2 * 33], s[3 * 33]); o.z = pk2(s[4 * 33], s[5 * 33]); o.w = pk2(s[6 * 33], s[7 * 33]);
        __builtin_nontemporal_store(o, (GAS u32x4*)(I.WT + (size_t)(I.dst_row0 + n) * I.Ksrc + I.k0 + 8 * c)); }
    LDS_WAIT(); asm volatile("" ::: "memory");
}
__host__ __device__ __forceinline__ int map_in(int n) { return n < 512 ? 256 * (n >> 7) + (n & 127) : (n < 1024 ? 256 * ((n - 512) >> 7) + 128 + ((n - 512) & 127) : n); }

__device__ __forceinline__ void p0_convert(Frame& F, int gw, int NGW, int which) {
    LAS float* scr = (LAS float*)(F.lds + RING_OFF + F.wave * 16384);
    constexpr int I_IN = 16 * 56, I_OUT = 16 * 32, I_G = 16 * 8, I_D = 4 * 32, I_E = 2 * I_G + I_D;
    const int NITEMS = which == 0 ? I_IN + I_OUT : NE * I_E;
    bf16_t* WI = (bf16_t*)(F.ws + WS_WI); bf16_t* WO = (bf16_t*)(F.ws + WS_WO); bf16_t* WGU = (bf16_t*)(F.ws + WS_WGU); bf16_t* WD = (bf16_t*)(F.ws + WS_WD);
    auto decode = [&](int it, P0Item& I) {
        int r = it;
        if (which == 0) {
            if (r < I_IN) { const int kb = r / 56, nb = r % 56; I.W = F.in[4]; I.Ksrc = DM; I.N = DIN; I.WT = WI; I.dst_row0 = map_in(32 * nb); I.k0 = 64 * kb; I.n0 = 32 * nb; return; } r -= I_IN;
            { const int kb = r / 32, nb = r % 32; I.W = F.in[13]; I.Ksrc = DM; I.N = DM; I.WT = WO; I.dst_row0 = 32 * nb; I.k0 = 64 * kb; I.n0 = 32 * nb; return; }
        }
        const int e = r / I_E; r -= e * I_E;
        if (r < I_G) { const int kb = r / 8, nb = r % 8, n0 = 32 * nb; I.W = F.in[21] + (size_t)e * DM * DE; I.Ksrc = DM; I.N = DE; I.WT = WGU + (size_t)e * 512 * DM; I.dst_row0 = 256 * (n0 >> 7) + (n0 & 127); I.k0 = 64 * kb; I.n0 = n0; return; } r -= I_G;
        if (r < I_G) { const int kb = r / 8, nb = r % 8, n0 = 32 * nb; I.W = F.in[22] + (size_t)e * DM * DE; I.Ksrc = DM; I.N = DE; I.WT = WGU + (size_t)e * 512 * DM; I.dst_row0 = 256 * (n0 >> 7) + 128 + (n0 & 127); I.k0 = 64 * kb; I.n0 = n0; return; } r -= I_G;
        { const int kb = r / 32, nb = r % 32; I.W = F.in[23] + (size_t)e * DE * DM; I.Ksrc = DE; I.N = DM; I.WT = WD + (size_t)e * DM * DE; I.dst_row0 = 32 * nb; I.k0 = 64 * kb; I.n0 = 32 * nb; }
    };
    int it = gw;
    if (it < NITEMS) {
        P0Item cur; f32x4 vc[8]; decode(it, cur); p0_item_load(cur, vc, F.lane);
#pragma unroll
        for (int i = 0; i < 8; ++i) asm volatile("" : "+v"(vc[i]));
        for (;;) {
            const int itn = it + NGW; const bool has = itn < NITEMS;
            P0Item nx = cur; f32x4 vn[8];
            if (has) { decode(itn, nx); p0_item_load(nx, vn, F.lane); }
            p0_item_store(cur, vc, scr, F.lane);
            if (!has) break;
            cur = nx; it = itn;
#pragma unroll
            for (int i = 0; i < 8; ++i) vc[i] = vn[i];
        }
    }
}
__device__ __forceinline__ void p0_prologue(Frame& F) {
    const float* c = F.in[1]; const float* w_ada = F.in[2]; const float* b_ada = F.in[3];
    {
        LAS float* cact = (LAS float*)(F.lds + RING_OFF);
        LAS float* red = (LAS float*)(F.lds + RING_OFF + 32768);
        for (int i = F.tid; i < NBATCH * DM; i += 512) { const float v = c[i]; cact[i] = v / (1.f + __expf(-v)); }
        __syncthreads();
        float* mod = (float*)(F.ws + WS_MOD);
        for (int cg = blockIdx.x; cg < 256; cg += F.G) {
            const int j0 = cg * 24, ks = F.tid >> 5, jj = F.tid & 31;
            float a[8] = {0.f, 0.f, 0.f, 0.f, 0.f, 0.f, 0.f, 0.f};
            if (jj < 24) {
#pragma unroll 32
                for (int k = ks * 64; k < ks * 64 + 64; ++k) { const float w = w_ada[(size_t)k * 6 * DM + j0 + jj];
#pragma unroll
                    for (int b = 0; b < 8; ++b) a[b] += cact[b * DM + k] * w; }
            }
#pragma unroll
            for (int b = 0; b < 8; ++b) red[(ks * 8 + b) * 32 + jj] = a[b];
            __syncthreads();
            if (F.tid < 8 * 24) { const int b = F.tid / 24, j = F.tid % 24; float s = 0.f;
                for (int q = 0; q < 16; ++q) s += red[(q * 8 + b) * 32 + j];
                mod[b * 6 * DM + j0 + j] = s + b_ada[j0 + j]; }
            __syncthreads();
        }
    }
    sub_stamp(F, 10);
    {
        const int gt = blockIdx.x * 512 + F.tid, NT = F.G * 512;
        float* bperm = (float*)(F.ws + WS_BPERM); const float* b_in = F.in[5];
        for (int n = gt; n < DIN; n += NT) bperm[map_in(n)] = b_in[n];
        bf16_t* wr_hi = (bf16_t*)(F.ws + WS_WR); bf16_t* wr_lo = wr_hi + 48 * DM;
        const float* wrg = F.in[17]; const float* wre = F.in[19];
        for (int i = gt; i < 48 * DM; i += NT) { const int j = i / DM, k = i % DM; float v = 0.f;
            if (j < 4) v = wrg[k * NG + j]; else if (j < 36) v = wre[k * NE + (j - 4)];
            const unsigned h = f2bf(v); const float r = v - bf2f((unsigned short)h); wr_hi[i] = (bf16_t)h; wr_lo[i] = (bf16_t)f2bf(r); }
    }
    sub_stamp(F, 11);
    p0_convert(F, F.vcu * NWAVES + F.wave, F.G * NWAVES, 0);
}

__device__ __forceinline__ void p1_modulate(Frame& F) {
    const float* x = F.in[0]; const float* mod = (const float*)(F.ws + WS_MOD); bf16_t* H = (bf16_t*)(F.ws + WS_H);
    const int cv = F.tid & 127, rsub = F.tid >> 7, col = cv * 8;
    int r0 = blockIdx.x * 16; if (r0 >= T) return;
    f32x4 xa[4], xb[4];
#pragma unroll
    for (int i = 0; i < 4; ++i) { const size_t e0 = (size_t)(r0 + rsub + 4 * i) * DM + col; xa[i] = *(const f32x4*)(x + e0); xb[i] = *(const f32x4*)(x + e0 + 4); }
#pragma unroll
    for (int i = 0; i < 4; ++i) { asm volatile("" : "+v"(xa[i])); asm volatile("" : "+v"(xb[i])); }
    for (;;) {
        const int rn = r0 + F.G * 16; const bool has = rn < T;
        f32x4 na[4], nb[4];
        if (has) {
#pragma unroll
            for (int i = 0; i < 4; ++i) { const size_t e0 = (size_t)(rn + rsub + 4 * i) * DM + col; na[i] = *(const f32x4*)(x + e0); nb[i] = *(const f32x4*)(x + e0 + 4); } }
        const int b = r0 / SEQ; const float* mb = mod + b * 6 * DM;
        const f32x4 s0 = *(const f32x4*)(mb + DM + col) + 1.f, s1 = *(const f32x4*)(mb + DM + col + 4) + 1.f, h0 = *(const f32x4*)(mb + col), h1 = *(const f32x4*)(mb + col + 4);
#pragma unroll
        for (int i = 0; i < 4; ++i) { const size_t e0 = (size_t)(r0 + rsub + 4 * i) * DM + col; const f32x4 y0 = xa[i] * s0 + h0, y1 = xb[i] * s1 + h1;
            u32x4 o; o.x = pk2(y0[0], y0[1]); o.y = pk2(y0[2], y0[3]); o.z = pk2(y1[0], y1[1]); o.w = pk2(y1[2], y1[3]);
            *(u32x4*)(H + e0) = o; }
        if (!has) break;
        r0 = rn;
#pragma unroll
        for (int i = 0; i < 4; ++i) { xa[i] = na[i]; xb[i] = nb[i]; }
    }
}

struct InProj {
    static constexpr bool PERM = true;
    int K, G, c; const bf16_t* A; const bf16_t* Bt; const float* bias; bf16_t* VG; bf16_t* Q; bf16_t* KV;
    __device__ __forceinline__ bool next(int i, pg8::Unit& u) const { u.e = 0; return pg8::static_next(i, G, c, T / 256, DIN / 256, u.pm, u.pn); }
    __device__ __forceinline__ const char* a_base(const pg8::Unit& u) const { return (const char*)A + (size_t)u.pm * 256 * K * 2; }
    __device__ __forceinline__ const char* b_base(const pg8::Unit& u) const { return (const char*)Bt + (size_t)u.pn * 256 * K * 2; }
    __device__ __forceinline__ void a_voff(const pg8::Unit&, const int (&R)[2], const int (&C)[2], unsigned (&v)[2][2]) const {
#pragma unroll
        for (int i = 0; i < 2; ++i) { v[0][i] = (unsigned)(R[i] * K + C[i]) * 2u; v[1][i] = v[0][i] + (unsigned)(128 * K * 2); } }
    __device__ __forceinline__ void epi(const f32x4 (&acc)[2][2][4][2], const pg8::Unit& u, int wr, int wc, int fr, int fq) const {
        const int row0 = u.pm * 256 + wr * 64 + fr; const int bcol0 = u.pn * 256 + wc * 32 + 8 * fq;
        f32x4 bv[2][2];
#pragma unroll
        for (int bj = 0; bj < 2; ++bj)
#pragma unroll
            for (int n = 0; n < 2; ++n) bv[bj][n] = *(const f32x4*)(bias + bcol0 + bj * 128 + 4 * n);
        if (u.pn < 4) {
            bf16_t* base = VG + u.pn * 128 + wc * 32 + 8 * fq;
#pragma unroll
            for (int ai = 0; ai < 2; ++ai)
#pragma unroll
                for (int m = 0; m < 4; ++m) { bf16_t* rowp = base + (size_t)(row0 + ai * 128 + m * 16) * DCONV;
                    f32x4 a0 = acc[ai][0][m][0] + bv[0][0], a1 = acc[ai][0][m][1] + bv[0][1], g0 = acc[ai][1][m][0] + bv[1][0], g1 = acc[ai][1][m][1] + bv[1][1];
#pragma unroll
                    for (int j = 0; j < 4; ++j) { a0[j] *= fast_sigmoid(g0[j]); a1[j] *= fast_sigmoid(g1[j]); }
                    u32x4 w; w.x = cvt_pk_bf16(a0[0], a0[1]); w.y = cvt_pk_bf16(a0[2], a0[3]); w.z = cvt_pk_bf16(a1[0], a1[1]); w.w = cvt_pk_bf16(a1[2], a1[3]);
                    *(u32x4*)rowp = w; }
        } else {
            const bool isq = u.pn < 6; const float sc = isq ? QSCALE : 1.f; const int ldc = isq ? DATTN : 2 * DKV;
            bf16_t* base = (isq ? Q + (u.pn - 4) * 256 : KV) + wc * 32 + 8 * fq;
#pragma unroll
            for (int ai = 0; ai < 2; ++ai)
#pragma unroll
                for (int m = 0; m < 4; ++m) { bf16_t* rowp = base + (size_t)(row0 + ai * 128 + m * 16) * ldc;
#pragma unroll
                    for (int bj = 0; bj < 2; ++bj) { const f32x4 v0 = (acc[ai][bj][m][0] + bv[bj][0]) * sc, v1 = (acc[ai][bj][m][1] + bv[bj][1]) * sc;
                        u32x4 w; w.x = cvt_pk_bf16(v0[0], v0[1]); w.y = cvt_pk_bf16(v0[2], v0[3]); w.z = cvt_pk_bf16(v1[0], v1[1]); w.w = cvt_pk_bf16(v1[2], v1[3]);
                        *(u32x4*)(rowp + bj * 128) = w; } }
        }
    }
};


template <int R> __device__ __forceinline__ void conv_rows(float (&acc)[32], const float (&w)[31], const unsigned (&vr)[62]) {
    if constexpr (R < 62) {
        const float v = __builtin_bit_cast(float, vr[R] << 16);
#pragma unroll
        for (int j = 0; j < 31; ++j) { const int o = R - j; if (o >= 0 && o < 32) acc[o] += w[j] * v; }
        conv_rows<R + 1>(acc, w, vr);
    }
}
__device__ __forceinline__ void conv_load(const bf16_t* VG, const bf16_t* zeros, int t0, int c, unsigned (&vr)[62]) {
    const int s0 = t0 % SEQ, tb = t0 - s0;
#pragma unroll
    for (int r = 0; r < 62; ++r) { const int ss = s0 - 30 + r; const bf16_t* p = ss < 0 ? zeros + c : VG + (size_t)(tb + ss) * DCONV + c; vr[r] = *p; }
}
__device__ __forceinline__ void p3_conv_all(Frame& F) {
    const bf16_t* VG = (const bf16_t*)(F.ws + WS_VG);
    const float* conv_w = F.in[6]; const float* conv_b = F.in[7]; const float* lng = F.in[8]; const float* lnb = F.in[9]; const float* outg = F.in[10];
    bf16_t* Y = (bf16_t*)(F.ws + WS_H);
    LAS float* tile = (LAS float*)(F.lds + RING_OFF);
    const int c = F.tid; const int NU = T / 32;
    int u = blockIdx.x; if (u >= NU) return;
    float w[31];
#pragma unroll
    for (int j = 0; j < 31; ++j) w[j] = conv_w[j * DCONV + c];
    const float cb = conv_b[c];
    const bf16_t* zeros = (const bf16_t*)(F.ws + WS_CTL + 512 * 1024);
    unsigned vin[62]; conv_load(VG, zeros, 32 * u, c, vin);
#pragma unroll
    for (int r = 0; r < 62; ++r) asm volatile("" : "+v"(vin[r]));
    for (;;) {
        const int t0 = 32 * u; const int un = u + F.G; const bool has = un < NU;
        unsigned vnx[62];
        if (has) conv_load(VG, zeros, 32 * un, c, vnx);
        float acc[32];
#pragma unroll
        for (int o = 0; o < 32; ++o) acc[o] = cb;
        conv_rows<0>(acc, w, vin);
#pragma unroll
        for (int o = 0; o < 32; ++o) tile[o * 516 + c] = acc[o];
        __syncthreads();
        {
            const int c8 = F.lane * 8;
            const f32x4 g0 = *(const f32x4*)(lng + c8), g1 = *(const f32x4*)(lng + c8 + 4), b0 = *(const f32x4*)(lnb + c8), b1 = *(const f32x4*)(lnb + c8 + 4), og0 = *(const f32x4*)(outg + c8), og1 = *(const f32x4*)(outg + c8 + 4);
#pragma unroll
            for (int i = 0; i < 4; ++i) { const int o = F.wave * 4 + i;
                f32x4 v0 = *(const LAS f32x4*)(tile + o * 516 + c8), v1 = *(const LAS f32x4*)(tile + o * 516 + c8 + 4);
                const float mean = wave_sum((v0[0] + v0[1]) + (v0[2] + v0[3]) + (v1[0] + v1[1]) + (v1[2] + v1[3])) * (1.f / DCONV);
                v0 = v0 - mean; v1 = v1 - mean;
                const float var = wave_sum((v0[0] * v0[0] + v0[1] * v0[1]) + (v0[2] * v0[2] + v0[3] * v0[3]) + (v1[0] * v1[0] + v1[1] * v1[1]) + (v1[2] * v1[2] + v1[3] * v1[3])) * (1.f / DCONV);
                const float rstd = rsqrtf(var + EPS);
                v0 = v0 * rstd * g0 + b0; v1 = v1 * rstd * g1 + b1;
                float q = 0.f;
#pragma unroll
                for (int j = 0; j < 4; ++j) { v0[j] = fast_silu(v0[j]); v1[j] = fast_silu(v1[j]); q += v0[j] * v0[j] + v1[j] * v1[j]; }
                q = group8_sum(q);
                const float r2 = rsqrtf(q * (1.f / 64.f) + EPS);
                v0 = v0 * r2 * og0; v1 = v1 * r2 * og1;
                u32x4 ow; ow.x = pk2(v0[0], v0[1]); ow.y = pk2(v0[2], v0[3]); ow.z = pk2(v1[0], v1[1]); ow.w = pk2(v1[2], v1[3]);
                *(u32x4*)(Y + (size_t)(t0 + o) * DM + c8) = ow; }
        }
        __syncthreads();
        if (!has) break;
        u = un;
#pragma unroll
        for (int r = 0; r < 62; ++r) vin[r] = vnx[r];
    }
}

namespace att {
constexpr int KCH = 4112;
constexpr int L_K = 0, L_V = 8 * KCH, L_O = L_V + 32768, OST = 8704, L_WS = L_O + 8 * OST, L_END = L_WS + 8 * 128;
static_assert(L_END <= RING_BYTES, "attention LDS");
typedef short s16x4 __attribute__((ext_vector_type(4)));
typedef float f32x16 __attribute__((ext_vector_type(16)));
typedef short v4i16_t __attribute__((ext_vector_type(4)));
__device__ __forceinline__ int crow(int r, int hi) { return (r & 3) + 8 * (r >> 2) + 4 * hi; }
__device__ __forceinline__ s16x4 vtr(const LAS unsigned char* p) { return __builtin_bit_cast(s16x4, __builtin_amdgcn_ds_read_tr16_b64_v4i16((LAS v4i16_t*)p)); }

__device__ __forceinline__ void attn_unit(Frame& F, int b, int kvh, int blk) {
    const bf16_t* Q = (const bf16_t*)(F.ws + WS_Q); const bf16_t* KV = (const bf16_t*)(F.ws + WS_KV); bf16_t* Y = (bf16_t*)(F.ws + WS_H);
    const float* sinks = F.in[11]; const float* outg = F.in[12];
    LAS unsigned char* lds = F.lds + RING_OFF;
    const int lane = F.lane, r32 = lane & 31, hi = lane >> 5, wave = F.wave;
    const int t0 = b * SEQ + blk * 128;
    bf16x8 qrr[2][4];
#pragma unroll
    for (int wi = 0; wi < 2; ++wi) { const int wu = wave + 8 * wi, hq = wu >> 2, sub = wu & 3;
        const bf16_t* qrow = Q + (size_t)(t0 + 32 * sub + r32) * DATTN + (kvh * 4 + hq) * 64 + hi * 8;
#pragma unroll
        for (int s = 0; s < 4; ++s) qrr[wi][s] = *(const bf16x8*)(qrow + 16 * s); }
    {
        u32x4 kq[4], vq[4];
#pragma unroll
        for (int i = 0; i < 4; ++i) { const int p = F.tid + 512 * i, key = p >> 3, ch = p & 7; const bool valid = (blk > 0) || key >= 128;
            const int tk = valid ? t0 - 128 + key : t0;
            const bf16_t* gk = KV + (size_t)tk * 256 + kvh * 64 + ch * 8;
            kq[i] = *(const u32x4*)gk; vq[i] = *(const u32x4*)(gk + 128);
            if (!valid) { kq[i] = (u32x4){0u, 0u, 0u, 0u}; vq[i] = kq[i]; } }
#pragma unroll
        for (int i = 0; i < 4; ++i) { const int p = F.tid + 512 * i, key = p >> 3, ch = p & 7;
            *(LAS u32x4*)(lds + L_K + ch * KCH + key * 16) = kq[i];
            *(LAS u32x4*)(lds + L_V + (key >> 6) * 8192 + ((ch >> 2) * 4 + ((key & 63) >> 4)) * 1024 + (key & 15) * 64 + (ch & 3) * 16) = vq[i]; }
    }
    __syncthreads();
    if (b == 0 && kvh == 0 && blk == 0) sub_stamp(F, 17);
    const int vlane = (4 * hi + ((lane & 15) >> 2)) * 64 + ((lane >> 4) & 1) * 32 + (lane & 3) * 8;
#pragma unroll
    for (int wi = 0; wi < 2; ++wi) {
        const int wu = wave + 8 * wi, hq = wu >> 2, sub = wu & 3, i0 = 32 * sub, h = kvh * 4 + hq;
        bf16x8 qr[4];
#pragma unroll
        for (int s = 0; s < 4; ++s) qr[s] = qrr[wi][s];
        f32x16 st[5];
        {
            bf16x8 kf[5][4];
#pragma unroll
            for (int t = 0; t < 5; ++t)
#pragma unroll
                for (int s = 0; s < 4; ++s) kf[t][s] = *(const LAS bf16x8*)(lds + L_K + (2 * s + hi) * KCH + (i0 + 32 * t + r32) * 16);
#pragma unroll
            for (int t = 0; t < 5; ++t)
#pragma unroll
                for (int s = 0; s < 4; ++s) asm volatile("" : "+v"(kf[t][s]));
#pragma unroll
            for (int t = 0; t < 5; ++t) {
#pragma unroll
                for (int r = 0; r < 16; ++r) st[t][r] = 0.f;
#pragma unroll
                for (int s = 0; s < 4; ++s) st[t] = __builtin_amdgcn_mfma_f32_32x32x16_bf16(kf[t][s], qr[s], st[t], 0, 0, 0); }
        }
        const float sinkl = sinks[h] * LOG2E;
        float m = sinkl;
#pragma unroll
        for (int t = 0; t < 5; ++t)
#pragma unroll
            for (int r = 0; r < 16; ++r) { const int cj = crow(r, hi); bool ok = true;
                if (t == 0) ok = cj >= r32 + 1; if (t == 4) ok = cj <= r32;
                if (blk == 0) ok = ok && (i0 + 32 * t + cj >= 128);
                const float v = ok ? st[t][r] : -1e30f; st[t][r] = v; m = fmaxf(m, v); }
        m = fmaxf(m, __shfl_xor(m, 32));
        float l = 0.f;
#pragma unroll
        for (int t = 0; t < 5; ++t)
#pragma unroll
            for (int r = 0; r < 16; ++r) { const float pv = __builtin_amdgcn_exp2f(st[t][r] - m); st[t][r] = pv; l += pv; }
        l += __shfl_xor(l, 32); l += __builtin_amdgcn_exp2f(sinkl - m);
        f32x16 o[2];
#pragma unroll
        for (int r = 0; r < 16; ++r) { o[0][r] = 0.f; o[1][r] = 0.f; }
        {
            u32x4 pw[5][2]; s16x4 vlo[5][2][2], vhi[5][2][2];
#pragma unroll
            for (int t = 0; t < 5; ++t)
#pragma unroll
                for (int s2 = 0; s2 < 2; ++s2) {
                    pw[t][s2].x = cvt_pk_bf16(st[t][8 * s2 + 0], st[t][8 * s2 + 1]); pw[t][s2].y = cvt_pk_bf16(st[t][8 * s2 + 2], st[t][8 * s2 + 3]); pw[t][s2].z = cvt_pk_bf16(st[t][8 * s2 + 4], st[t][8 * s2 + 5]); pw[t][s2].w = cvt_pk_bf16(st[t][8 * s2 + 6], st[t][8 * s2 + 7]);
                    const int kk0 = i0 + 32 * t + 16 * s2, g = kk0 >> 6, pc = (kk0 & 63) >> 4;
#pragma unroll
                    for (int d0 = 0; d0 < 2; ++d0) { const LAS unsigned char* vb = lds + L_V + g * 8192 + (d0 * 4 + pc) * 1024 + vlane; vlo[t][s2][d0] = vtr(vb); vhi[t][s2][d0] = vtr(vb + 512); } }
#pragma unroll
            for (int t = 0; t < 5; ++t)
#pragma unroll
                for (int s2 = 0; s2 < 2; ++s2)
#pragma unroll
                    for (int d0 = 0; d0 < 2; ++d0) { asm volatile("" : "+v"(vlo[t][s2][d0])); asm volatile("" : "+v"(vhi[t][s2][d0])); }
#pragma unroll
            for (int t = 0; t < 5; ++t)
#pragma unroll
                for (int s2 = 0; s2 < 2; ++s2) { const bf16x8 pa = __builtin_bit_cast(bf16x8, pw[t][s2]);
#pragma unroll
                    for (int d0 = 0; d0 < 2; ++d0) { const s16x4 lo = vlo[t][s2][d0], hh = vhi[t][s2][d0];
                        const bf16x8 vf = (bf16x8){lo[0], lo[1], lo[2], lo[3], hh[0], hh[1], hh[2], hh[3]};
                        o[d0] = __builtin_amdgcn_mfma_f32_32x32x16_bf16(pa, vf, o[d0], 0, 0, 0); } }
        }
        LAS float* wsf = (LAS float*)(lds + L_WS + wave * 128);
        LAS float* ost = (LAS float*)(lds + L_O + wave * OST);
        if (hi == 0) wsf[r32] = l;
#pragma unroll
        for (int r = 0; r < 16; ++r) { const int q = crow(r, hi); ost[q * 68 + r32] = o[0][r]; ost[q * 68 + 32 + r32] = o[1][r]; }
        LDS_WAIT(); asm volatile("" ::: "memory");
        { const int q = lane >> 1, half = lane & 1; const float rl = 1.f / wsf[q];
          f32x4 v[8]; float ss = 0.f;
#pragma unroll
          for (int j = 0; j < 8; ++j) { v[j] = *(const LAS f32x4*)(ost + q * 68 + half * 32 + 4 * j) * rl; ss += (v[j][0] * v[j][0] + v[j][1] * v[j][1]) + (v[j][2] * v[j][2] + v[j][3] * v[j][3]); }
          ss += __shfl_xor(ss, 1);
          const float rr = rsqrtf(ss * (1.f / 64.f) + EPS);
          const float* gp = outg + h * 64 + half * 32; bf16_t* yp = Y + (size_t)(t0 + i0 + q) * DM + DCONV + h * 64 + half * 32;
#pragma unroll
          for (int j = 0; j < 4; ++j) { const f32x4 a = v[2 * j] * rr * *(const f32x4*)(gp + 8 * j), c2 = v[2 * j + 1] * rr * *(const f32x4*)(gp + 8 * j + 4);
              u32x4 ow; ow.x = pk2(a[0], a[1]); ow.y = pk2(a[2], a[3]); ow.z = pk2(c2[0], c2[1]); ow.w = pk2(c2[2], c2[3]);
              *(u32x4*)(yp + 8 * j) = ow; } }
        LDS_WAIT(); asm volatile("" ::: "memory");
        if (b == 0 && kvh == 0 && blk == 0) sub_stamp(F, 18 + wi);
    }
    __syncthreads();
}
}

__device__ __forceinline__ void p3_attn_only(Frame& F) {
    for (int u = blockIdx.x; u < NBATCH * NKV * (SEQ / 128); u += F.G) { const int blk = u & 31, kvh = (u >> 5) & 1, b = u >> 6; att::attn_unit(F, b, kvh, blk); }
}
__device__ __forceinline__ void p3_conv_only(Frame& F) {
    p3_conv_all(F);
}
__device__ __forceinline__ void p3_mixers(Frame& F) {
#ifndef SKIP_ATTN
    for (int u = blockIdx.x; u < NBATCH * NKV * (SEQ / 128); u += F.G) { const int blk = u & 31, kvh = (u >> 5) & 1, b = u >> 6; att::attn_unit(F, b, kvh, blk); }
#endif
    sub_stamp(F, 13);
#ifndef SKIP_CONV
    p3_conv_all(F);
#endif
    sub_stamp(F, 14);
}

struct OutProj {
    static constexpr bool PERM = true;
    int K, G, c; const bf16_t* A; const bf16_t* Bt; const float* bo; bf16_t* MIX;
    __device__ __forceinline__ bool next(int i, pg8::Unit& u) const { u.e = 0; return pg8::static_next(i, G, c, T / 256, DM / 256, u.pm, u.pn); }
    __device__ __forceinline__ const char* a_base(const pg8::Unit& u) const { return (const char*)A + (size_t)u.pm * 256 * K * 2; }
    __device__ __forceinline__ const char* b_base(const pg8::Unit& u) const { return (const char*)Bt + (size_t)u.pn * 256 * K * 2; }
    __device__ __forceinline__ void a_voff(const pg8::Unit&, const int (&R)[2], const int (&C)[2], unsigned (&v)[2][2]) const {
#pragma unroll
        for (int i = 0; i < 2; ++i) { v[0][i] = (unsigned)(R[i] * K + C[i]) * 2u; v[1][i] = v[0][i] + (unsigned)(128 * K * 2); } }
    __device__ __forceinline__ void epi(const f32x4 (&acc)[2][2][4][2], const pg8::Unit& u, int wr, int wc, int fr, int fq) const {
        const int row0 = u.pm * 256 + wr * 64 + fr; const int col0 = u.pn * 256 + wc * 32 + 8 * fq;
        f32x4 bv[2][2];
#pragma unroll
        for (int bj = 0; bj < 2; ++bj)
#pragma unroll
            for (int n = 0; n < 2; ++n) bv[bj][n] = *(const f32x4*)(bo + col0 + bj * 128 + 4 * n);
#pragma unroll
        for (int ai = 0; ai < 2; ++ai)
#pragma unroll
            for (int m = 0; m < 4; ++m) { bf16_t* rowp = MIX + (size_t)(row0 + ai * 128 + m * 16) * DM + col0;
#pragma unroll
                for (int bj = 0; bj < 2; ++bj) { const f32x4 v0 = acc[ai][bj][m][0] + bv[bj][0], v1 = acc[ai][bj][m][1] + bv[bj][1];
                    u32x4 w; w.x = cvt_pk_bf16(v0[0], v0[1]); w.y = cvt_pk_bf16(v0[2], v0[3]); w.z = cvt_pk_bf16(v1[0], v1[1]); w.w = cvt_pk_bf16(v1[2], v1[3]);
                    *(u32x4*)(rowp + bj * 128) = w; } }
    }
};

constexpr int TAB_OFF = LDSCTL_OFF + 1024;
__device__ __forceinline__ void build_route_table(Frame& F) {
    volatile LAS int* tab = (volatile LAS int*)(F.lds + TAB_OFF);
    if (F.tid == 0) { int tp = 0;
        for (int e = 0; e < NE; ++e) { const int cn = (int)__hip_atomic_load(F.ctl + CW_ECNT + 64 * e, RLX_AGENT); tab[e] = cn; tab[32 + e] = tp; tp += (cn + 255) >> 8; }
        tab[64] = tp; }
    __syncthreads();
}

__device__ __forceinline__ void p5_rows(Frame& F) {
    float* X = F.out; const float* xin = F.in[0]; const bf16_t* MIX = (const bf16_t*)(F.ws + WS_MIX); bf16_t* H2 = (bf16_t*)(F.ws + WS_H2);
    const float* ln_g = F.in[15]; const float* ln_b = F.in[16]; const float* mod = (const float*)(F.ws + WS_MOD);
    const bf16_t* wr_hi = (const bf16_t*)(F.ws + WS_WR); const bf16_t* wr_lo = wr_hi + 48 * DM;
    const float* brg = F.in[18]; const float* bre = F.in[20];
    int* list = (int*)(F.ws + WS_LIST); unsigned* tokrec = (unsigned*)(F.ws + WS_TOK);
    LAS float* lg = (LAS float*)(F.lds + RING_OFF + F.wave * 3072);
    volatile LAS int* lcnt = (volatile LAS int*)(F.lds + RING_OFF + 24576);
    const int lane = F.lane, i16 = lane & 15, kq = lane >> 4;
    constexpr int WLS = 2080;
    LAS unsigned char* wl = F.lds + RING_OFF + 32768;
    for (int p2 = F.tid; p2 < 36 * 128; p2 += 512) { const int rw = p2 >> 7, ch = p2 & 127; *(LAS u32x4*)(wl + rw * WLS + ch * 16) = *(const u32x4*)(wr_hi + (size_t)rw * DM + ch * 8); }
    for (int tile = blockIdx.x; tile < T / 128; tile += F.G) {
        if (F.tid < 64) lcnt[F.tid] = 0;
        __syncthreads();
        const int rbase = tile * 128 + F.wave * 16; const int b = (tile * 128) / SEQ;
        const float* sc2 = mod + b * 6 * DM + 4 * DM; const float* sh2 = mod + b * 6 * DM + 3 * DM;
        {
            const float* g1 = mod + b * 6 * DM + 2 * DM;
            f32x4 gg[4], lgv[4], lbv[4], scv[4], shv[4];
#pragma unroll
            for (int j = 0; j < 4; ++j) { const int col = 4 * lane + 256 * j; gg[j] = *(const f32x4*)(g1 + col); lgv[j] = *(const f32x4*)(ln_g + col); lbv[j] = *(const f32x4*)(ln_b + col);
                scv[j] = *(const f32x4*)(sc2 + col) + 1.f; shv[j] = *(const f32x4*)(sh2 + col); }
            f32x4 z[2][4]; u32x2 mv[2][4];
#pragma unroll
            for (int r = 0; r < 2; ++r)
#pragma unroll
                for (int j = 0; j < 4; ++j) { const size_t o = (size_t)(rbase + r) * DM + 4 * lane + 256 * j; z[r][j] = *(const f32x4*)(xin + o); mv[r][j] = *(const u32x2*)(MIX + o); }
#pragma unroll
            for (int r = 0; r < 2; ++r)
#pragma unroll
                for (int j = 0; j < 4; ++j) { asm volatile("" : "+v"(z[r][j])); asm volatile("" : "+v"(mv[r][j])); }
#pragma unroll 1
            for (int rb = 0; rb < 16; rb += 2) {
                f32x4 zn[2][4]; u32x2 mn[2][4];
                if (rb + 2 < 16) {
#pragma unroll
                    for (int r = 0; r < 2; ++r)
#pragma unroll
                        for (int j = 0; j < 4; ++j) { const size_t o = (size_t)(rbase + rb + 2 + r) * DM + 4 * lane + 256 * j; zn[r][j] = *(const f32x4*)(xin + o); mn[r][j] = *(const u32x2*)(MIX + o); } }
                float sm[2];
#pragma unroll
                for (int r = 0; r < 2; ++r) { sm[r] = 0.f;
#pragma unroll
                    for (int j = 0; j < 4; ++j) { f32x4 m4; m4[0] = __builtin_bit_cast(float, mv[r][j].x << 16); m4[1] = __builtin_bit_cast(float, mv[r][j].x & 0xffff0000u); m4[2] = __builtin_bit_cast(float, mv[r][j].y << 16); m4[3] = __builtin_bit_cast(float, mv[r][j].y & 0xffff0000u);
                        z[r][j] = z[r][j] * ALPHA + gg[j] * m4; sm[r] += (z[r][j][0] + z[r][j][1]) + (z[r][j][2] + z[r][j][3]); } }
#pragma unroll
                for (int r = 0; r < 2; ++r) sm[r] = wave_sum(sm[r]);
                float sq[2];
#pragma unroll
                for (int r = 0; r < 2; ++r) { const float mean = sm[r] * (1.f / DM); sq[r] = 0.f;
#pragma unroll
                    for (int j = 0; j < 4; ++j) { z[r][j] = z[r][j] - mean; sq[r] += (z[r][j][0] * z[r][j][0] + z[r][j][1] * z[r][j][1]) + (z[r][j][2] * z[r][j][2] + z[r][j][3] * z[r][j][3]); } }
#pragma unroll
                for (int r = 0; r < 2; ++r) sq[r] = wave_sum(sq[r]);
#pragma unroll
                for (int r = 0; r < 2; ++r) { const float rstd = rsqrtf(sq[r] * (1.f / DM) + EPS);
#pragma unroll
                    for (int j = 0; j < 4; ++j) { const size_t o = (size_t)(rbase + rb + r) * DM + 4 * lane + 256 * j; const f32x4 x1 = z[r][j] * rstd * lgv[j] + lbv[j];
                        *(f32x4*)(X + o) = x1; const f32x4 t = x1 * scv[j] + shv[j];
                        u32x2 hw; hw.x = pk2(t[0], t[1]); hw.y = pk2(t[2], t[3]); *(u32x2*)(H2 + o) = hw; } }
#pragma unroll
                for (int r = 0; r < 2; ++r)
#pragma unroll
                    for (int j = 0; j < 4; ++j) { z[r][j] = zn[r][j]; mv[r][j] = mn[r][j]; }
            }
            asm volatile("s_waitcnt vmcnt(0)" ::: "memory");
        }
        sub_stamp(F, 15);
        const int row = rbase + i16;
        f32x4 acc[3];
#pragma unroll
        for (int ct = 0; ct < 3; ++ct) acc[ct] = (f32x4){0.f, 0.f, 0.f, 0.f};
        { const bf16_t* hr = H2 + (size_t)row * DM + 8 * kq;
          bf16x8 ah[32];
#pragma unroll
          for (int u = 0; u < 32; ++u) ah[u] = *(const bf16x8*)(hr + 32 * u);
#pragma unroll
          for (int u = 0; u < 32; ++u) asm volatile("" : "+v"(ah[u]));
          const int r2 = (32 + i16) < 36 ? 32 + i16 : 35;
          const LAS unsigned char* w0 = wl + i16 * WLS + kq * 16; const LAS unsigned char* w1 = wl + (16 + i16) * WLS + kq * 16; const LAS unsigned char* w2 = wl + r2 * WLS + kq * 16;
#pragma unroll
          for (int u = 0; u < 32; ++u) {
              acc[0] = __builtin_amdgcn_mfma_f32_16x16x32_bf16(ah[u], *(const LAS bf16x8*)(w0 + 64 * u), acc[0], 0, 0, 0);
              acc[1] = __builtin_amdgcn_mfma_f32_16x16x32_bf16(ah[u], *(const LAS bf16x8*)(w1 + 64 * u), acc[1], 0, 0, 0);
              acc[2] = __builtin_amdgcn_mfma_f32_16x16x32_bf16(ah[u], *(const LAS bf16x8*)(w2 + 64 * u), acc[2], 0, 0, 0); }
        }
        sub_stamp(F, 16);
#pragma unroll
        for (int ct = 0; ct < 3; ++ct)
#pragma unroll
            for (int r = 0; r < 4; ++r) lg[(4 * kq + r) * 48 + 16 * ct + i16] = acc[ct][r];
        LDS_WAIT(); asm volatile("" ::: "memory");
        int e1 = 0, e2 = 0, rk1 = 0, rk2 = 0; float w1 = 0.f, w2 = 0.f;
        if (lane < 16) {
            const LAS float* L = lg + lane * 48;
            float gl[4];
#pragma unroll
            for (int j = 0; j < 4; ++j) gl[j] = L[j] + brg[j];
            int gi = 0; float gm = gl[0];
#pragma unroll
            for (int j = 1; j < 4; ++j) if (gl[j] > gm) { gm = gl[j]; gi = j; }
            float gs = 0.f;
#pragma unroll
            for (int j = 0; j < 4; ++j) gs += __expf(gl[j] - gm);
            const float ptop = 1.f / gs;
            float el[8];
#pragma unroll
            for (int j = 0; j < 8; ++j) el[j] = L[4 + gi * 8 + j] + bre[gi * 8 + j];
            int i1 = 0; float m1 = el[0];
#pragma unroll
            for (int j = 1; j < 8; ++j) if (el[j] > m1) { m1 = el[j]; i1 = j; }
            int i2 = -1; float m2 = -3e38f;
#pragma unroll
            for (int j = 0; j < 8; ++j) if (j != i1 && el[j] > m2) { m2 = el[j]; i2 = j; }
            const float pb = __expf(m2 - m1), inv = ptop / (1.f + pb);
            e1 = gi * 8 + i1; e2 = gi * 8 + i2; w1 = inv; w2 = pb * inv;
            rk1 = __hip_atomic_fetch_add((LAS int*)lcnt + e1, 1, __ATOMIC_RELAXED, __HIP_MEMORY_SCOPE_WORKGROUP);
            rk2 = __hip_atomic_fetch_add((LAS int*)lcnt + e2, 1, __ATOMIC_RELAXED, __HIP_MEMORY_SCOPE_WORKGROUP);
        }
        __syncthreads();
        if (F.tid < 32) { const int n = lcnt[F.tid]; int base = 0; if (n > 0) base = (int)__hip_atomic_fetch_add(F.ctl + CW_ECNT + 64 * F.tid, (unsigned)n, RLX_AGENT); lcnt[32 + F.tid] = base; }
        __syncthreads();
        if (lane < 16) { const int tok = tile * 128 + F.wave * 16 + lane; const int s1 = lcnt[32 + e1] + rk1, s2 = lcnt[32 + e2] + rk2;
            list[(size_t)e1 * T + s1] = tok; list[(size_t)e2 * T + s2] = tok;
            u32x4 r0; r0.x = (unsigned)e1; r0.y = (unsigned)s1; r0.z = (unsigned)e2; r0.w = (unsigned)s2;
            u32x4 r1; r1.x = __builtin_bit_cast(unsigned, w1); r1.y = __builtin_bit_cast(unsigned, w2); r1.z = 0u; r1.w = 0u;
            *(u32x4*)(tokrec + (size_t)tok * 8) = r0; *(u32x4*)(tokrec + (size_t)tok * 8 + 4) = r1; }
        __syncthreads();
    }
}

__device__ __forceinline__ bool moe_next(const volatile LAS int* tab, int i, int G, int c, int NT, pg8::Unit& u) {
    const int nwg = tab[64] * NT; const long L = (long)i * G + c; if (L >= nwg) return false;
    int wgid = (int)L; { const int q = nwg / 8, r = nwg % 8, xcd = wgid % 8, off = wgid / 8; wgid = (xcd < r ? xcd * (q + 1) : r * (q + 1) + (xcd - r) * q) + off; }
    const int mtg = wgid / NT; int e = 0;
    for (int k = 1; k < NE; ++k) e += (tab[32 + k] <= mtg) ? 1 : 0;
    u.e = __builtin_amdgcn_readfirstlane(e); u.pm = __builtin_amdgcn_readfirstlane(mtg - tab[32 + e]); u.pn = __builtin_amdgcn_readfirstlane(wgid % NT); return true;
}
struct MoeUp {
    static constexpr bool PERM = true;
    int K, G, c; const volatile LAS int* tab; const bf16_t* H2; const bf16_t* WGU; const int* list; bf16_t* ACT;
    __device__ __forceinline__ bool next(int i, pg8::Unit& u) const { return moe_next(tab, i, G, c, 2, u); }
    __device__ __forceinline__ const char* a_base(const pg8::Unit&) const { return (const char*)H2; }
    __device__ __forceinline__ const char* b_base(const pg8::Unit& u) const { return (const char*)WGU + ((size_t)u.e * 512 + u.pn * 256) * K * 2; }
    __device__ __forceinline__ void a_voff(const pg8::Unit& u, const int (&R)[2], const int (&C)[2], unsigned (&v)[2][2]) const {
        const int cn = tab[u.e]; const int* lp = list + (size_t)u.e * T;
#pragma unroll
        for (int h = 0; h < 2; ++h)
#pragma unroll
            for (int i = 0; i < 2; ++i) { const int idx = u.pm * 256 + h * 128 + R[i]; const int tok = lp[idx < cn ? idx : 0]; v[h][i] = (unsigned)(tok * K + C[i]) * 2u; } }
    __device__ __forceinline__ void epi(const f32x4 (&acc)[2][2][4][2], const pg8::Unit& u, int wr, int wc, int fr, int fq) const {
        const int row0 = tab[32 + u.e] * 256 + u.pm * 256 + wr * 64 + fr;
        bf16_t* base = ACT + u.pn * 128 + wc * 32 + 8 * fq;
#pragma unroll
        for (int ai = 0; ai < 2; ++ai)
#pragma unroll
            for (int m = 0; m < 4; ++m) { bf16_t* rowp = base + (size_t)(row0 + ai * 128 + m * 16) * DE;
                f32x4 g0 = acc[ai][0][m][0], g1 = acc[ai][0][m][1]; const f32x4 u0 = acc[ai][1][m][0], u1 = acc[ai][1][m][1];
#pragma unroll
                for (int j = 0; j < 4; ++j) { g0[j] = fast_silu(g0[j]) * u0[j]; g1[j] = fast_silu(g1[j]) * u1[j]; }
                u32x4 w; w.x = cvt_pk_bf16(g0[0], g0[1]); w.y = cvt_pk_bf16(g0[2], g0[3]); w.z = cvt_pk_bf16(g1[0], g1[1]); w.w = cvt_pk_bf16(g1[2], g1[3]);
                *(u32x4*)rowp = w; }
    }
};
struct MoeDown {
    static constexpr bool PERM = true;
    int K, G, c; const volatile LAS int* tab; const bf16_t* ACT; const bf16_t* WD; bf16_t* YS;
    __device__ __forceinline__ bool next(int i, pg8::Unit& u) const { return moe_next(tab, i, G, c, 4, u); }
    __device__ __forceinline__ const char* a_base(const pg8::Unit& u) const { return (const char*)ACT + ((size_t)tab[32 + u.e] * 256 + u.pm * 256) * K * 2; }
    __device__ __forceinline__ const char* b_base(const pg8::Unit& u) const { return (const char*)WD + ((size_t)u.e * DM + u.pn * 256) * K * 2; }
    __device__ __forceinline__ void a_voff(const pg8::Unit&, const int (&R)[2], const int (&C)[2], unsigned (&v)[2][2]) const {
#pragma unroll
        for (int i = 0; i < 2; ++i) { v[0][i] = (unsigned)(R[i] * K + C[i]) * 2u; v[1][i] = v[0][i] + (unsigned)(128 * K * 2); } }
    __device__ __forceinline__ void epi(const f32x4 (&acc)[2][2][4][2], const pg8::Unit& u, int wr, int wc, int fr, int fq) const {
        const int row0 = tab[32 + u.e] * 256 + u.pm * 256 + wr * 64 + fr;
        unsigned char* base = (unsigned char*)YS + u.pn * 256 + wc * 32 + 8 * fq;
#pragma unroll
        for (int ai = 0; ai < 2; ++ai)
#pragma unroll
            for (int m = 0; m < 4; ++m) { unsigned char* rowp = base + (size_t)(row0 + ai * 128 + m * 16) * DM;
#pragma unroll
                for (int bj = 0; bj < 2; ++bj) { const f32x4 v0 = acc[ai][bj][m][0] * 64.f, v1 = acc[ai][bj][m][1] * 64.f;
                    u32x2 w; int t0 = __builtin_amdgcn_cvt_pk_fp8_f32(v0[0], v0[1], 0, false); t0 = __builtin_amdgcn_cvt_pk_fp8_f32(v0[2], v0[3], t0, true);
                    int t1 = __builtin_amdgcn_cvt_pk_fp8_f32(v1[0], v1[1], 0, false); t1 = __builtin_amdgcn_cvt_pk_fp8_f32(v1[2], v1[3], t1, true);
                    w.x = (unsigned)t0; w.y = (unsigned)t1;
                    *(u32x2*)(rowp + bj * 128) = w; } }
    }
};

__device__ __forceinline__ void p8_final(Frame& F) {
    float* X = F.out; const unsigned char* YS = (const unsigned char*)(F.ws + WS_YS); const unsigned* tokrec = (const unsigned*)(F.ws + WS_TOK);
    const float* mod = (const float*)(F.ws + WS_MOD); const float* lg = F.in[24]; const float* lb = F.in[25];
    volatile LAS int* tab = (volatile LAS int*)(F.lds + TAB_OFF);
    const int lane = F.lane; const int gw = blockIdx.x * NWAVES + F.wave, NGW = F.G * NWAVES;
    f32x4 lgv[4], lbv[4];
#pragma unroll
    for (int j = 0; j < 4; ++j) { const int col = 4 * lane + 256 * j; lgv[j] = *(const f32x4*)(lg + col); lbv[j] = *(const f32x4*)(lb + col); }
#pragma unroll 1
    for (int base = gw; base < T; base += 2 * NGW) {
        int tr[2]; bool ok[2]; u32x4 r0[2]; u32x2 r1[2];
#pragma unroll
        for (int r = 0; r < 2; ++r) { const int t = base + r * NGW; ok[r] = t < T; tr[r] = ok[r] ? t : base; r0[r] = *(const u32x4*)(tokrec + (size_t)tr[r] * 8); r1[r] = *(const u32x2*)(tokrec + (size_t)tr[r] * 8 + 4); }
        f32x4 z[2][4]; unsigned ya[2][4], yb[2][4]; float w1[2], w2[2]; f32x4 gv[2][4];
#pragma unroll
        for (int r = 0; r < 2; ++r) {
            const int e1 = __builtin_amdgcn_readfirstlane((int)r0[r].x), s1 = __builtin_amdgcn_readfirstlane((int)r0[r].y), e2 = __builtin_amdgcn_readfirstlane((int)r0[r].z), s2 = __builtin_amdgcn_readfirstlane((int)r0[r].w);
            w1[r] = __builtin_bit_cast(float, __builtin_amdgcn_readfirstlane(r1[r].x)) * (1.f / 64.f); w2[r] = __builtin_bit_cast(float, __builtin_amdgcn_readfirstlane(r1[r].y)) * (1.f / 64.f);
            const size_t ra = (size_t)(tab[32 + e1] * 256 + s1), rb = (size_t)(tab[32 + e2] * 256 + s2);
            const float* g2 = mod + (tr[r] / SEQ) * 6 * DM + 5 * DM;
#pragma unroll
            for (int j = 0; j < 4; ++j) { const int col = 4 * lane + 256 * j;
                z[r][j] = *(const f32x4*)(X + (size_t)tr[r] * DM + col); gv[r][j] = *(const f32x4*)(g2 + col);
                ya[r][j] = *(const unsigned*)(YS + ra * DM + col); yb[r][j] = *(const unsigned*)(YS + rb * DM + col); } }
        float sm[2];
#pragma unroll
        for (int r = 0; r < 2; ++r) { sm[r] = 0.f;
#pragma unroll
            for (int j = 0; j < 4; ++j) { f32x4 f;
                const f32x2 a0 = __builtin_amdgcn_cvt_pk_f32_fp8((int)ya[r][j], false), a1 = __builtin_amdgcn_cvt_pk_f32_fp8((int)ya[r][j], true);
                const f32x2 b0 = __builtin_amdgcn_cvt_pk_f32_fp8((int)yb[r][j], false), b1 = __builtin_amdgcn_cvt_pk_f32_fp8((int)yb[r][j], true);
                f[0] = w1[r] * a0.x + w2[r] * b0.x; f[1] = w1[r] * a0.y + w2[r] * b0.y; f[2] = w1[r] * a1.x + w2[r] * b1.x; f[3] = w1[r] * a1.y + w2[r] * b1.y;
                z[r][j] = z[r][j] * ALPHA + gv[r][j] * f; sm[r] += (z[r][j][0] + z[r][j][1]) + (z[r][j][2] + z[r][j][3]); } }
#pragma unroll
        for (int r = 0; r < 2; ++r) sm[r] = wave_sum(sm[r]);
        float sq[2];
#pragma unroll
        for (int r = 0; r < 2; ++r) { const float mean = sm[r] * (1.f / DM); sq[r] = 0.f;
#pragma unroll
            for (int j = 0; j < 4; ++j) { z[r][j] = z[r][j] - mean; sq[r] += (z[r][j][0] * z[r][j][0] + z[r][j][1] * z[r][j][1]) + (z[r][j][2] * z[r][j][2] + z[r][j][3] * z[r][j][3]); } }
#pragma unroll
        for (int r = 0; r < 2; ++r) sq[r] = wave_sum(sq[r]);
#pragma unroll
        for (int r = 0; r < 2; ++r) { const float rstd = rsqrtf(sq[r] * (1.f / DM) + EPS);
            if (ok[r]) {
#pragma unroll
                for (int j = 0; j < 4; ++j) { const int col = 4 * lane + 256 * j; *(f32x4*)(X + (size_t)tr[r] * DM + col) = z[r][j] * rstd * lgv[j] + lbv[j]; } } }
    }
}

__global__ void __launch_bounds__(NWAVES * 64, 2) mega_fwd(Args args) {
    extern __shared__ __attribute__((aligned(16))) unsigned char lds[];
    Frame F;
    F.lds = (LAS unsigned char*)lds;
    F.MISC = (volatile LAS unsigned*)(F.lds + MISC_OFF);
    F.tid = threadIdx.x; F.lane = F.tid & 63; F.wave = __builtin_amdgcn_readfirstlane(F.tid >> 6);
    F.G = gridDim.x; { const int bx = blockIdx.x; F.vcu = (F.G % 8 == 0) ? (bx % 8) * (F.G / 8) + bx / 8 : bx; }
    F.ws = args.ws; F.out = args.out; F.ctl = (gu32*)(args.ws + WS_CTL);
#pragma unroll
    for (int i = 0; i < 26; ++i) F.in[i] = args.in[i];
    for (int u = F.tid; u < (LDS_BYTES - LDSCTL_OFF) / 4; u += NWAVES * 64) ((LAS unsigned*)(F.lds + LDSCTL_OFF))[u] = 0u;
    __syncthreads();
    XcdBarrier bar = xcd_barrier_post((unsigned*)(F.ctl + CW_BAR), F.MISC + 8);
    volatile LAS unsigned* TS = (volatile LAS unsigned*)(F.lds + LDSCTL_OFF + 2048);
#define STAMP(k) do { if (DIAG && blockIdx.x == 0 && F.tid == 0) TS[k] = (unsigned)__builtin_amdgcn_s_memrealtime(); } while (0)
    STAMP(0);
    const int lo = args.ph_lo, hi = args.ph_hi;
#define IN(k) (lo <= (k) && (k) < hi)
#define BOTH(k) (IN(k) && IN((k) + 1))
    if (IN(0)) { p0_prologue(F); sub_stamp(F, 12); if (DUP_PHASE == 0) { xcd_barrier(bar); p0_prologue(F); } if (BOTH(0)) xcd_barrier(bar); STAMP(1); }
    if (IN(1)) { p1_modulate(F); if (DUP_PHASE == 1) { xcd_barrier(bar); p1_modulate(F); } if (BOTH(1)) xcd_barrier(bar); STAMP(2); }
    if (IN(2)) {
        InProj S; S.K = DM; S.G = F.G; S.c = (int)blockIdx.x; S.A = (const bf16_t*)(F.ws + WS_H); S.Bt = (const bf16_t*)(F.ws + WS_WI); S.bias = (const float*)(F.ws + WS_BPERM);
        S.VG = (bf16_t*)(F.ws + WS_VG); S.Q = (bf16_t*)(F.ws + WS_Q); S.KV = (bf16_t*)(F.ws + WS_KV);
        pg8::gemm_phase<InProj>(F.lds + RING_OFF, S);
        if (DUP_PHASE == 2) { xcd_barrier(bar); pg8::gemm_phase<InProj>(F.lds + RING_OFF, S); }
        {
            const int nwg = (T / 256) * (DIN / 256), G = F.G, c = (int)blockIdx.x; const int maxu = (nwg + G - 1) / G; const int full = nwg - (maxu - 1) * G;
            const int nlight = (full == G) ? 0 : G - full;
            if (nlight == 0) p0_convert(F, c * NWAVES + F.wave, G * NWAVES, 1);
            else if (c >= full) p0_convert(F, (c - full) * NWAVES + F.wave, nlight * NWAVES, 1);
        }
        if (BOTH(2)) xcd_barrier(bar); STAMP(3);
    }
    if (IN(3)) { p3_mixers(F); if (DUP_PHASE == 3) { xcd_barrier(bar); p3_mixers(F); } if (DUP_PHASE == 30) { xcd_barrier(bar); p3_attn_only(F); } if (DUP_PHASE == 31) { xcd_barrier(bar); p3_conv_only(F); } if (BOTH(3)) xcd_barrier(bar); STAMP(4); }
    if (IN(4)) {
        OutProj S; S.K = DM; S.G = F.G; S.c = (int)blockIdx.x; S.A = (const bf16_t*)(F.ws + WS_H); S.Bt = (const bf16_t*)(F.ws + WS_WO); S.bo = F.in[14]; S.MIX = (bf16_t*)(F.ws + WS_MIX);
        pg8::gemm_phase<OutProj>(F.lds + RING_OFF, S);
        if (DUP_PHASE == 4) { xcd_barrier(bar); pg8::gemm_phase<OutProj>(F.lds + RING_OFF, S); }
        if (BOTH(4)) xcd_barrier(bar); STAMP(5);
    }
    if (IN(5)) { p5_rows(F); if (BOTH(5)) xcd_barrier(bar); STAMP(6); }
    if (IN(6) || IN(7) || IN(8)) build_route_table(F);
    if (IN(6)) {
        MoeUp S; S.K = DM; S.G = F.G; S.c = (int)blockIdx.x; S.tab = (const volatile LAS int*)(F.lds + TAB_OFF); S.H2 = (const bf16_t*)(F.ws + WS_H2); S.WGU = (const bf16_t*)(F.ws + WS_WGU);
        S.list = (const int*)(F.ws + WS_LIST); S.ACT = (bf16_t*)(F.ws + WS_ACT);
        pg8::gemm_phase<MoeUp>(F.lds + RING_OFF, S);
        if (DUP_PHASE == 6) { xcd_barrier(bar); pg8::gemm_phase<MoeUp>(F.lds + RING_OFF, S); }
        if (BOTH(6)) xcd_barrier(bar); STAMP(7);
    }
    if (IN(7)) {
        MoeDown S; S.K = DE; S.G = F.G; S.c = (int)blockIdx.x; S.tab = (const volatile LAS int*)(F.lds + TAB_OFF); S.ACT = (const bf16_t*)(F.ws + WS_ACT); S.WD = (const bf16_t*)(F.ws + WS_WD); S.YS = (bf16_t*)(F.ws + WS_YS);
        pg8::gemm_phase<MoeDown>(F.lds + RING_OFF, S);
        if (DUP_PHASE == 7) { xcd_barrier(bar); pg8::gemm_phase<MoeDown>(F.lds + RING_OFF, S); }
        if (BOTH(7)) xcd_barrier(bar); STAMP(8);
    }
    if (IN(8)) { p8_final(F); }
#if DIAG
    {
        xcd_barrier(bar); STAMP(9);
        __syncthreads();
#define DSEL(k) ((k) == 9 ? TS[9] - TS[0] : (k) == 10 ? TS[10] - TS[0] : (k) == 11 ? TS[11] - TS[10] : (k) == 12 ? TS[12] - TS[11] : (k) == 13 ? TS[13] - TS[3] : (k) == 17 ? TS[17] - TS[3] : (k) == 18 ? TS[18] - TS[17] : (k) == 19 ? TS[19] - TS[18] : (k) == 15 ? TS[15] - TS[5] : (k) == 16 ? TS[16] - TS[15] : (k) == 14 ? TS[14] - TS[13] : TS[(k) + 1] - TS[(k)])
        const unsigned ta = DSEL(DIAG_A);
        const unsigned tb = DSEL(DIAG_B);
        if (blockIdx.x == 0) {
            const float da = (float)ta * 0.01f, db = (float)tb * 0.01f;
            int n = (int)(db * 500.f); if (n > 126000) n = 126000;
            const int NGW = F.G * NWAVES;
            for (int e = F.tid; e < n; e += 512) { const int ee = e + 1024; const int ri = ee >> 10, col = ee & 1023; const int row = (ri & 7) + (ri >> 3) * NGW; F.out[(size_t)row * DM + col] += 0.05f; }
            if (F.tid == 0) F.out[0] += 1.f + da * 0.02f;
        }
    }
#endif
#undef IN
#undef BOTH
}

namespace nv {
__device__ __forceinline__ float sigmoidf_(float v) { return 1.f / (1.f + __expf(-v)); }
__device__ __forceinline__ float siluf_(float v) { return v / (1.f + __expf(-v)); }
__global__ void __launch_bounds__(256) k_gemm(const float* A, const float* B, const float* bias, float* C, int M, int N, int K) {
    __shared__ float As[16][65]; __shared__ float Bs[16][64];
    int tx = threadIdx.x % 16, ty = threadIdx.x / 16; int m0 = blockIdx.y * 64, n0 = blockIdx.x * 64;
    float acc[4][4] = {};
    for (int k0 = 0; k0 < K; k0 += 16) {
        for (int i = threadIdx.x; i < 64 * 16; i += 256) { int r = i / 16, kk = i % 16; As[kk][r] = A[(size_t)(m0 + r) * K + k0 + kk]; }
        for (int i = threadIdx.x; i < 16 * 64; i += 256) { int kk = i / 64, cc = i % 64; Bs[kk][cc] = B[(size_t)(k0 + kk) * N + n0 + cc]; }
        __syncthreads();
#pragma unroll
        for (int kk = 0; kk < 16; ++kk) { float a[4], b[4];
#pragma unroll
            for (int i = 0; i < 4; ++i) { a[i] = As[kk][ty * 4 + i]; b[i] = Bs[kk][tx * 4 + i]; }
#pragma unroll
            for (int i = 0; i < 4; ++i)
#pragma unroll
                for (int j = 0; j < 4; ++j) acc[i][j] += a[i] * b[j]; }
        __syncthreads();
    }
    for (int i = 0; i < 4; ++i) for (int j = 0; j < 4; ++j) { int r = m0 + ty * 4 + i, cc = n0 + tx * 4 + j; C[(size_t)r * N + cc] = acc[i][j] + (bias ? bias[cc] : 0.f); }
}
__device__ __forceinline__ float block_sum512(float v, float* red) {
    for (int o = 32; o > 0; o >>= 1) v += __shfl_xor(v, o);
    __syncthreads();
    if ((threadIdx.x & 63) == 0) red[threadIdx.x >> 6] = v;
    __syncthreads();
    float s = 0.f; for (int i = 0; i < 8; ++i) s += red[i];
    return s;
}
__global__ void __launch_bounds__(512) k_conv2(const bf16_t* VG, const float* conv_w, const float* conv_b, const float* lng, const float* lnb, const float* outg, float* ycat) {
    __shared__ float red[8];
    int t = blockIdx.x, c = threadIdx.x; int s = t % SEQ;
    float acc = 0.f;
    for (int j = 0; j < CW; ++j) { int ss = s - (CW - 1) + j; if (ss < 0) continue; acc += conv_w[j * DCONV + c] * bf2f(VG[(size_t)(t - (CW - 1) + j) * DCONV + c]); }
    acc += conv_b[c];
    float mean = block_sum512(acc, red) * (1.f / DCONV); float d = acc - mean;
    float var = block_sum512(d * d, red) * (1.f / DCONV);
    float y = d * rsqrtf(var + EPS) * lng[c] + lnb[c];
    y = siluf_(y);
    float q = y * y; for (int o = 32; o > 0; o >>= 1) q += __shfl_xor(q, o);
    y = y * rsqrtf(q * (1.f / 64.f) + EPS) * outg[c];
    ycat[(size_t)t * DM + c] = y;
}
__global__ void __launch_bounds__(512) k_attn2(const bf16_t* Q, const bf16_t* KV, const float* sinks, const float* outg, float* ycat) {
    __shared__ float ps[8][128];
    int t = blockIdx.x, h = threadIdx.x >> 6, lane = threadIdx.x & 63; int s = t % SEQ; int kvh = h / 4;
    const bf16_t* q = Q + (size_t)t * DATTN + h * HD;
    float sc[2];
    for (int i = 0; i < 2; ++i) { int d = lane + 64 * i; int ss = s - d; float v = -1e30f;
        if (ss >= 0) { const bf16_t* k = KV + (size_t)(t - d) * 256 + kvh * HD; float a = 0.f; for (int e = 0; e < HD; ++e) a += bf2f(q[e]) * bf2f(k[e]); v = a; }
        sc[i] = v; }
    float sk = sinks[h] * LOG2E; float m = fmaxf(fmaxf(sc[0], sc[1]), sk);
    for (int o = 32; o > 0; o >>= 1) m = fmaxf(m, __shfl_xor(m, o));
    float p0 = (sc[0] > -1e29f) ? exp2f(sc[0] - m) : 0.f, p1 = (sc[1] > -1e29f) ? exp2f(sc[1] - m) : 0.f;
    float l = p0 + p1; for (int o = 32; o > 0; o >>= 1) l += __shfl_xor(l, o);
    l += exp2f(sk - m);
    ps[h][lane] = p0 / l; ps[h][lane + 64] = p1 / l;
    __syncthreads();
    float o = 0.f; int nd = (s + 1 < WIN) ? s + 1 : WIN;
    for (int d = 0; d < nd; ++d) o += ps[h][d] * bf2f(KV[(size_t)(t - d) * 256 + DKV + kvh * HD + lane]);
    float qq = o * o; for (int oo = 32; oo > 0; oo >>= 1) qq += __shfl_xor(qq, oo);
    ycat[(size_t)t * DM + DCONV + h * HD + lane] = o * rsqrtf(qq * (1.f / 64.f) + EPS) * outg[h * HD + lane];
}
__device__ __forceinline__ float block_sum256(float v, float* red) {
    for (int o = 32; o > 0; o >>= 1) v += __shfl_xor(v, o);
    __syncthreads();
    if ((threadIdx.x & 63) == 0) red[threadIdx.x >> 6] = v;
    __syncthreads();
    return red[0] + red[1] + red[2] + red[3];
}
__global__ void __launch_bounds__(256) k_ln1(const float* x, const float* mix, const float* mod, const float* g, const float* bta, float* x1) {
    __shared__ float red[4];
    int t = blockIdx.x, b = t / SEQ; float z[4]; float s = 0.f;
    for (int i = 0; i < 4; ++i) { int c = threadIdx.x + 256 * i; z[i] = ALPHA * x[(size_t)t * DM + c] + mod[b * 6 * DM + 2 * DM + c] * mix[(size_t)t * DM + c]; s += z[i]; }
    float mean = block_sum256(s, red) * (1.f / DM); float q = 0.f;
    for (int i = 0; i < 4; ++i) { z[i] -= mean; q += z[i] * z[i]; }
    float rstd = rsqrtf(block_sum256(q, red) * (1.f / DM) + EPS);
    for (int i = 0; i < 4; ++i) { int c = threadIdx.x + 256 * i; x1[(size_t)t * DM + c] = z[i] * rstd * g[c] + bta[c]; }
}
__global__ void k_bf2f(const bf16_t* in, float* out, size_t n) { size_t i = (size_t)blockIdx.x * blockDim.x + threadIdx.x; if (i < n) out[i] = bf2f(in[i]); }
__global__ void __launch_bounds__(256) k_moe(float* io, const float* mod, const float* wrg, const float* brg, const float* wre, const float* bre,
                                            const float* wg, const float* wu, const float* wd, const float* g2ln, const float* b2ln) {
    __shared__ float h2[DM]; __shared__ float part[4][64]; __shared__ float logit[64]; __shared__ float act[DE]; __shared__ int se[2]; __shared__ float sw[2]; __shared__ float red[4];
    int t = blockIdx.x, b = t / SEQ, tid = threadIdx.x;
    float x1v[4];
    for (int i = 0; i < 4; ++i) { int c = tid + 256 * i; x1v[i] = io[(size_t)t * DM + c]; h2[c] = x1v[i] * (1.f + mod[b * 6 * DM + 4 * DM + c]) + mod[b * 6 * DM + 3 * DM + c]; }
    __syncthreads();
    { int j = tid & 63, kp = tid >> 6; float a = 0.f;
      if (j < 36) { for (int k = kp * 256; k < kp * 256 + 256; ++k) a += h2[k] * (j < 4 ? wrg[k * NG + j] : wre[k * NE + (j - 4)]); }
      part[kp][j] = a; }
    __syncthreads();
    if (tid < 36) logit[tid] = part[0][tid] + part[1][tid] + part[2][tid] + part[3][tid] + (tid < 4 ? brg[tid] : bre[tid - 4]);
    __syncthreads();
    if (tid == 0) {
        float m = logit[0]; int gi = 0; for (int i = 1; i < 4; ++i) if (logit[i] > m) { m = logit[i]; gi = i; }
        float ssum = 0.f; for (int i = 0; i < 4; ++i) ssum += __expf(logit[i] - m); float ptop = 1.f / ssum;
        const float* el = logit + 4 + gi * 8; float em = el[0]; int i1 = 0; for (int i = 1; i < 8; ++i) if (el[i] > em) { em = el[i]; i1 = i; }
        float e2m = -3e38f; int i2 = -1; for (int i = 0; i < 8; ++i) if (i != i1 && el[i] > e2m) { e2m = el[i]; i2 = i; }
        float pa = 1.f, pb = __expf(e2m - em); float inv = ptop / (pa + pb);
        se[0] = gi * 8 + i1; se[1] = gi * 8 + i2; sw[0] = pa * inv; sw[1] = pb * inv;
    }
    __syncthreads();
    float y[4] = {0.f, 0.f, 0.f, 0.f};
    for (int s = 0; s < 2; ++s) {
        int e = se[s]; float w = sw[s];
        const float* G = wg + (size_t)e * DM * DE; const float* U = wu + (size_t)e * DM * DE; const float* Dn = wd + (size_t)e * DE * DM;
        float ga = 0.f, ua = 0.f;
        for (int k = 0; k < DM; ++k) { float hv = h2[k]; ga += hv * G[(size_t)k * DE + tid]; ua += hv * U[(size_t)k * DE + tid]; }
        __syncthreads();
        act[tid] = siluf_(ga) * ua;
        __syncthreads();
        for (int j = 0; j < DE; ++j) { float av = act[j] * w; for (int i = 0; i < 4; ++i) y[i] += av * Dn[(size_t)j * DM + tid + 256 * i]; }
    }
    float z[4]; float sm = 0.f;
    for (int i = 0; i < 4; ++i) { int c = tid + 256 * i; z[i] = ALPHA * x1v[i] + mod[b * 6 * DM + 5 * DM + c] * y[i]; sm += z[i]; }
    float mean = block_sum256(sm, red) * (1.f / DM); float q = 0.f;
    for (int i = 0; i < 4; ++i) { z[i] -= mean; q += z[i] * z[i]; }
    float rstd = rsqrtf(block_sum256(q, red) * (1.f / DM) + EPS);
    for (int i = 0; i < 4; ++i) { int c = tid + 256 * i; io[(size_t)t * DM + c] = z[i] * rstd * g2ln[c] + b2ln[c]; }
}
}

extern "C" void kernel_launch(void* const* d_in, const int* in_sizes, int n_in, void* d_out, int out_size, void* d_ws, size_t ws_size, hipStream_t stream) {
    static int grid = 0;
    if (grid == 0) {
        int dev = 0, cus = 0;
        if (hipGetDevice(&dev) != hipSuccess || hipDeviceGetAttribute(&cus, hipDeviceAttributeMultiprocessorCount, dev) != hipSuccess) { fprintf(stderr, "kernel_launch: device query failed\n"); grid = -1; return; }
        if (hipFuncSetAttribute((const void*)mega_fwd, hipFuncAttributeMaxDynamicSharedMemorySize, LDS_BYTES) != hipSuccess) { fprintf(stderr, "kernel_launch: hipFuncSetAttribute failed\n"); grid = -1; return; }
        int per_cu = 0;
        if (hipOccupancyMaxActiveBlocksPerMultiprocessor(&per_cu, (const void*)mega_fwd, NWAVES * 64, LDS_BYTES) != hipSuccess || per_cu < 1) fprintf(stderr, "kernel_launch: occupancy query reports %d\n", per_cu);
        (void)hipGetLastError();
        grid = cus;
    }
    if (grid < 0) return;
    (void)hipMemsetAsync((char*)d_ws + WS_CTL, 0, CTL_ZERO_BYTES, stream);
    Args a{};
    for (int i = 0; i < 26; ++i) a.in[i] = (const float*)d_in[i];
    a.out = (float*)d_out; a.ws = (unsigned char*)d_ws; a.ph_lo = 0; a.ph_hi = DEV_STAGE + 1;
    hipLaunchKernelGGL(mega_fwd, dim3(grid), dim3(NWAVES * 64), LDS_BYTES, stream, a);
    {
        using namespace nv;
        char* ws = (char*)d_ws; float* out = (float*)d_out;
        const float* x = (const float*)d_in[0];
        const float* mod = (const float*)(ws + WS_MOD);
        float* ycat = (float*)(ws + WS_DEV1);
        float* mix = (float*)(ws + 56 * MiB);
#if DEV_STAGE == 3
        k_bf2f<<<(unsigned)((size_t)T * DM / 256), 256, 0, stream>>>((const bf16_t*)(ws + WS_H), ycat, (size_t)T * DM);
        mix = (float*)(ws + 120 * MiB);
        k_gemm<<<dim3(DM / 64, T / 64), 256, 0, stream>>>(ycat, (const float*)d_in[13], (const float*)d_in[14], mix, T, DM, DM);
        k_ln1<<<T, 256, 0, stream>>>(x, mix, mod, (const float*)d_in[15], (const float*)d_in[16], out);
        k_moe<<<T, 256, 0, stream>>>(out, mod, (const float*)d_in[17], (const float*)d_in[18], (const float*)d_in[19], (const float*)d_in[20], (const float*)d_in[21], (const float*)d_in[22], (const float*)d_in[23], (const float*)d_in[24], (const float*)d_in[25]);
#endif
#if DEV_STAGE == 2
        k_conv2<<<T, 512, 0, stream>>>((const bf16_t*)(ws + WS_VG), (const float*)d_in[6], (const float*)d_in[7], (const float*)d_in[8], (const float*)d_in[9], (const float*)d_in[10], ycat);
        k_attn2<<<T, 512, 0, stream>>>((const bf16_t*)(ws + WS_Q), (const bf16_t*)(ws + WS_KV), (const float*)d_in[11], (const float*)d_in[12], ycat);
        k_gemm<<<dim3(DM / 64, T / 64), 256, 0, stream>>>(ycat, (const float*)d_in[13], (const float*)d_in[14], mix, T, DM, DM);
        k_ln1<<<T, 256, 0, stream>>>(x, mix, mod, (const float*)d_in[15], (const float*)d_in[16], out);
        k_moe<<<T, 256, 0, stream>>>(out, mod, (const float*)d_in[17], (const float*)d_in[18], (const float*)d_in[19], (const float*)d_in[20], (const float*)d_in[21], (const float*)d_in[22], (const float*)d_in[23], (const float*)d_in[24], (const float*)d_in[25]);
#endif
    }
}
```
